# Optimizing an MI355X kernel written in HIP

```python
import math
import jax, jax.numpy as jnp
from jax import lax
import numpy as np

D_MODEL = 2048
BATCH = 4
SEQ = 2048
DEPTH = 2

HEAD_DIM = 128
SB_HEADS = 6
SB_WIDTH = SB_HEADS * HEAD_DIM
SSM_CH_PER_GROUP = 16
SSM_GROUPS = 32
SSM_WIDTH = SSM_GROUPS * SSM_CH_PER_GROUP
SSM_STATE = 64
DIFF_HEADS = 6
DIFF_QK_DIM = HEAD_DIM // 2
DIFF_QK_WIDTH = DIFF_HEADS * 2 * DIFF_QK_DIM
DIFF_WIDTH = DIFF_HEADS * HEAD_DIM
MIX_WIDTH = SB_WIDTH + SSM_WIDTH + DIFF_WIDTH
IN_SPLIT_SIZES = (SB_WIDTH, SB_WIDTH, SB_WIDTH, SSM_WIDTH, DIFF_QK_WIDTH, DIFF_QK_WIDTH, DIFF_WIDTH)
IN_COLS = 3 * SB_WIDTH + SSM_WIDTH + 2 * DIFF_QK_WIDTH + DIFF_WIDTH
D_FF = 5632
FFN_RESIDUAL_WEIGHT = 0.5
NUM_BUCKETS = 32
MAX_DISTANCE = 128
Q_BLOCK = 128
NORM_EPS = 1e-6
DT_MIN = 1e-3
DT_MAX = 1e-1

kernel_name = "hybrid_sb_s5_diffattn_macaron"


def rms_norm(x, g):
    xf = x.astype(jnp.float32)
    y = xf * lax.rsqrt(jnp.mean(xf * xf, axis=-1, keepdims=True) + NORM_EPS)
    return (y * g.astype(jnp.float32)).astype(x.dtype)


def swiglu(x, w_gate, w_up, w_down):
    return (jax.nn.silu(x @ w_gate) * (x @ w_up)) @ w_down


def split_heads(t, n_heads, d):
    b, s, _ = t.shape
    return t.reshape(b, s, n_heads, d).transpose(0, 2, 1, 3)


def to_blocks(t):
    b, h, s, d = t.shape
    return jnp.moveaxis(t.reshape(b, h, s // Q_BLOCK, Q_BLOCK, d), 2, 0)


def from_blocks(t):
    nb, b, h, q, d = t.shape
    return jnp.transpose(t, (1, 0, 3, 2, 4)).reshape(b, nb * q, h * d)


def t5_bucket(q_pos, k_pos):
    n = jnp.maximum(q_pos[:, None] - k_pos[None, :], 0)
    max_exact = NUM_BUCKETS // 2
    nf = jnp.maximum(n, 1).astype(jnp.float32)
    large = max_exact + (jnp.log(nf / max_exact) / math.log(MAX_DISTANCE / max_exact)
                         * (NUM_BUCKETS - max_exact)).astype(jnp.int32)
    large = jnp.minimum(large, NUM_BUCKETS - 1)
    return jnp.where(n < max_exact, n, large)


def stick_breaking_attention(q, k, v):
    s = q.shape[2]
    scale = 1.0 / math.sqrt(HEAD_DIM)
    k_pos = jnp.arange(s, dtype=jnp.int32)

    def block(args):
        qb, q0 = args
        z = jnp.einsum('bhqd,bhkd->bhqk', qb, k, preferred_element_type=jnp.float32) * scale
        q_pos = q0 + jnp.arange(Q_BLOCK, dtype=jnp.int32)
        mask = k_pos[None, :] < q_pos[:, None]
        log_beta = jax.nn.log_sigmoid(z)
        log_keep = jnp.where(mask, jax.nn.log_sigmoid(-z), 0.0)
        between = lax.cumsum(log_keep, axis=3, reverse=True) - log_keep
        weights = jnp.where(mask, jnp.exp(log_beta + between), 0.0)
        return jnp.einsum('bhqk,bhkd->bhqd', weights.astype(v.dtype), v)

    starts = jnp.arange(s // Q_BLOCK, dtype=jnp.int32) * Q_BLOCK
    return from_blocks(lax.map(block, (to_blocks(q), starts)))


def diff_attention(q1, q2, k1, k2, v, lam, rel_bias):
    s = q1.shape[2]
    scale = 1.0 / math.sqrt(DIFF_QK_DIM)
    k_pos = jnp.arange(s, dtype=jnp.int32)
    neg = jnp.finfo(jnp.float32).min

    def block(args):
        q1b, q2b, q0 = args
        q_pos = q0 + jnp.arange(Q_BLOCK, dtype=jnp.int32)
        bias = jnp.transpose(rel_bias[t5_bucket(q_pos, k_pos)], (2, 0, 1)).astype(jnp.float32)
        mask = k_pos[None, :] <= q_pos[:, None]

        def probs(qb, kk):
            logits = jnp.einsum('bhqd,bhkd->bhqk', qb, kk, preferred_element_type=jnp.float32) * scale + bias
            return jax.nn.softmax(jnp.where(mask, logits, neg), axis=-1)

        p = probs(q1b, k1) - lam * probs(q2b, k2)
        return jnp.einsum('bhqk,bhkd->bhqd', p.astype(v.dtype), v)

    starts = jnp.arange(s // Q_BLOCK, dtype=jnp.int32) * Q_BLOCK
    return from_blocks(lax.map(block, (to_blocks(q1), to_blocks(q2), starts)))


def s5_mixer(u, a_re, a_im, log_dt, b_re, b_im, c_re, c_im, d_skip, w_glu, b_glu):
    bsz, s, _ = u.shape
    f32 = jnp.float32
    uf = u.astype(f32).reshape(bsz, s, SSM_GROUPS, SSM_CH_PER_GROUP)
    ar, ai = a_re.astype(f32), a_im.astype(f32)
    dt = jnp.exp(log_dt.astype(f32))[:, None]
    mag = jnp.exp(ar * dt)
    lb_re, lb_im = mag * jnp.cos(ai * dt), mag * jnp.sin(ai * dt)
    den = ar * ar + ai * ai
    f_re = ((lb_re - 1.0) * ar + lb_im * ai) / den
    f_im = (lb_im * ar - (lb_re - 1.0) * ai) / den
    br, bi = b_re.astype(f32), b_im.astype(f32)
    bb_re = f_re[..., None] * br - f_im[..., None] * bi
    bb_im = f_re[..., None] * bi + f_im[..., None] * br
    bu_re = jnp.einsum('gpc,bsgc->bsgp', bb_re, uf)
    bu_im = jnp.einsum('gpc,bsgc->bsgp', bb_im, uf)
    el_re = jnp.broadcast_to(lb_re, (1, s, SSM_GROUPS, SSM_STATE))
    el_im = jnp.broadcast_to(lb_im, (1, s, SSM_GROUPS, SSM_STATE))

    def combine(e1, e2):
        a1r, a1i, b1r, b1i = e1
        a2r, a2i, b2r, b2i = e2
        return (a2r * a1r - a2i * a1i, a2r * a1i + a2i * a1r,
                a2r * b1r - a2i * b1i + b2r, a2r * b1i + a2i * b1r + b2i)

    _, _, x_re, x_im = lax.associative_scan(combine, (el_re, el_im, bu_re, bu_im), axis=1)
    y = (jnp.einsum('gcp,bsgp->bsgc', c_re.astype(f32), x_re)
         - jnp.einsum('gcp,bsgp->bsgc', c_im.astype(f32), x_im)
         + d_skip.astype(f32) * uf)
    y = jax.nn.gelu(y.reshape(bsz, s, SSM_WIDTH)).astype(u.dtype)
    return y * jax.nn.sigmoid(y @ w_glu + b_glu)


def setup_inputs(seed: int = 0) -> dict:
    key = jax.random.key(seed)
    keys = iter(jax.random.split(key, 48))

    def nrm(shape, scale):
        return jax.random.normal(next(keys), shape, jnp.float32) * scale

    def gain(shape):
        return 1.0 + nrm(shape, 0.02)

    L, D, F = DEPTH, D_MODEL, D_FF
    G, P, C = SSM_GROUPS, SSM_STATE, SSM_CH_PER_GROUP
    n_idx = jnp.arange(P, dtype=jnp.float32)
    inp = {}
    inp["x"] = nrm((BATCH, SEQ, D), 1.0)
    inp["ffn1_pre_g"] = gain((L, D))
    inp["ffn1_w_gate"] = nrm((L, D, F), D ** -0.5)
    inp["ffn1_w_up"] = nrm((L, D, F), D ** -0.5)
    inp["ffn1_w_down"] = nrm((L, F, D), F ** -0.5)
    inp["ffn1_post_g"] = gain((L, D))
    inp["mix_pre_g"] = gain((L, D))
    inp["w_in"] = nrm((L, D, IN_COLS), D ** -0.5)
    inp["ssm_a_re"] = -0.5 + nrm((L, G, P), 0.01)
    inp["ssm_a_im"] = math.pi * n_idx + nrm((L, G, P), 0.01)
    inp["ssm_log_dt"] = jax.random.uniform(next(keys), (L, G), jnp.float32,
                                           math.log(DT_MIN), math.log(DT_MAX))
    inp["ssm_b_re"] = nrm((L, G, P, C), (2 * C) ** -0.5)
    inp["ssm_b_im"] = nrm((L, G, P, C), (2 * C) ** -0.5)
    inp["ssm_c_re"] = nrm((L, G, C, P), (2 * P) ** -0.5)
    inp["ssm_c_im"] = nrm((L, G, C, P), (2 * P) ** -0.5)
    inp["ssm_d"] = nrm((L, G, C), 1.0)
    inp["ssm_w_glu"] = nrm((L, SSM_WIDTH, SSM_WIDTH), SSM_WIDTH ** -0.5)
    inp["ssm_b_glu"] = nrm((L, SSM_WIDTH), 0.02)
    inp["diff_lq1"] = nrm((L, DIFF_QK_DIM), 0.1)
    inp["diff_lk1"] = nrm((L, DIFF_QK_DIM), 0.1)
    inp["diff_lq2"] = nrm((L, DIFF_QK_DIM), 0.1)
    inp["diff_lk2"] = nrm((L, DIFF_QK_DIM), 0.1)
    inp["diff_subln_g"] = gain((L, HEAD_DIM))
    inp["rel_bias"] = nrm((NUM_BUCKETS, DIFF_HEADS), 0.5)
    inp["w_out"] = nrm((L, MIX_WIDTH, D), MIX_WIDTH ** -0.5)
    inp["mix_post_g"] = gain((L, D))
    inp["ffn2_pre_g"] = gain((L, D))
    inp["ffn2_w_gate"] = nrm((L, D, F), D ** -0.5)
    inp["ffn2_w_up"] = nrm((L, D, F), D ** -0.5)
    inp["ffn2_w_down"] = nrm((L, F, D), F ** -0.5)
    inp["ffn2_post_g"] = gain((L, D))
    return inp


def reference(x, ffn1_pre_g, ffn1_w_gate, ffn1_w_up, ffn1_w_down, ffn1_post_g,
              mix_pre_g, w_in, ssm_a_re, ssm_a_im, ssm_log_dt, ssm_b_re, ssm_b_im,
              ssm_c_re, ssm_c_im, ssm_d, ssm_w_glu, ssm_b_glu,
              diff_lq1, diff_lk1, diff_lq2, diff_lk2, diff_subln_g, rel_bias,
              w_out, mix_post_g,
              ffn2_pre_g, ffn2_w_gate, ffn2_w_up, ffn2_w_down, ffn2_post_g):
    split_points = [sum(IN_SPLIT_SIZES[:i + 1]) for i in range(len(IN_SPLIT_SIZES) - 1)]
    h = x
    for l in range(DEPTH):
        y = swiglu(rms_norm(h, ffn1_pre_g[l]), ffn1_w_gate[l], ffn1_w_up[l], ffn1_w_down[l])
        h = h + FFN_RESIDUAL_WEIGHT * rms_norm(y, ffn1_post_g[l])

        xn = rms_norm(h, mix_pre_g[l])
        proj = xn @ w_in[l]
        sb_q, sb_k, sb_v, ssm_u, dq, dk, dv = jnp.split(proj, split_points, axis=-1)
        b, s, _ = proj.shape

        o_sb = stick_breaking_attention(split_heads(sb_q, SB_HEADS, HEAD_DIM),
                                        split_heads(sb_k, SB_HEADS, HEAD_DIM),
                                        split_heads(sb_v, SB_HEADS, HEAD_DIM))

        o_ssm = s5_mixer(ssm_u, ssm_a_re[l], ssm_a_im[l], ssm_log_dt[l], ssm_b_re[l], ssm_b_im[l],
                         ssm_c_re[l], ssm_c_im[l], ssm_d[l], ssm_w_glu[l], ssm_b_glu[l])

        qh = dq.reshape(b, s, DIFF_HEADS, 2, DIFF_QK_DIM).transpose(3, 0, 2, 1, 4)
        kh = dk.reshape(b, s, DIFF_HEADS, 2, DIFF_QK_DIM).transpose(3, 0, 2, 1, 4)
        vh = split_heads(dv, DIFF_HEADS, HEAD_DIM)
        lambda_init = 0.8 - 0.6 * math.exp(-0.3 * l)
        lam = (jnp.exp(jnp.sum(diff_lq1[l].astype(jnp.float32) * diff_lk1[l].astype(jnp.float32)))
               - jnp.exp(jnp.sum(diff_lq2[l].astype(jnp.float32) * diff_lk2[l].astype(jnp.float32)))
               + lambda_init)
        o_diff = diff_attention(qh[0], qh[1], kh[0], kh[1], vh, lam, rel_bias)
        o_diff = rms_norm(o_diff.reshape(b, s, DIFF_HEADS, HEAD_DIM), diff_subln_g[l]) * (1.0 - lambda_init)
        o_diff = o_diff.reshape(b, s, DIFF_WIDTH)

        mixed = jnp.concatenate([o_sb, o_ssm, o_diff], axis=-1)
        h = h + rms_norm(mixed @ w_out[l], mix_post_g[l])

        y = swiglu(rms_norm(h, ffn2_pre_g[l]), ffn2_w_gate[l], ffn2_w_up[l], ffn2_w_down[l])
        h = h + FFN_RESIDUAL_WEIGHT * rms_norm(y, ffn2_post_g[l])
    return h
```

```cpp
#include <hip/hip_runtime.h>
#include <cstdio>
#include <cstdint>
namespace pg8 {
#define PG8_LAS __attribute__((address_space(3)))
typedef unsigned short bf16_t;
typedef short bf16x8 __attribute__((ext_vector_type(8)));
typedef float f32x4 __attribute__((ext_vector_type(4)));
typedef unsigned u32x4 __attribute__((ext_vector_type(4)));
constexpr int BM = 256, BK = 64, HALF = 128, HTB = HALF * BK * 2  , STAGE_BYTES = 8 * HTB, NXCD = 8, WGM = 8;

__host__ __device__ __forceinline__ int lds_byte(int r, int c) { const int st = (r >> 4) * 2 + (c >> 5), rr = r & 15, cc = c & 31, ob = rr * 64 + cc * 2; return st * 1024 + (ob ^ (((ob >> 9) & 1) << 5)); }
__host__ __device__ __forceinline__ void stage_rc(int b, int& R, int& C) { const int st = b / 1024, sb = b % 1024, swz = sb ^ (((sb >> 9) & 1) << 5); R = (st >> 1) * 16 + swz / 64; C = (st & 1) * 32 + (swz % 64) / 2; }
__host__ __device__ __forceinline__ int perm32(int rho) { const int n = rho >> 4, i = rho & 15; return 8 * (i >> 2) + 4 * n + (i & 3); }

struct Unit { int pm, pn; };
struct Gemm { const bf16_t* A; const bf16_t* Bt; int M, N, K; };

struct StaticOrder {
    int nM, nN, nwg, G, c;
    __host__ __device__ void init(int M, int N, int G_, int c_) { nM = M / BM; nN = N / BM; nwg = nM * nN; G = G_; c = c_; }
    __host__ __device__ bool next(int i, Unit& u) const {
        const long L = (long)i * G + c; if (L >= nwg) return false;
        int wgid = (int)L; { const int q = nwg / NXCD, r = nwg % NXCD, xcd = wgid % NXCD, off = wgid / NXCD; wgid = (xcd < r ? xcd * (q + 1) : r * (q + 1) + (xcd - r) * q) + off; }
        const int nig = WGM * nN, gid = wgid / nig, fm = gid * WGM, gsz = (nM - fm) < WGM ? (nM - fm) : WGM;
        u.pm = fm + ((wgid % nig) % gsz); u.pn = (wgid % nig) / gsz; return true;
    }
    __device__ __forceinline__ void a_ready(const Unit&) const {}
    __device__ __forceinline__ void done(const Unit&) const {}
};

__device__ __forceinline__ unsigned cvt_pk_bf16(float lo, float hi) { unsigned r; asm volatile("v_cvt_pk_bf16_f32 %0, %1, %2" : "=v"(r) : "v"(lo), "v"(hi)); return r; }
typedef float f32x2 __attribute__((ext_vector_type(2)));
__device__ __forceinline__ f32x2 gelu_pk(f32x2 v) {
    const f32x2 av = __builtin_elementwise_abs(v), d = av * 0.2316418882f + 1.0f;
    f32x2 t; t.x = __builtin_amdgcn_rcpf(d.x); t.y = __builtin_amdgcn_rcpf(d.y);
    f32x2 q = t * 0.5307027145f + (-0.7265760135f); q = q * t + 0.7107068705f; q = q * t + (-0.142248368f); q = q * t + 0.127414796f; q = q * t;
    const f32x2 s = (v * v) * (-0.72134752044f);
    f32x2 e; e.x = __builtin_amdgcn_exp2f(s.x); e.y = __builtin_amdgcn_exp2f(s.y);
    const f32x2 m = v * (q * e), r = v - m;
    f32x2 o; o.x = v.x < 0.f ? m.x : r.x; o.y = v.y < 0.f ? m.y : r.y; return o;
}

template <int ACT  > struct EpiBf16 {
    static constexpr bool PERM = true, AFTER_DRAIN = false; static_assert(ACT == 0 || ACT == 1, "EpiBf16: ACT is 0 (none) or 1 (gelu_pk)");
    bf16_t* O; int ldc; const float* bias; int split_cols; size_t split_stride; float scale0;
    __device__ __forceinline__ void operator()(const f32x4 (&acc)[2][2][4][2], const Unit& u, int wr, int wc, int fr, int fq) const {
        const int row0 = u.pm * BM + wr * 64 + fr; int colt = u.pn * BM; bf16_t* base = O;
        float sc = 1.f; if (split_cols) { const int t = colt / split_cols; base += (size_t)t * split_stride; colt -= t * split_cols; if (t == 0) sc = scale0; }
        const int col0 = colt + wc * 32 + 8 * fq, bcol0 = u.pn * BM + wc * 32 + 8 * fq;
        f32x4 bv[2][2];
#pragma unroll
        for (int bj = 0; bj < 2; ++bj)
#pragma unroll
            for (int n = 0; n < 2; ++n) bv[bj][n] = bias ? *(const f32x4*)(bias + bcol0 + bj * HALF + 4 * n) : (f32x4){0.f, 0.f, 0.f, 0.f};
#pragma unroll
        for (int ai = 0; ai < 2; ++ai)
#pragma unroll
            for (int m = 0; m < 4; ++m) { bf16_t* rowp = base + (size_t)(row0 + ai * HALF + m * 16) * ldc + col0;
#pragma unroll
                for (int bj = 0; bj < 2; ++bj) { f32x4 v0 = acc[ai][bj][m][0] + bv[bj][0], v1 = acc[ai][bj][m][1] + bv[bj][1];
                    if (ACT == 1) { f32x2 a = gelu_pk((f32x2){v0[0], v0[1]}), b = gelu_pk((f32x2){v0[2], v0[3]}), c = gelu_pk((f32x2){v1[0], v1[1]}), d = gelu_pk((f32x2){v1[2], v1[3]});
                        v0 = (f32x4){a.x, a.y, b.x, b.y}; v1 = (f32x4){c.x, c.y, d.x, d.y}; }
                    v0 = v0 * sc; v1 = v1 * sc; u32x4 w; w.x = cvt_pk_bf16(v0[0], v0[1]); w.y = cvt_pk_bf16(v0[2], v0[3]); w.z = cvt_pk_bf16(v1[0], v1[1]); w.w = cvt_pk_bf16(v1[2], v1[3]);
                    *(u32x4*)(rowp + bj * HALF) = w; } }
    }
};

template <class Epi, class Sched, bool ALIGN_EPI = false, bool SP2 = false>
__device__ __forceinline__ void gemm_phase(PG8_LAS unsigned char* lds, const Gemm g, const Sched& S, const Epi& E) {
    int tid_o = threadIdx.x; asm volatile("" : "+v"(tid_o));
    const int tid = tid_o, wid = __builtin_amdgcn_readfirstlane(tid >> 6), lane = tid & 63, wr = wid >> 2, wc = wid & 3, fr = lane & 15, fq = lane >> 4;
    const int K = g.K, nt = K / BK;
    unsigned voffA[2], voffB[2];
#pragma unroll
    for (int i = 0; i < 2; ++i) { int R, C; stage_rc(tid * 16 + i * 8192, R, C); const int Rb = Epi::PERM ? ((R & ~31) + perm32(R & 31)) : R;
        voffA[i] = (unsigned)(R * K + C) * 2u; voffB[i] = (unsigned)(Rb * K + C) * 2u; }
    const size_t kstep = (size_t)(BK * 2);
    const size_t hstep = (size_t)HALF * K * 2;
    const size_t tstep = 2 * hstep;
    const unsigned ldsw = (unsigned)wid * 1024u;
    const int aoff = lds_byte(wr * 64 + fr, fq * 8), boff = lds_byte(wc * 32 + fr, fq * 8);
#define PG8_SA(b, h) (((b) * 2 + (h)) * HTB)
#define PG8_SB(b, h) ((4 + (b) * 2 + (h)) * HTB)
#define PG8_STAGE(bufoff, gbase, voff) do { _Pragma("unroll") for (int _i = 0; _i < 2; ++_i) \
        __builtin_amdgcn_global_load_lds((const unsigned*)((const char*)(gbase) + (voff)[_i]), (PG8_LAS unsigned*)(lds + (bufoff) + ldsw + _i * 8192), 16, 0, 0); } while (0)
#define PG8_LDA(dst, b, h) do { _Pragma("unroll") for (int m = 0; m < 4; ++m) _Pragma("unroll") for (int k = 0; k < 2; ++k) dst[m][k] = *(const PG8_LAS bf16x8*)(lds + PG8_SA(b, h) + aoff + m * 2048 + k * 1024); } while (0)
#define PG8_LDB(dst, b, h) do { _Pragma("unroll") for (int n = 0; n < 2; ++n) _Pragma("unroll") for (int k = 0; k < 2; ++k) dst[n][k] = *(const PG8_LAS bf16x8*)(lds + PG8_SB(b, h) + boff + n * 2048 + k * 1024); } while (0)
#define PG8_MMA(ai, bj, At, Bt) do { __builtin_amdgcn_s_setprio(1); _Pragma("unroll") for (int m = 0; m < 4; ++m) _Pragma("unroll") for (int n = 0; n < 2; ++n) _Pragma("unroll") for (int k = 0; k < 2; ++k) \
        acc[ai][bj][m][n] = __builtin_amdgcn_mfma_f32_16x16x32_bf16(Bt[n][k], At[m][k], acc[ai][bj][m][n], 0, 0, 0); __builtin_amdgcn_s_setprio(0); } while (0)
#define PG8_WAIT_V(n) asm volatile("s_waitcnt vmcnt(" #n ")" ::: "memory")
#define PG8_WAIT_L(n) asm volatile("s_waitcnt lgkmcnt(" #n ")" ::: "memory")
#define PG8_BAR __builtin_amdgcn_s_barrier()
#define PG8_SCHED __builtin_amdgcn_sched_barrier(0)
    Unit cur, nxt; int ui = 0;
    if (!S.next(0, cur)) return;
    f32x4 acc[2][2][4][2];
#pragma unroll
    for (int a = 0; a < 2; ++a)
#pragma unroll
        for (int b = 0; b < 2; ++b)
#pragma unroll
            for (int m = 0; m < 4; ++m)
#pragma unroll
                for (int n = 0; n < 2; ++n) acc[a][b][m][n] = (f32x4){0.f, 0.f, 0.f, 0.f};
    bf16x8 At[4][2], B0[2][2], B1[2][2];
    const char* cA = (const char*)g.A + (size_t)cur.pm * tstep; const char* cB = (const char*)g.Bt + (size_t)cur.pn * tstep;
    S.a_ready(cur);
    if constexpr (SP2) {
        PG8_STAGE(PG8_SB(0, 0), cB, voffB); PG8_STAGE(PG8_SB(0, 1), cB + hstep, voffB); PG8_STAGE(PG8_SA(0, 0), cA, voffA); PG8_STAGE(PG8_SA(0, 1), cA + hstep, voffA);
        if (wr == 1) PG8_BAR;
        PG8_WAIT_V(2); PG8_BAR;
        PG8_STAGE(PG8_SB(1, 0), cB + kstep, voffB); PG8_STAGE(PG8_SA(1, 0), cA + kstep, voffA); PG8_STAGE(PG8_SB(1, 1), cB + hstep + kstep, voffB);
        PG8_WAIT_V(6); PG8_BAR;
    } else {
        PG8_STAGE(PG8_SB(0, 0), cB, voffB); PG8_STAGE(PG8_SA(0, 0), cA, voffA); PG8_STAGE(PG8_SB(0, 1), cB + hstep, voffB); PG8_STAGE(PG8_SA(0, 1), cA + hstep, voffA);
        if (wr == 1) PG8_BAR;
        PG8_WAIT_V(4); PG8_BAR;
        PG8_STAGE(PG8_SB(1, 0), cB + kstep, voffB); PG8_STAGE(PG8_SA(1, 0), cA + kstep, voffA); PG8_STAGE(PG8_SB(1, 1), cB + hstep + kstep, voffB);
        PG8_WAIT_V(6); PG8_BAR;
    }
    for (;;) {
        const bool has_next = S.next(ui + 1, nxt);
        const char* nA = has_next ? (const char*)g.A + (size_t)nxt.pm * tstep : cA; const char* nB = has_next ? (const char*)g.Bt + (size_t)nxt.pn * tstep : cB;
        for (int t = 0; t < nt; t += 2) {
            const bool last = (t == nt - 2);
            const char* a1 = cA + (size_t)(t + 1) * kstep;
            const char* a2 = last ? nA : cA + (size_t)(t + 2) * kstep; const char* b2 = last ? nB : cB + (size_t)(t + 2) * kstep;
            const char* a3 = a2 + kstep; const char* b3 = b2 + kstep;
            if (last && has_next) S.a_ready(nxt);
            if constexpr (SP2) {
            PG8_LDB(B0, 0, 0); PG8_LDB(B1, 0, 1); PG8_SCHED; PG8_LDA(At, 0, 0); PG8_STAGE(PG8_SA(1, 1), a1 + hstep, voffA);
            PG8_WAIT_V(8); PG8_WAIT_L(0); PG8_BAR; PG8_MMA(0, 0, At, B0); PG8_MMA(0, 1, At, B1); PG8_BAR; PG8_SCHED;
            PG8_LDA(At, 0, 1); PG8_STAGE(PG8_SB(0, 0), b2, voffB); PG8_STAGE(PG8_SB(0, 1), b2 + hstep, voffB); PG8_STAGE(PG8_SA(0, 0), a2, voffA);
            PG8_WAIT_V(8); PG8_WAIT_L(0); PG8_BAR; PG8_MMA(1, 0, At, B0); PG8_MMA(1, 1, At, B1); PG8_BAR; PG8_SCHED;
            PG8_LDB(B0, 1, 0); PG8_LDB(B1, 1, 1); PG8_SCHED; PG8_LDA(At, 1, 0); PG8_STAGE(PG8_SA(0, 1), a2 + hstep, voffA);
            PG8_WAIT_V(8); PG8_WAIT_L(0); PG8_BAR; PG8_MMA(0, 0, At, B0); PG8_MMA(0, 1, At, B1); PG8_BAR; PG8_SCHED;
            PG8_LDA(At, 1, 1); PG8_STAGE(PG8_SB(1, 0), b3, voffB); PG8_STAGE(PG8_SB(1, 1), b3 + hstep, voffB); PG8_STAGE(PG8_SA(1, 0), a3, voffA);
            PG8_WAIT_V(8); PG8_WAIT_L(0); PG8_BAR; PG8_MMA(1, 0, At, B0); PG8_MMA(1, 1, At, B1); PG8_BAR; PG8_SCHED;
            } else {
            PG8_LDB(B0, 0, 0); PG8_SCHED; PG8_LDA(At, 0, 0); PG8_STAGE(PG8_SA(1, 1), a1 + hstep, voffA);
            PG8_WAIT_L(8); PG8_BAR; PG8_WAIT_L(0); PG8_MMA(0, 0, At, B0); PG8_BAR; PG8_SCHED;
            PG8_LDB(B1, 0, 1); PG8_STAGE(PG8_SB(0, 0), b2, voffB);
            PG8_BAR; PG8_WAIT_L(0); PG8_MMA(0, 1, At, B1); PG8_BAR;
            PG8_LDA(At, 0, 1); PG8_STAGE(PG8_SA(0, 0), a2, voffA);
            PG8_BAR; PG8_WAIT_L(0); PG8_MMA(1, 0, At, B0); PG8_BAR; PG8_SCHED;
            PG8_STAGE(PG8_SB(0, 1), b2 + hstep, voffB);
            PG8_WAIT_V(6); PG8_BAR; PG8_MMA(1, 1, At, B1); PG8_BAR;
            PG8_LDB(B0, 1, 0); PG8_SCHED; PG8_LDA(At, 1, 0); PG8_STAGE(PG8_SA(0, 1), a2 + hstep, voffA);
            PG8_WAIT_L(8); PG8_BAR; PG8_WAIT_L(0); PG8_MMA(0, 0, At, B0); PG8_BAR; PG8_SCHED;
            PG8_LDB(B1, 1, 1); PG8_STAGE(PG8_SB(1, 0), b3, voffB);
            PG8_BAR; PG8_WAIT_L(0); PG8_MMA(0, 1, At, B1); PG8_BAR;
            PG8_LDA(At, 1, 1); PG8_STAGE(PG8_SA(1, 0), a3, voffA);
            PG8_BAR; PG8_WAIT_L(0); PG8_MMA(1, 0, At, B0); PG8_BAR; PG8_SCHED;
            PG8_STAGE(PG8_SB(1, 1), b3 + hstep, voffB);
            PG8_WAIT_V(6); PG8_BAR; PG8_MMA(1, 1, At, B1); PG8_BAR;
            }
        }
        if constexpr (ALIGN_EPI) { if (wr == 0) PG8_BAR; }
        if constexpr (!Epi::AFTER_DRAIN) { E(acc, cur, wr, wc, fr, fq); S.done(cur); }
        if (!has_next) break;
#pragma unroll
        for (int a = 0; a < 2; ++a)
#pragma unroll
            for (int b = 0; b < 2; ++b)
#pragma unroll
                for (int m = 0; m < 4; ++m)
#pragma unroll
                    for (int n = 0; n < 2; ++n) acc[a][b][m][n] = (f32x4){0.f, 0.f, 0.f, 0.f};
        cur = nxt; cA = nA; cB = nB; ++ui;
        if constexpr (ALIGN_EPI) { if (wr == 1) PG8_BAR; }
    }
    PG8_WAIT_V(0);
    if constexpr (!ALIGN_EPI) { if (wr == 0) PG8_BAR; }
    PG8_BAR;
    if constexpr (Epi::AFTER_DRAIN) { E.fused(acc, cur, wr, wc, fr, fq, lds, wid, lane); S.done(cur); }
#undef PG8_SA
#undef PG8_SB
#undef PG8_STAGE
#undef PG8_LDA
#undef PG8_LDB
#undef PG8_MMA
#undef PG8_WAIT_V
#undef PG8_WAIT_L
#undef PG8_BAR
#undef PG8_SCHED
}
}
namespace pg8 {
struct EpiSwiGLU {
    static constexpr bool PERM = true, AFTER_DRAIN = false;
    bf16_t* O; int ldc;
    __device__ __forceinline__ void operator()(const f32x4 (&acc)[2][2][4][2], const Unit& u, int wr, int wc, int fr, int fq) const {
        const int row0 = u.pm * BM + wr * 64 + fr; const int col0 = u.pn * HALF + wc * 32 + 8 * fq;
#pragma unroll
        for (int ai = 0; ai < 2; ++ai)
#pragma unroll
            for (int m = 0; m < 4; ++m) { bf16_t* rowp = O + (size_t)(row0 + ai * HALF + m * 16) * ldc + col0;
                float v[8];
#pragma unroll
                for (int n = 0; n < 2; ++n)
#pragma unroll
                    for (int i = 0; i < 4; ++i) { const float g = acc[ai][0][m][n][i], up = acc[ai][1][m][n][i];
                        const float sg = g * __builtin_amdgcn_rcpf(1.0f + __builtin_amdgcn_exp2f(-1.4426950408889634f * g)); v[4 * n + i] = sg * up; }
                u32x4 w; w.x = cvt_pk_bf16(v[0], v[1]); w.y = cvt_pk_bf16(v[2], v[3]); w.z = cvt_pk_bf16(v[4], v[5]); w.w = cvt_pk_bf16(v[6], v[7]);
                *(u32x4*)rowp = w; }
    }
};
struct EpiF32 {
    static constexpr bool PERM = true, AFTER_DRAIN = false;
    float* O; int ldc;
    __device__ __forceinline__ void operator()(const f32x4 (&acc)[2][2][4][2], const Unit& u, int wr, int wc, int fr, int fq) const {
        const int row0 = u.pm * BM + wr * 64 + fr; const int col0 = u.pn * BM + wc * 32 + 8 * fq;
#pragma unroll
        for (int ai = 0; ai < 2; ++ai)
#pragma unroll
            for (int m = 0; m < 4; ++m) { float* rowp = O + (size_t)(row0 + ai * HALF + m * 16) * ldc + col0;
#pragma unroll
                for (int bj = 0; bj < 2; ++bj) { *(f32x4*)(rowp + bj * HALF) = acc[ai][bj][m][0]; *(f32x4*)(rowp + bj * HALF + 4) = acc[ai][bj][m][1]; } }
    }
};
struct EpiGlu {
    static constexpr bool PERM = true, AFTER_DRAIN = false;
    bf16_t* O; int ldc; const bf16_t* ys; int ldy; const float* bias;
    __device__ __forceinline__ void operator()(const f32x4 (&acc)[2][2][4][2], const Unit& u, int wr, int wc, int fr, int fq) const {
        const int row0 = u.pm * BM + wr * 64 + fr; const int col0 = u.pn * BM + wc * 32 + 8 * fq;
#pragma unroll
        for (int ai = 0; ai < 2; ++ai)
#pragma unroll
            for (int m = 0; m < 4; ++m) { const int row = row0 + ai * HALF + m * 16;
#pragma unroll
                for (int bj = 0; bj < 2; ++bj) { const int col = col0 + bj * HALF;
                    const u32x4 yp = *(const u32x4*)(ys + (size_t)row * ldy + col);
                    const f32x4 b0 = *(const f32x4*)(bias + col), b1 = *(const f32x4*)(bias + col + 4);
                    const float yv[8] = {__uint_as_float(yp.x << 16), __uint_as_float(yp.x & 0xffff0000u), __uint_as_float(yp.y << 16), __uint_as_float(yp.y & 0xffff0000u),
                                         __uint_as_float(yp.z << 16), __uint_as_float(yp.z & 0xffff0000u), __uint_as_float(yp.w << 16), __uint_as_float(yp.w & 0xffff0000u)};
                    float v[8];
#pragma unroll
                    for (int i = 0; i < 4; ++i) { const float z0 = acc[ai][bj][m][0][i] + b0[i], z1 = acc[ai][bj][m][1][i] + b1[i];
                        v[i] = yv[i] * __builtin_amdgcn_rcpf(1.0f + __builtin_amdgcn_exp2f(-1.4426950408889634f * z0));
                        v[4 + i] = yv[4 + i] * __builtin_amdgcn_rcpf(1.0f + __builtin_amdgcn_exp2f(-1.4426950408889634f * z1)); }
                    u32x4 w; w.x = cvt_pk_bf16(v[0], v[1]); w.y = cvt_pk_bf16(v[2], v[3]); w.z = cvt_pk_bf16(v[4], v[5]); w.w = cvt_pk_bf16(v[6], v[7]);
                    *(u32x4*)(O + (size_t)row * ldc + col) = w; } }
    }
};
struct EpiBf16Plain {
    static constexpr bool PERM = true, AFTER_DRAIN = false;
    bf16_t* O; int ldc;
    __device__ __forceinline__ void operator()(const f32x4 (&acc)[2][2][4][2], const Unit& u, int wr, int wc, int fr, int fq) const {
        const int row0 = u.pm * BM + wr * 64 + fr; const int col0 = u.pn * BM + wc * 32 + 8 * fq;
#pragma unroll
        for (int ai = 0; ai < 2; ++ai)
#pragma unroll
            for (int m = 0; m < 4; ++m) { bf16_t* rowp = O + (size_t)(row0 + ai * HALF + m * 16) * ldc + col0;
#pragma unroll
                for (int bj = 0; bj < 2; ++bj) { const f32x4 v0 = acc[ai][bj][m][0], v1 = acc[ai][bj][m][1];
                    u32x4 w; w.x = cvt_pk_bf16(v0[0], v0[1]); w.y = cvt_pk_bf16(v0[2], v0[3]); w.z = cvt_pk_bf16(v1[0], v1[1]); w.w = cvt_pk_bf16(v1[2], v1[3]);
                    *(u32x4*)(rowp + bj * HALF) = w; } }
    }
};
struct GatedUnit {
    Unit un; unsigned* cnt; unsigned want;
    __device__ __forceinline__ bool next(int i, Unit& u) const { u = un; return i == 0; }
    __device__ __forceinline__ void a_ready(const Unit&) const {
        if (threadIdx.x == 0) { unsigned sp = 0;
            while (__hip_atomic_load(cnt, __ATOMIC_RELAXED, __HIP_MEMORY_SCOPE_AGENT) < want) { __builtin_amdgcn_s_sleep(2); if (++sp > (1u << 22)) break; }
            __builtin_amdgcn_fence(__ATOMIC_ACQUIRE, "agent"); asm volatile("s_waitcnt vmcnt(0)" ::: "memory"); }
        __syncthreads();
    }
    __device__ __forceinline__ void done(const Unit&) const {}
};
}
#include <hip/hip_cooperative_groups.h>
namespace cg = cooperative_groups;
#define LAS __attribute__((address_space(3)))
typedef unsigned short bf16;
typedef float f32x4 __attribute__((ext_vector_type(4)));
typedef float f32x16 __attribute__((ext_vector_type(16)));
typedef short bf16x8 __attribute__((ext_vector_type(8)));
typedef short s16x4 __attribute__((ext_vector_type(4)));
typedef unsigned u32x4 __attribute__((ext_vector_type(4)));
typedef unsigned u32x2 __attribute__((ext_vector_type(2)));
typedef float f32x2_t __attribute__((ext_vector_type(2)));
typedef __bf16 bf16x2_t __attribute__((ext_vector_type(2)));

constexpr int NB = 4, SEQ = 2048, DM = 2048, M = NB * SEQ, FF = 5632, INC = 5120, NLAYER = 2;
constexpr int C_SBQ = 0, C_SBK = 768, C_SBV = 1536, C_U = 2304, C_DQ = 2816, C_DK = 3584, C_DV = 4352;
constexpr int MIX_SB = 0, MIX_SSM = 768, MIX_DIFF = 1280;
constexpr float EPS = 1e-6f;
constexpr float LOG2E = 1.4426950408889634f;
constexpr int NTHREADS = 512, NWAVES = 8;
constexpr int LDS_BYTES = 148480;

constexpr size_t SZ_WGU = (size_t)2 * FF * DM * 2, SZ_WD = (size_t)DM * FF * 2, SZ_WIN = (size_t)INC * DM * 2, SZ_WOUT = (size_t)DM * DM * 2, SZ_WGLU = (size_t)512 * 512 * 2;
constexpr size_t LW_GU1 = 0, LW_D1 = LW_GU1 + SZ_WGU, LW_IN = LW_D1 + SZ_WD, LW_OUT = LW_IN + SZ_WIN, LW_GLU = LW_OUT + SZ_WOUT, LW_GU2 = LW_GLU + SZ_WGLU, LW_D2 = LW_GU2 + SZ_WGU, LW_SIZE = LW_D2 + SZ_WD;
constexpr size_t WS_W = 1u << 20;
constexpr size_t WS_XN = WS_W + NLAYER * LW_SIZE;
constexpr size_t WS_BIG = WS_XN + (size_t)M * DM * 2;
constexpr size_t WS_Y = WS_BIG + (size_t)M * FF * 2;
constexpr size_t WS_MIX = WS_Y + (size_t)M * DM * 4;
constexpr size_t WS_YS = WS_MIX + (size_t)M * DM * 2;
constexpr size_t WS_YSB = WS_YS + (size_t)M * 512 * 4;
constexpr size_t WS_END = WS_YSB + (size_t)M * 512 * 2;

struct Args { const float* in[31]; float* out; unsigned char* ws; };
typedef __attribute__((address_space(4))) const Args* KArgs;
__device__ __forceinline__ KArgs kargs_ptr() { KArgs ap = (KArgs)__builtin_amdgcn_kernarg_segment_ptr(); asm volatile("" : "+s"(ap)); return ap; }
#define IN(k) (kargs_ptr()->in[(k)])

__device__ const unsigned char T5B[128] = {0, 1, 2, 3, 4, 5, 6, 7, 8, 9, 10, 11, 12, 13, 14, 15, 16, 16, 16, 17, 17, 18, 18, 18, 19, 19, 19, 20, 20, 20, 20, 21, 21, 21, 21, 22, 22, 22, 22, 22, 23, 23, 23, 23, 23, 23, 24, 24, 24, 24, 24, 24, 25, 25, 25, 25, 25, 25, 25, 26, 26, 26, 26, 26, 26, 26, 26, 27, 27, 27, 27, 27, 27, 27, 27, 27, 27, 28, 28, 28, 28, 28, 28, 28, 28, 28, 28, 29, 29, 29, 29, 29, 29, 29, 29, 29, 29, 29, 29, 30, 30, 30, 30, 30, 30, 30, 30, 30, 30, 30, 30, 30, 30, 31, 31, 31, 31, 31, 31, 31, 31, 31, 31, 31, 31, 31, 31, 31};

#define LDS_WAIT() asm volatile("s_waitcnt lgkmcnt(0)" ::: "memory")
#define WAVE_SYNC() do { asm volatile("s_waitcnt lgkmcnt(0)" ::: "memory"); __builtin_amdgcn_wave_barrier(); } while (0)
#define MFMA32(a, b, c) __builtin_amdgcn_mfma_f32_32x32x16_bf16((a), (b), (c), 0, 0, 0)
__device__ __forceinline__ unsigned f2bf(float f) { unsigned u = __float_as_uint(f); return (u + 0x7fffu + ((u >> 16) & 1u)) >> 16; }
__device__ __forceinline__ unsigned pk2(float lo, float hi) { return f2bf(lo) | (f2bf(hi) << 16); }
__device__ __forceinline__ unsigned cvtpk(float lo, float hi) { f32x2_t v = {lo, hi}; bf16x2_t b = __builtin_convertvector(v, bf16x2_t); return __builtin_bit_cast(unsigned, b); }
__device__ __forceinline__ float bf2f(unsigned short b) { return __uint_as_float(((unsigned)b) << 16); }
__device__ __forceinline__ float wave_sum(float v) {
#pragma unroll
    for (int o = 1; o < 64; o <<= 1) v += __shfl_xor(v, o);
    return v;
}
__device__ __forceinline__ int crow(int i, int h) { return (i & 3) + 8 * (i >> 2) + 4 * h; }

#define XB_TMO      128
#define XB_XCNT(j)  (256  + 64 * (j))
#define XB_XSUB(j)  (1280 + 64 * (j))
#define XB_XGEN(j)  (2304 + 64 * (j))
#define XB_TOP      3328
#define XB_TOPGEN   3392
#define XCD_BAR_WORDS 3456
#define XB_SPIN_CAP (1u << 18)

__device__ __forceinline__ unsigned xb_ld(unsigned* p)              { return __hip_atomic_load(p, __ATOMIC_RELAXED, __HIP_MEMORY_SCOPE_AGENT); }
__device__ __forceinline__ unsigned xb_add(unsigned* p, unsigned v) { return __hip_atomic_fetch_add(p, v, __ATOMIC_RELAXED, __HIP_MEMORY_SCOPE_AGENT); }
__device__ __forceinline__ unsigned xb_xcc_id() { return (unsigned)__builtin_amdgcn_s_getreg((3 << 11) | 20) & 0xFu; }
#define XB_SPIN(cond, bar) do { unsigned _sp = 0; while (cond) { __builtin_amdgcn_s_sleep(1); \
    if ((++_sp & 255u) == 0u) { if (xb_ld(&(bar)[XB_TMO])) break; if (_sp > XB_SPIN_CAP) { atomicAdd(&(bar)[XB_TMO], 1u); break; } } } } while (0)

struct XcdBarrier {
    unsigned* bar; unsigned x;
    volatile LAS unsigned* st;
};

__device__ __forceinline__ XcdBarrier xcd_barrier_post(unsigned* bar, volatile LAS unsigned* st) {
    XcdBarrier b; b.bar = bar; b.x = xb_xcc_id(); b.st = st;
    if (threadIdx.x == 0) (void)xb_add(&bar[XB_XCNT(b.x)], 1u);
    return b;
}
__device__ __forceinline__ void xcd_barrier_complete(unsigned* bar, unsigned x, unsigned& nloc, unsigned& nx) {
    const unsigned G = gridDim.x * gridDim.y * gridDim.z;
    unsigned sum, cnt, mine, sp = 0u;
    for (;;) {
        sum = 0u; cnt = 0u; mine = 0u;
#pragma unroll
        for (unsigned j = 0; j < 16; ++j) { const unsigned c = xb_ld(&bar[XB_XCNT(j)]); sum += c; cnt += (c > 0u) ? 1u : 0u; mine = (j == x) ? c : mine; }
        if (sum == G) break;
        __builtin_amdgcn_s_sleep(1);
        if ((++sp & 255u) == 0u) { if (xb_ld(&bar[XB_TMO])) break; if (sp > XB_SPIN_CAP) { atomicAdd(&bar[XB_TMO], 1u); break; } }
    }
    nloc = mine > 0u ? mine : 1u; nx = cnt > 0u ? cnt : 1u;
}

__device__ __forceinline__ void xcd_barrier(const XcdBarrier& b) {
    asm volatile("s_waitcnt vmcnt(0)" ::: "memory");
    __syncthreads();
    if (threadIdx.x == 0) {
        unsigned* bar = b.bar;
        __builtin_amdgcn_s_waitcnt(0);
        unsigned nloc = b.st[0], nx = b.st[1];
        if (nloc == 0u) { xcd_barrier_complete(bar, b.x, nloc, nx); b.st[0] = nloc; b.st[1] = nx; }
        const unsigned old = xb_add(&bar[XB_XSUB(b.x)], 1u);
        const unsigned gen = old / nloc;
        if (old + 1u == (gen + 1u) * nloc) {
            __builtin_amdgcn_fence(__ATOMIC_RELEASE, "agent");
            asm volatile("s_waitcnt vmcnt(0)" ::: "memory");
            const unsigned og = xb_add(&bar[XB_TOP], 1u);
            const unsigned tg = og / nx;
            if (og + 1u == (tg + 1u) * nx) xb_add(&bar[XB_TOPGEN], 1u);
            else XB_SPIN(xb_ld(&bar[XB_TOPGEN]) == tg, bar);
            __builtin_amdgcn_fence(__ATOMIC_ACQUIRE, "agent");
            xb_add(&bar[XB_XGEN(b.x)], 1u);
            asm volatile("s_waitcnt vmcnt(0)" ::: "memory");
        } else {
            XB_SPIN(xb_ld(&bar[XB_XGEN(b.x)]) == gen, bar);
            __builtin_amdgcn_fence(__ATOMIC_ACQUIRE, "agent");
            asm volatile("s_waitcnt vmcnt(0)" ::: "memory");
        }
    }
    __syncthreads();
}

__device__ __forceinline__ void transpose_item(const float* __restrict__ W, int K, int N, bf16* WT, int mode, LAS float* scr, int item, int lane) {
    const int nblk = N / 32, kb = item / nblk, nb = item % nblk, k0 = 64 * kb, n0 = 32 * nb;
#pragma unroll 8
    for (int i = 0; i < 32; ++i) { const int kk = 2 * i + (lane >> 5); scr[kk * 33 + (lane & 31)] = __builtin_nontemporal_load(&W[(size_t)(k0 + kk) * N + n0 + (lane & 31)]); }
    LDS_WAIT();
    const int rb = mode == 0 ? n0 : ((n0 >> 7) * 256 + (n0 & 127) + (mode == 2 ? 128 : 0));
    const int c = lane & 7;
#pragma unroll
    for (int j = 0; j < 4; ++j) { const int n = (lane >> 3) + 8 * j; const LAS float* s = scr + (8 * c) * 33 + n;
        u32x4 o; o.x = pk2(s[0 * 33], s[1 * 33]); o.y = pk2(s[2 * 33], s[3 * 33]); o.z = pk2(s[4 * 33], s[5 * 33]); o.w = pk2(s[6 * 33], s[7 * 33]);
        *(u32x4*)(WT + (size_t)(rb + n) * K + k0 + 8 * c) = o; }
    LDS_WAIT();
}

__device__ __forceinline__ void row_pass(const bf16* Y, const float* Hin, float* Hout, bf16* XN, const float* gpost, float wres, const float* gpre, int gw, int ngw, int lane) {
    for (int m = gw; m < M; m += ngw) {
        f32x4 hv[8];
        const f32x4* hr = (const f32x4*)(Hin + (size_t)m * DM) + 2 * lane;
#pragma unroll
        for (int j = 0; j < 4; ++j) { hv[2 * j] = hr[128 * j]; hv[2 * j + 1] = hr[128 * j + 1]; }
        if (Y) {
            f32x4 yv[8]; const u32x4* yr = (const u32x4*)(Y + (size_t)m * DM) + lane; float ss = 0.f;
#pragma unroll
            for (int j = 0; j < 4; ++j) { const u32x4 p = yr[64 * j];
                yv[2 * j] = (f32x4){__uint_as_float(p.x << 16), __uint_as_float(p.x & 0xffff0000u), __uint_as_float(p.y << 16), __uint_as_float(p.y & 0xffff0000u)};
                yv[2 * j + 1] = (f32x4){__uint_as_float(p.z << 16), __uint_as_float(p.z & 0xffff0000u), __uint_as_float(p.w << 16), __uint_as_float(p.w & 0xffff0000u)}; }
#pragma unroll
            for (int j = 0; j < 8; ++j) ss += (yv[j].x * yv[j].x + yv[j].y * yv[j].y) + (yv[j].z * yv[j].z + yv[j].w * yv[j].w);
            ss = wave_sum(ss);
            const float rstd = wres / sqrtf(ss * (1.0f / DM) + EPS);
#pragma unroll
            for (int j = 0; j < 4; ++j) { const f32x4 g0 = ((const f32x4*)gpost)[2 * lane + 128 * j], g1 = ((const f32x4*)gpost)[2 * lane + 128 * j + 1];
                hv[2 * j] = hv[2 * j] + yv[2 * j] * g0 * rstd; hv[2 * j + 1] = hv[2 * j + 1] + yv[2 * j + 1] * g1 * rstd; }
        }
        if (Hout) { f32x4* ho = (f32x4*)(Hout + (size_t)m * DM) + 2 * lane;
#pragma unroll
            for (int j = 0; j < 4; ++j) { ho[128 * j] = hv[2 * j]; ho[128 * j + 1] = hv[2 * j + 1]; } }
        if (gpre) {
            float s2 = 0.f;
#pragma unroll
            for (int j = 0; j < 8; ++j) s2 += (hv[j].x * hv[j].x + hv[j].y * hv[j].y) + (hv[j].z * hv[j].z + hv[j].w * hv[j].w);
            s2 = wave_sum(s2);
            const float r2 = 1.0f / sqrtf(s2 * (1.0f / DM) + EPS);
            u32x4* xo = (u32x4*)(XN + (size_t)m * DM) + lane;
#pragma unroll
            for (int j = 0; j < 4; ++j) { const f32x4 g0 = ((const f32x4*)gpre)[2 * lane + 128 * j], g1 = ((const f32x4*)gpre)[2 * lane + 128 * j + 1];
                const f32x4 v0 = hv[2 * j] * g0 * r2, v1 = hv[2 * j + 1] * g1 * r2; u32x4 o; o.x = pk2(v0.x, v0.y); o.y = pk2(v0.z, v0.w); o.z = pk2(v1.x, v1.y); o.w = pk2(v1.z, v1.w); xo[64 * j] = o; }
        }
    }
}

constexpr int KP = 272, VP = 320;
constexpr int KBYTES = 64 * KP, VBYTES = 64 * VP;
constexpr int A_K = 0, A_V = 2 * KBYTES, A_BIAS = A_V + 2 * VBYTES, A_FLAG = A_BIAS + 1024, A_Q = A_FLAG + 1024, A_END = A_Q + 8 * 32 * KP;

__device__ __forceinline__ void tile_prefetch(u32x4 (&rg)[2], const bf16* g, int tid) {
#pragma unroll
    for (int i = 0; i < 2; ++i) { const int chunk = tid + 512 * i, row = chunk >> 4, ch = chunk & 15; rg[i] = *(const u32x4*)(g + (size_t)row * INC + ch * 8); }
}
__device__ __forceinline__ void tile_store(LAS char* dst, int pitch, const u32x4 (&rg)[2], int tid) {
#pragma unroll
    for (int i = 0; i < 2; ++i) { const int chunk = tid + 512 * i, row = chunk >> 4, ch = chunk & 15; *(LAS u32x4*)(dst + row * pitch + ch * 16) = rg[i]; }
}
__device__ __forceinline__ void pv_half(f32x16 (&o)[4], const LAS char* Vb, int kh, bf16x8 P0, bf16x8 P1, int lane) {
    const int h = lane >> 5, i16 = lane & 15, qq = i16 >> 2, p = i16 & 3, blk = (lane >> 4) & 1;
    const LAS char* vb = Vb + (32 * kh + 4 * h + qq) * VP + (16 * blk + 4 * p) * 2;
#pragma unroll
    for (int s2 = 0; s2 < 2; ++s2)
#pragma unroll
        for (int db = 0; db < 4; ++db) {
            const s16x4 lo = __builtin_bit_cast(s16x4, __builtin_amdgcn_ds_read_tr16_b64_v4i16((LAS s16x4*)(vb + (16 * s2) * VP + db * 64)));
            const s16x4 hi = __builtin_bit_cast(s16x4, __builtin_amdgcn_ds_read_tr16_b64_v4i16((LAS s16x4*)(vb + (16 * s2 + 8) * VP + db * 64)));
            const bf16x8 vf = __builtin_shufflevector(lo, hi, 0, 1, 2, 3, 4, 5, 6, 7);
            o[db] = MFMA32(vf, s2 == 0 ? P0 : P1, o[db]);
        }
}

__device__ __forceinline__ void sb_unit(LAS char* lds, const bf16* PROJ, bf16* MIX, int b, int hd, int qb) {
    int tid_o = threadIdx.x; asm volatile("" : "+v"(tid_o)); const int tid = tid_o, lane = tid & 63, r = lane & 31, h = lane >> 5, w = __builtin_amdgcn_readfirstlane(tid >> 6);
    const int q0 = qb * 256, qw = q0 + 32 * w, q = qw + r;
    const size_t rowb = (size_t)b * SEQ;
    const float SCALE = 0.08838834764831845f;
    bf16x8 qf[8];
    { const bf16* Qg = PROJ + (rowb + q) * INC + C_SBQ + hd * 128 + 8 * h;
#pragma unroll
      for (int s = 0; s < 8; ++s) qf[s] = *(const bf16x8*)(Qg + 16 * s); }
    const bf16* Kg = PROJ + rowb * INC + C_SBK + hd * 128; const bf16* Vg = PROJ + rowb * INC + C_SBV + hd * 128;
    f32x16 o[4];
#pragma unroll
    for (int d = 0; d < 4; ++d)
#pragma unroll
        for (int i = 0; i < 16; ++i) o[d][i] = 0.f;
    float R = 0.f; bool wdone = false;
    const int kt_hi = (q0 + 255) >> 6;
    volatile LAS int* flags = (volatile LAS int*)(lds + A_FLAG);
    u32x4 kr[2], vr[2];
    tile_prefetch(kr, Kg + (size_t)(kt_hi * 64) * INC, tid); tile_prefetch(vr, Vg + (size_t)(kt_hi * 64) * INC, tid);
    int it = 0;
    for (int kt = kt_hi; kt >= 0; --kt, ++it) {
        const int buf = it & 1;
        LAS char* Kb = lds + A_K + buf * KBYTES; LAS char* Vb = lds + A_V + buf * VBYTES;
        tile_store(Kb, KP, kr, tid); tile_store(Vb, VP, vr, tid);
        __syncthreads();
        if (it > 0) { int alld = 1;
#pragma unroll
            for (int ww = 0; ww < 8; ++ww) alld &= flags[((it - 1) & 1) * 8 + ww];
            if (alld) break; }
        if (kt > 0) { tile_prefetch(kr, Kg + (size_t)((kt - 1) * 64) * INC, tid); tile_prefetch(vr, Vg + (size_t)((kt - 1) * 64) * INC, tid); }
        const int k0 = kt * 64;
        if (k0 < qw + 31 && !wdone) {
#pragma unroll
            for (int kh = 1; kh >= 0; --kh) {
                f32x16 c;
#pragma unroll
                for (int i = 0; i < 16; ++i) c[i] = 0.f;
                const LAS char* kp = Kb + (32 * kh + r) * KP + 16 * h;
#pragma unroll
                for (int s = 0; s < 8; ++s) { const bf16x8 kf = *(const LAS bf16x8*)(kp + 32 * s); c = MFMA32(kf, qf[s], c); }
                const int keyb = k0 + 32 * kh + 4 * h;
                float lk[16], lb[16], gs[4], og[4];
#pragma unroll
                for (int i = 0; i < 16; ++i) { const int key = keyb + (i & 3) + 8 * (i >> 2); const float z = c[i] * SCALE;
                    const float e = __expf(-fabsf(z)); const float ls = fminf(z, 0.f) - __logf(1.0f + e);
                    lb[i] = ls; lk[i] = (key < q) ? (ls - z) : 0.f; }
#pragma unroll
                for (int g = 0; g < 4; ++g) { gs[g] = (lk[4 * g] + lk[4 * g + 1]) + (lk[4 * g + 2] + lk[4 * g + 3]); og[g] = __shfl_xor(gs[g], 32); }
                const float sg = (gs[0] + gs[1]) + (gs[2] + gs[3]), so = (og[0] + og[1]) + (og[2] + og[3]);
                float after[4];
                after[3] = (h ? 0.f : og[3]);
                after[2] = gs[3] + og[3] + (h ? 0.f : og[2]);
                after[1] = gs[3] + gs[2] + og[3] + og[2] + (h ? 0.f : og[1]);
                after[0] = gs[3] + gs[2] + gs[1] + og[3] + og[2] + og[1] + (h ? 0.f : og[0]);
                float wv[16];
#pragma unroll
                for (int g = 0; g < 4; ++g) { const float base = R + after[g];
                    const float s3 = 0.f, s2 = lk[4 * g + 3], s1 = s2 + lk[4 * g + 2], s0 = s1 + lk[4 * g + 1];
                    const float bt[4] = {s0, s1, s2, s3};
#pragma unroll
                    for (int j = 0; j < 4; ++j) { const int i = 4 * g + j; const int key = keyb + j + 8 * g;
                        wv[i] = (key < q) ? __expf(lb[i] + base + bt[j]) : 0.f; } }
                R += sg + so;
                u32x4 p0, p1;
                p0.x = cvtpk(wv[0], wv[1]); p0.y = cvtpk(wv[2], wv[3]); p0.z = cvtpk(wv[4], wv[5]); p0.w = cvtpk(wv[6], wv[7]);
                p1.x = cvtpk(wv[8], wv[9]); p1.y = cvtpk(wv[10], wv[11]); p1.z = cvtpk(wv[12], wv[13]); p1.w = cvtpk(wv[14], wv[15]);
                pv_half(o, Vb, kh, __builtin_bit_cast(bf16x8, p0), __builtin_bit_cast(bf16x8, p1), lane);
            }
            wdone = __all(R < -110.f);
        }
        if (lane == 0) flags[(it & 1) * 8 + w] = wdone ? 1 : 0;
    }
    bf16* Og = MIX + (rowb + q) * DM + MIX_SB + hd * 128 + 4 * h;
#pragma unroll
    for (int db = 0; db < 4; ++db)
#pragma unroll
        for (int g = 0; g < 4; ++g) { u32x2 ov; ov.x = cvtpk(o[db][4 * g], o[db][4 * g + 1]); ov.y = cvtpk(o[db][4 * g + 2], o[db][4 * g + 3]); *(u32x2*)(Og + 32 * db + 8 * g) = ov; }
    __syncthreads();
}

__device__ __forceinline__ f32x16 diff_qk(const LAS char* kp, const LAS char* qp) {
    f32x16 c;
#pragma unroll
    for (int i = 0; i < 16; ++i) c[i] = 0.f;
#pragma unroll
    for (int s = 0; s < 4; ++s) { const bf16x8 kf = *(const LAS bf16x8*)(kp + 32 * s); const bf16x8 qf = *(const LAS bf16x8*)(qp + 32 * s); c = MFMA32(kf, qf, c); }
    return c;
}
__device__ __forceinline__ void diff_sm(f32x16& c, bool far, float bfar, const LAS float* bt, int q, int keyb, float& m, float& l, f32x16 (&o)[4], bf16x8& P0, bf16x8& P1) {
    const float SC2 = 0.125f * LOG2E;
    if (far) {
#pragma unroll
        for (int i = 0; i < 16; ++i) c[i] = c[i] * SC2 + bfar;
    } else {
#pragma unroll
        for (int i = 0; i < 16; ++i) { const int key = keyb + (i & 3) + 8 * (i >> 2); const int n = q - key; const int ni = n < 0 ? 0 : (n > 128 ? 128 : n);
            c[i] = (n < 0) ? -INFINITY : (c[i] * SC2 + bt[ni]); }
    }
    float mx = fmaxf(fmaxf(c[0], c[1]), fmaxf(c[2], c[3]));
#pragma unroll
    for (int i = 4; i < 16; i += 4) mx = fmaxf(mx, fmaxf(fmaxf(c[i], c[i + 1]), fmaxf(c[i + 2], c[i + 3])));
    mx = fmaxf(mx, __shfl_xor(mx, 32));
    const float mnew = fmaxf(m, mx);
    if (__any(mx > m + 8.0f)) {
        const float sc = __builtin_amdgcn_exp2f(m - mnew); l *= sc;
#pragma unroll
        for (int d = 0; d < 4; ++d)
#pragma unroll
            for (int i = 0; i < 16; ++i) o[d][i] *= sc;
        m = mnew;
    }
    float a = 0.f;
#pragma unroll
    for (int i = 0; i < 16; ++i) { c[i] = __builtin_amdgcn_exp2f(c[i] - m); a += c[i]; }
    l += a;
    u32x4 p0, p1;
    p0.x = cvtpk(c[0], c[1]); p0.y = cvtpk(c[2], c[3]); p0.z = cvtpk(c[4], c[5]); p0.w = cvtpk(c[6], c[7]);
    p1.x = cvtpk(c[8], c[9]); p1.y = cvtpk(c[10], c[11]); p1.z = cvtpk(c[12], c[13]); p1.w = cvtpk(c[14], c[15]);
    P0 = __builtin_bit_cast(bf16x8, p0); P1 = __builtin_bit_cast(bf16x8, p1);
}
__device__ __forceinline__ void diff_unit(LAS char* lds, const bf16* PROJ, bf16* MIX, const float* relb, float lam, float outscale, const float* subg, int b, int hd, int qb) {
    int tid_o = threadIdx.x; asm volatile("" : "+v"(tid_o)); const int tid = tid_o, lane = tid & 63, r = lane & 31, h = lane >> 5, w = __builtin_amdgcn_readfirstlane(tid >> 6);
    const int rg = w & 3, kh = w >> 2;
    const int q0 = qb * 128, qw = q0 + 32 * rg, q = qw + r;
    const size_t rowb = (size_t)b * SEQ;
    LAS float* bt = (LAS float*)(lds + A_BIAS);
    if (tid < 129) { const int bucket = tid < 128 ? (int)T5B[tid] : 31; bt[tid] = relb[bucket * 6 + hd] * LOG2E; }
    LAS char* qp = lds + A_Q + w * (32 * KP) + r * KP + 16 * h;
    { const bf16* Qg = PROJ + (rowb + q) * INC + C_DQ + hd * 128 + 8 * h;
#pragma unroll
      for (int s = 0; s < 8; ++s) *(LAS u32x4*)(qp + 32 * s) = *(const u32x4*)(Qg + 16 * s); }
    const bf16* Kg = PROJ + rowb * INC + C_DK + hd * 128; const bf16* Vg = PROJ + rowb * INC + C_DV + hd * 128;
    float m1 = -1e30f, m2 = -1e30f, l1 = 0.f, l2 = 0.f;
    f32x16 o1[4], o2[4];
#pragma unroll
    for (int d = 0; d < 4; ++d)
#pragma unroll
        for (int i = 0; i < 16; ++i) { o1[d][i] = 0.f; o2[d][i] = 0.f; }
    const int nt = ((q0 + 127) >> 6) + 1;
    u32x4 kr[2], vr[2];
    tile_prefetch(kr, Kg, tid); tile_prefetch(vr, Vg, tid);
#pragma unroll 1
    for (int kt = 0; kt < nt; ++kt) {
        const int buf = kt & 1;
        LAS char* Kb = lds + A_K + buf * KBYTES; LAS char* Vb = lds + A_V + buf * VBYTES;
        tile_store(Kb, KP, kr, tid); tile_store(Vb, VP, vr, tid);
        __syncthreads();
        if (kt + 1 < nt) { tile_prefetch(kr, Kg + (size_t)((kt + 1) * 64) * INC, tid); tile_prefetch(vr, Vg + (size_t)((kt + 1) * 64) * INC, tid); }
        const int k0 = kt * 64;
        if (k0 + 32 * kh <= qw + 31) {
            const bool far = (qw - (k0 + 63)) >= 128; const float bfar = bt[128];
            const LAS char* kp = Kb + (32 * kh + r) * KP + 16 * h;
            const int keyb = k0 + 32 * kh + 4 * h;
            bf16x8 Pa, Pb, Pc, Pd;
            f32x16 c1 = diff_qk(kp, qp), c2 = diff_qk(kp + 128, qp + 128);
            diff_sm(c1, far, bfar, bt, q, keyb, m1, l1, o1, Pa, Pb);
            pv_half(o1, Vb, kh, Pa, Pb, lane);
            diff_sm(c2, far, bfar, bt, q, keyb, m2, l2, o2, Pc, Pd);
            pv_half(o2, Vb, kh, Pc, Pd, lane);
            __builtin_amdgcn_sched_barrier(0);
        }
    }
    l1 += __shfl_xor(l1, 32); l2 += __shfl_xor(l2, 32);
    __syncthreads();
    LAS float* EX = (LAS float*)(lds + rg * 16384) + lane;
    LAS float* ST = (LAS float*)(lds + 65536 + rg * 1024) + lane;
    if (kh == 1) { ST[0] = m1; ST[64] = l1; ST[128] = m2; ST[192] = l2;
#pragma unroll
        for (int d = 0; d < 4; ++d)
#pragma unroll
            for (int i = 0; i < 16; ++i) EX[(16 * d + i) * 64] = o1[d][i]; }
    __syncthreads();
    float f2a = 1.f, f2b = 0.f;
    if (kh == 0) {
        const float mb1 = ST[0], lb1 = ST[64], mb2 = ST[128], lb2 = ST[192];
        const float mn1 = fmaxf(m1, mb1), fa = __builtin_amdgcn_exp2f(m1 - mn1), fb = __builtin_amdgcn_exp2f(mb1 - mn1);
        l1 = l1 * fa + lb1 * fb;
#pragma unroll
        for (int d = 0; d < 4; ++d)
#pragma unroll
            for (int i = 0; i < 16; ++i) o1[d][i] = o1[d][i] * fa + EX[(16 * d + i) * 64] * fb;
        const float mn2 = fmaxf(m2, mb2); f2a = __builtin_amdgcn_exp2f(m2 - mn2); f2b = __builtin_amdgcn_exp2f(mb2 - mn2);
        l2 = l2 * f2a + lb2 * f2b;
    }
    __syncthreads();
    if (kh == 1) {
#pragma unroll
        for (int d = 0; d < 4; ++d)
#pragma unroll
            for (int i = 0; i < 16; ++i) EX[(16 * d + i) * 64] = o2[d][i]; }
    __syncthreads();
    if (kh == 0) {
        const float inv1 = 1.0f / l1, inv2 = lam / l2;
        float ss = 0.f;
#pragma unroll
        for (int db = 0; db < 4; ++db)
#pragma unroll
            for (int i = 0; i < 16; ++i) { const float v2 = o2[db][i] * f2a + EX[(16 * db + i) * 64] * f2b; const float v = o1[db][i] * inv1 - v2 * inv2; o1[db][i] = v; ss += v * v; }
        ss += __shfl_xor(ss, 32);
        const float rs = outscale / sqrtf(ss * (1.0f / 128.0f) + EPS);
        bf16* Og = MIX + (rowb + q) * DM + MIX_DIFF + hd * 128 + 4 * h;
#pragma unroll
        for (int db = 0; db < 4; ++db)
#pragma unroll
            for (int g = 0; g < 4; ++g) { const f32x4 gg = *(const f32x4*)(subg + 32 * db + 8 * g + 4 * h);
                u32x2 ov; ov.x = cvtpk(o1[db][4 * g] * rs * gg.x, o1[db][4 * g + 1] * rs * gg.y); ov.y = cvtpk(o1[db][4 * g + 2] * rs * gg.z, o1[db][4 * g + 3] * rs * gg.w); *(u32x2*)(Og + 32 * db + 8 * g) = ov; }
    }
    __syncthreads();
}

constexpr int S_E = 0, S_XT = 16384, S_XTB = 32 * KP;
__device__ __forceinline__ float gelu_tanh(float y) {
    const float a = 0.7978845608028654f * (y + 0.044715f * y * y * y);
    const float t = 1.0f - 2.0f / (__expf(2.0f * a) + 1.0f);
    return 0.5f * y * (1.0f + t);
}
#define SSM_BU(uf_) \
    f32x16 a_re, b_re, a_im, b_im; \
    { f32x16 z; _Pragma("unroll") for (int i = 0; i < 16; ++i) z[i] = 0.f; \
      a_re = MFMA32(uf_, bfrag[0], z); b_re = MFMA32(uf_, bfrag[1], z); a_im = MFMA32(uf_, bfrag[2], z); b_im = MFMA32(uf_, bfrag[3], z); \
      _Pragma("unroll") for (int i = 0; i < 16; ++i) { \
          auto s1 = __builtin_amdgcn_permlane32_swap(__float_as_uint(a_re[i]), __float_as_uint(b_re[i]), false, false); a_re[i] = __uint_as_float(s1[0]); b_re[i] = __uint_as_float(s1[1]); \
          auto s2 = __builtin_amdgcn_permlane32_swap(__float_as_uint(a_im[i]), __float_as_uint(b_im[i]), false, false); a_im[i] = __uint_as_float(s2[0]); b_im[i] = __uint_as_float(s2[1]); } }
#define SSM_ADV(bur_, bui_) do { const float nxr = lr * xr - li * xi + (bur_), nxi = lr * xi + li * xr + (bui_); xr = nxr; xi = nxi; } while (0)
__device__ __forceinline__ void ssm_unit(LAS char* lds, int l, const bf16* PROJ, bf16* YSB, int b, int g, unsigned* done_cnt) {
    int tid_o = threadIdx.x; asm volatile("" : "+v"(tid_o)); const int tid = tid_o, lane = tid & 63, r = lane & 31, h = lane >> 5, w = __builtin_amdgcn_readfirstlane(tid >> 6);
    const int lg = l * 32 + g;
    const size_t rowb = (size_t)b * SEQ;
    LAS float* E = (LAS float*)(lds + S_E);
    LAS char* XT = lds + S_XT + w * S_XTB;
    const int trow = 16 * ((r >> 2) & 1) + (r & 3) + 4 * (r >> 3);
    const float ar = IN(8)[lg * 64 + lane], ai = IN(9)[lg * 64 + lane], dt = expf(IN(10)[lg]);
    const float mag = expf(ar * dt); const float lr = mag * cosf(ai * dt), li = mag * sinf(ai * dt);
    const float den = ar * ar + ai * ai;
    const float fr = ((lr - 1.0f) * ar + li * ai) / den, fi = (li * ar - (lr - 1.0f) * ai) / den;
    bf16x8 bfrag[4];
    { float bbr[16], bbi[16], pbr[16], pbi[16];
      const f32x4* br4 = (const f32x4*)(IN(11) + ((size_t)lg * 64 + lane) * 16); const f32x4* bi4 = (const f32x4*)(IN(12) + ((size_t)lg * 64 + lane) * 16);
#pragma unroll
      for (int j = 0; j < 4; ++j) { const f32x4 br = br4[j], bi = bi4[j];
#pragma unroll
          for (int e = 0; e < 4; ++e) { bbr[4 * j + e] = fr * br[e] - fi * bi[e]; bbi[4 * j + e] = fr * bi[e] + fi * br[e]; } }
#pragma unroll
      for (int c = 0; c < 16; ++c) { pbr[c] = __shfl_xor(bbr[c], 32); pbi[c] = __shfl_xor(bbi[c], 32); }
#pragma unroll
      for (int nb = 0; nb < 4; ++nb) { const bool own = ((nb & 1) == h); float v[8];
#pragma unroll
          for (int j = 0; j < 8; ++j) { const float o_ = (nb < 2) ? (h ? bbr[8 + j] : bbr[j]) : (h ? bbi[8 + j] : bbi[j]); const float p_ = (nb < 2) ? (h ? pbr[8 + j] : pbr[j]) : (h ? pbi[8 + j] : pbi[j]); v[j] = own ? o_ : p_; }
          u32x4 pk; pk.x = cvtpk(v[0], v[1]); pk.y = cvtpk(v[2], v[3]); pk.z = cvtpk(v[4], v[5]); pk.w = cvtpk(v[6], v[7]); bfrag[nb] = __builtin_bit_cast(bf16x8, pk); } }
    bf16x8 cmf[9];
#pragma unroll
    for (int s = 0; s < 8; ++s) { u32x4 pk = {0u, 0u, 0u, 0u};
        if (r < 16) { const float* src = (s < 4 ? IN(13) : IN(14)) + ((size_t)lg * 16 + r) * 64 + 16 * (s & 3) + 8 * h; const float sg = s < 4 ? 1.0f : -1.0f;
            const f32x4 a = *(const f32x4*)src * sg, c = *(const f32x4*)(src + 4) * sg;
            pk.x = cvtpk(a.x, a.y); pk.y = cvtpk(a.z, a.w); pk.z = cvtpk(c.x, c.y); pk.w = cvtpk(c.z, c.w); }
        cmf[s] = __builtin_bit_cast(bf16x8, pk); }
    { const float dsk = IN(15)[lg * 16 + (r & 15)]; float v[8];
#pragma unroll
      for (int j = 0; j < 8; ++j) v[j] = (r < 16 && (8 * h + j) == r) ? dsk : 0.f;
      u32x4 pk; pk.x = cvtpk(v[0], v[1]); pk.y = cvtpk(v[2], v[3]); pk.z = cvtpk(v[4], v[5]); pk.w = cvtpk(v[6], v[7]); cmf[8] = __builtin_bit_cast(bf16x8, pk); }
    float l64r = lr, l64i = li;
#pragma unroll
    for (int s = 0; s < 6; ++s) { const float nr = l64r * l64r - l64i * l64i, ni = 2.0f * l64r * l64i; l64r = nr; l64i = ni; }
#define SSM_UADDR(bi_) (PROJ + (rowb + 64 * (w + 8 * ((bi_) >> 1)) + 32 * ((bi_) & 1) + trow) * INC + C_U + g * 16 + 8 * h)
    {
        bf16x8 ufc = *(const bf16x8*)SSM_UADDR(0);
        float xr = 0.f, xi = 0.f;
#pragma unroll 1
        for (int bi = 0; bi < 8; ++bi) {
            const bf16x8 ufn = *(const bf16x8*)SSM_UADDR(bi < 7 ? bi + 1 : 7);
            SSM_BU(ufc)
#pragma unroll
            for (int i = 0; i < 16; ++i) SSM_ADV(a_re[i], a_im[i]);
#pragma unroll
            for (int i = 0; i < 16; ++i) SSM_ADV(b_re[i], b_im[i]);
            if (bi & 1) { const int k = w + 8 * (bi >> 1); E[k * 128 + lane] = xr; E[k * 128 + 64 + lane] = xi; xr = 0.f; xi = 0.f; }
            ufc = ufn;
        }
    }
    __syncthreads();
    LAS char* xw = XT + 2 * lane;
    const LAS char* xrd = XT + r * KP + 16 * h;
    {
        float cr = 0.f, ci = 0.f;
#pragma unroll 1
        for (int k = 0; k < w; ++k) { const float er = E[k * 128 + lane], ei = E[k * 128 + 64 + lane]; const float nr = l64r * cr - l64i * ci + er, ni = l64r * ci + l64i * cr + ei; cr = nr; ci = ni; }
        bf16x8 ufc = *(const bf16x8*)SSM_UADDR(0);
        float xr = cr, xi = ci;
#pragma unroll 1
        for (int bi = 0; bi < 8; ++bi) {
            const bf16x8 ufn = *(const bf16x8*)SSM_UADDR(bi < 7 ? bi + 1 : 7);
            const size_t row0 = rowb + 64 * (w + 8 * (bi >> 1)) + 32 * (bi & 1);
            { SSM_BU(ufc)
#pragma unroll
              for (int i = 0; i < 16; ++i) { SSM_ADV(a_re[i], a_im[i]); const unsigned pk = cvtpk(xr, xi); const int rho = 8 * (i >> 2) + (i & 3);
                  *(LAS unsigned short*)(xw + rho * KP) = (unsigned short)pk; *(LAS unsigned short*)(xw + rho * KP + 128) = (unsigned short)(pk >> 16); }
#pragma unroll
              for (int i = 0; i < 16; ++i) { SSM_ADV(b_re[i], b_im[i]); const unsigned pk = cvtpk(xr, xi); const int rho = 8 * (i >> 2) + 4 + (i & 3);
                  *(LAS unsigned short*)(xw + rho * KP) = (unsigned short)pk; *(LAS unsigned short*)(xw + rho * KP + 128) = (unsigned short)(pk >> 16); } }
            WAVE_SYNC();
            f32x16 y;
#pragma unroll
            for (int i = 0; i < 16; ++i) y[i] = 0.f;
            y = MFMA32(cmf[8], ufc, y);
#pragma unroll
            for (int s = 0; s < 8; ++s) { const bf16x8 xa = *(const LAS bf16x8*)(xrd + 32 * s); y = MFMA32(cmf[s], xa, y); }
            {
                bf16* yo = YSB + (row0 + trow) * 512 + g * 16 + 4 * h;
                u32x2 w0, w1;
                w0.x = pk2(gelu_tanh(y[0]), gelu_tanh(y[1])); w0.y = pk2(gelu_tanh(y[2]), gelu_tanh(y[3]));
                w1.x = pk2(gelu_tanh(y[4]), gelu_tanh(y[5])); w1.y = pk2(gelu_tanh(y[6]), gelu_tanh(y[7]));
                *(u32x2*)yo = w0; *(u32x2*)(yo + 8) = w1;
            }
            WAVE_SYNC();
            if ((bi & 1) && bi < 7) {
                const int k0c = w + 8 * (bi >> 1);
#pragma unroll 1
                for (int k = k0c; k < k0c + 8; ++k) { const float er = E[k * 128 + lane], ei = E[k * 128 + 64 + lane]; const float nr = l64r * cr - l64i * ci + er, ni = l64r * ci + l64i * cr + ei; cr = nr; ci = ni; }
                xr = cr; xi = ci;
            }
            ufc = ufn;
        }
    }
    asm volatile("s_waitcnt vmcnt(0)" ::: "memory");
    __syncthreads();
    if (tid == 0) { __builtin_amdgcn_fence(__ATOMIC_RELEASE, "agent"); asm volatile("s_waitcnt vmcnt(0)" ::: "memory"); __hip_atomic_fetch_add(done_cnt, 1u, __ATOMIC_RELAXED, __HIP_MEMORY_SCOPE_AGENT); }
}
#undef SSM_UADDR
#undef SSM_BU
#undef SSM_ADV
constexpr int I_G = (DM / 64) * (FF / 32), I_D = (FF / 64) * (DM / 32), I_IN = (DM / 64) * (INC / 32), I_OUT = (DM / 64) * (DM / 32), I_GLU = (512 / 64) * (512 / 32);
constexpr int CV_PER_LAYER = 4 * I_G + 2 * I_D + I_IN + I_OUT + I_GLU, CV_TOTAL = NLAYER * CV_PER_LAYER;
static_assert(CV_TOTAL % 8 == 0 && (2 * I_G) % 8 == 0, "batches of 8");
__device__ __forceinline__ void convert_item(int it, unsigned char* wsb, LAS float* scr, int lane) {
    const int l = it / CV_PER_LAYER; int r = it % CV_PER_LAYER;
    unsigned char* lw0 = wsb + WS_W + (size_t)l * LW_SIZE;
    if (r < I_G) { transpose_item(IN(2) + (size_t)l * DM * FF, DM, FF, (bf16*)(lw0 + LW_GU1), 1, scr, r, lane); return; } r -= I_G;
    if (r < I_G) { transpose_item(IN(3) + (size_t)l * DM * FF, DM, FF, (bf16*)(lw0 + LW_GU1), 2, scr, r, lane); return; } r -= I_G;
    if (r < I_D) { transpose_item(IN(4) + (size_t)l * FF * DM, FF, DM, (bf16*)(lw0 + LW_D1), 0, scr, r, lane); return; } r -= I_D;
    if (r < I_IN) { transpose_item(IN(7) + (size_t)l * DM * INC, DM, INC, (bf16*)(lw0 + LW_IN), 0, scr, r, lane); return; } r -= I_IN;
    if (r < I_OUT) { transpose_item(IN(24) + (size_t)l * DM * DM, DM, DM, (bf16*)(lw0 + LW_OUT), 0, scr, r, lane); return; } r -= I_OUT;
    if (r < I_GLU) { transpose_item(IN(16) + (size_t)l * 512 * 512, 512, 512, (bf16*)(lw0 + LW_GLU), 0, scr, r, lane); return; } r -= I_GLU;
    if (r < I_G) { transpose_item(IN(27) + (size_t)l * DM * FF, DM, FF, (bf16*)(lw0 + LW_GU2), 1, scr, r, lane); return; } r -= I_G;
    if (r < I_G) { transpose_item(IN(28) + (size_t)l * DM * FF, DM, FF, (bf16*)(lw0 + LW_GU2), 2, scr, r, lane); return; } r -= I_G;
    transpose_item(IN(29) + (size_t)l * FF * DM, FF, DM, (bf16*)(lw0 + LW_D2), 0, scr, r, lane);
}
__device__ __forceinline__ void convert_static(int start, int end, int b0, int nb, unsigned char* wsb, LAS unsigned char* lds) {
    const int ib = (int)blockIdx.x - b0; if (ib < 0 || ib >= nb) return;
    int tid_o = threadIdx.x; asm volatile("" : "+v"(tid_o)); const int lane = tid_o & 63, wave = __builtin_amdgcn_readfirstlane(tid_o >> 6);
    LAS float* scr = (LAS float*)(lds + wave * 16384);
#pragma unroll 1
    for (int it = start + ib * NWAVES + wave; it < end; it += nb * NWAVES) convert_item(it, wsb, scr, lane);
}
__device__ __forceinline__ void convert_batch64(int c0, unsigned char* wsb, LAS unsigned char* lds) {
    int tid_o = threadIdx.x; asm volatile("" : "+v"(tid_o)); const int lane = tid_o & 63, wave = __builtin_amdgcn_readfirstlane(tid_o >> 6);
    LAS float* scr = (LAS float*)(lds + wave * 16384);
#pragma unroll 1
    for (int j = 0; j < 8; ++j) convert_item(c0 + 8 * wave + j, wsb, scr, lane);
}
#ifndef CV_UPFRONT
#define CV_UPFRONT 1
#endif
#if CV_UPFRONT
constexpr int CV_P0_END = CV_TOTAL, CV_A_END = CV_TOTAL, CV_B_END = CV_TOTAL, CV_M_END = CV_TOTAL, CV_MB = 0;
#else
constexpr int CV_P0_END = 2 * I_G;
constexpr int CV_A_END = 4 * I_G + I_D + I_IN + I_OUT + I_GLU - 2 * I_G + 2048;
constexpr int CV_B_END = CV_PER_LAYER;
constexpr int CV_M_END = CV_PER_LAYER + 2 * I_G + I_D + I_IN + I_OUT + I_GLU;
constexpr int CV_MB = (CV_M_END - CV_B_END) / 64;
#endif
static_assert((CV_M_END - CV_B_END) % 64 == 0, "mixer-phase conversion batches");
#ifndef PHASE_MASK
#define PHASE_MASK 0xFFFF
#endif
#define PH(k) if constexpr (((PHASE_MASK) >> (k)) & 1)
#ifndef MK_SYNC
#define MK_SYNC() do { XcdBarrier xb_; xb_.bar = (unsigned*)ws + 1024; xb_.x = xb_xcc_id(); xb_.st = (volatile LAS unsigned*)(lds + LDS_BYTES - 32); xcd_barrier(xb_); } while (0)
#endif
#ifndef CV_P0_LIM
#define CV_P0_LIM (2 * I_G)
#endif
#ifndef CV_LIM_GU1
#define CV_LIM_GU1 32000
#endif
#ifndef CV_LIM_WIN
#define CV_LIM_WIN 52000
#endif
#ifndef CV_LIM_MIX
#define CV_LIM_MIX 64000
#endif
__global__ void __launch_bounds__(NTHREADS, 2) fwd_megakernel(Args args) {
    extern __shared__ __attribute__((aligned(16))) unsigned char lds_raw[];
    cg::grid_group grid = cg::this_grid();
    LAS unsigned char* lds = (LAS unsigned char*)lds_raw;
    const int G = gridDim.x, bid = blockIdx.x, ngw = G * NWAVES;
    if (threadIdx.x < 2) ((volatile LAS unsigned*)(lds + LDS_BYTES - 32))[threadIdx.x] = 0u;
    __syncthreads();
    (void)xcd_barrier_post((unsigned*)(kargs_ptr()->ws) + 1024, (volatile LAS unsigned*)(lds + LDS_BYTES - 32));
#define LANE_SETUP() int tid_o = threadIdx.x; asm volatile("" : "+v"(tid_o)); const int lane = tid_o & 63, wave = __builtin_amdgcn_readfirstlane(tid_o >> 6), gw = bid * NWAVES + wave; (void)gw; (void)lane
#define ws (kargs_ptr()->ws)
#define XN ((bf16*)(ws + WS_XN))
#define BIG ((bf16*)(ws + WS_BIG))
#define Y ((bf16*)(ws + WS_Y))
#define MIX ((bf16*)(ws + WS_MIX))
#define YS ((float*)(ws + WS_YS))
#define YSB ((bf16*)(ws + WS_YSB))
#define H (kargs_ptr()->out)

    { convert_static(0, CV_P0_END, 0, G, ws, lds);
      PH(0) { LANE_SETUP();
        row_pass(nullptr, IN(0), nullptr, XN, nullptr, 0.f, IN(1), gw, ngw, lane); }
    }
    if (__builtin_expect(kargs_ptr()->out == nullptr, 0)) grid.sync();
    MK_SYNC();

#pragma unroll 1
    for (int l = 0; l < NLAYER; ++l) {
#define lw (ws + WS_W + (size_t)l * LW_SIZE)
#pragma unroll 1
        for (int f = 0; f < 2; ++f) {
            PH(1) { pg8::Gemm g{XN, (const bf16*)(lw + (f ? LW_GU2 : LW_GU1)), M, 2 * FF, DM}; pg8::StaticOrder S; S.init(M, 2 * FF, G, bid);
              pg8::EpiSwiGLU E{BIG, FF};
              pg8::gemm_phase<pg8::EpiSwiGLU, pg8::StaticOrder, true, true>(lds, g, S, E); }
            MK_SYNC();
            PH(2) { pg8::Gemm g{BIG, (const bf16*)(lw + (f ? LW_D2 : LW_D1)), M, DM, FF}; pg8::StaticOrder S; S.init(M, DM, G, bid);
              pg8::EpiBf16Plain E{Y, DM};
              pg8::gemm_phase<pg8::EpiBf16Plain, pg8::StaticOrder, true, true>(lds, g, S, E); }
            MK_SYNC();
            PH(3) { LANE_SETUP(); const float* gpost = (f ? IN(30) : IN(5)) + (size_t)l * DM;
              const float* gpre = f == 0 ? IN(6) + (size_t)l * DM : (l + 1 < NLAYER ? IN(1) + (size_t)(l + 1) * DM : nullptr);
              row_pass(Y, (l == 0 && f == 0) ? IN(0) : (const float*)H, H, XN, gpost, 0.5f, gpre, gw, ngw, lane); }
            if (f == 1) break;
            MK_SYNC();
            PH(4) { pg8::Gemm g{XN, (const bf16*)(lw + LW_IN), M, INC, DM}; pg8::StaticOrder S; S.init(M, INC, G, bid);
              pg8::EpiBf16Plain E{BIG, INC};
              pg8::gemm_phase<pg8::EpiBf16Plain, pg8::StaticOrder, true, true>(lds, g, S, E); }
            MK_SYNC();
#ifndef MIX_REPS
#define MIX_REPS 1
#endif
            {
                LANE_SETUP();
                const float lambda_init = 0.8f - 0.6f * expf(-0.3f * (float)l);
                const float d1 = wave_sum(IN(18)[l * 64 + lane] * IN(19)[l * 64 + lane]);
                const float d2 = wave_sum(IN(20)[l * 64 + lane] * IN(21)[l * 64 + lane]);
                const float lam = expf(d1) - expf(d2) + lambda_init;
                volatile LAS int* slot = (volatile LAS int*)(lds + LDS_BYTES - 64);
                const unsigned myx = xb_xcc_id() & 7u;
#pragma unroll 1
                for (unsigned xo = 0; xo < 8; ++xo) {
                    const int x = (int)((myx + xo) & 7u);
                    unsigned* ctr = (unsigned*)ws + 64 * (l * 8 + x);
                    for (;;) {
                        if (tid_o == 0) *slot = (int)atomicAdd(ctr, 1u);
                        __syncthreads();
                        const int item = *slot;
                        __syncthreads();
                        if (item >= 64) break;
                        if (item < 24 || item >= 40) { PH(5) { const int di = item < 24 ? item : item - 16; const int qb = 15 - (di / 3), bh = 8 * (di % 3) + x;
                            diff_unit((LAS char*)lds, BIG, MIX, IN(23), lam, 1.0f - lambda_init, IN(22) + (size_t)l * 128, bh / 6, bh % 6, qb); } }
                        else { PH(6) { const int u = 8 * (item - 24) + x; ssm_unit((LAS char*)lds, l, BIG, YSB, u / 32, u % 32, (unsigned*)ws + 6144 + 64 * (l * 4 + u / 32)); } }
                    }
                }
            }
            PH(8) { int tid_o = threadIdx.x; asm volatile("" : "+v"(tid_o));
                volatile LAS int* slot = (volatile LAS int*)(lds + LDS_BYTES - 64);
                unsigned* ctr = (unsigned*)ws + 5632 + 64 * l;
                for (;;) {
                    if (tid_o == 0) *slot = (int)atomicAdd(ctr, 1u);
                    __syncthreads();
                    const int item = *slot;
                    __syncthreads();
                    if (item >= 64) break;
                    pg8::Gemm g{YSB, (const bf16*)(lw + LW_GLU), M, 512, 512};
                    pg8::GatedUnit S1{pg8::Unit{item >> 1, item & 1}, (unsigned*)ws + 6144 + 64 * (l * 4 + (item >> 4)), 32u};
                    pg8::EpiGlu E{MIX + MIX_SSM, DM, YSB, 512, IN(17) + (size_t)l * 512};
                    pg8::gemm_phase<pg8::EpiGlu, pg8::GatedUnit, true, true>(lds, g, S1, E);
                    __syncthreads();
                }
            }
            PH(7) { int tid_o = threadIdx.x; asm volatile("" : "+v"(tid_o));
                volatile LAS int* slot = (volatile LAS int*)(lds + LDS_BYTES - 64);
                const unsigned myx = xb_xcc_id() & 7u;
#pragma unroll 1
                for (unsigned xo = 0; xo < 8; ++xo) {
                    const int x = (int)((myx + xo) & 7u);
                    unsigned* ctr = (unsigned*)ws + 4608 + 64 * (l * 8 + x);
                    for (;;) {
                        if (tid_o == 0) *slot = (int)atomicAdd(ctr, 1u);
                        __syncthreads();
                        const int item = *slot;
                        __syncthreads();
                        if (item >= 24) break;
                        const int qb = 7 - (item / 3), bh = 8 * (item % 3) + x; sb_unit((LAS char*)lds, BIG, MIX, bh / 6, bh % 6, qb);
                    }
                }
            }
            MK_SYNC();
            PH(9) { pg8::Gemm g{MIX, (const bf16*)(lw + LW_OUT), M, DM, DM}; pg8::StaticOrder S; S.init(M, DM, G, bid);
              pg8::EpiBf16Plain E{Y, DM};
              pg8::gemm_phase<pg8::EpiBf16Plain, pg8::StaticOrder, true, true>(lds, g, S, E); }
            MK_SYNC();
            PH(3) { LANE_SETUP(); row_pass(Y, H, H, XN, IN(25) + (size_t)l * DM, 1.0f, IN(26) + (size_t)l * DM, gw, ngw, lane); }
            MK_SYNC();
        }
        if (l + 1 < NLAYER) MK_SYNC();
    }
}

#undef ws
#undef XN
#undef BIG
#undef Y
#undef MIX
#undef YS
#undef YSB
#undef H
#undef lw
extern "C" void kernel_launch(void* const* d_in, const int* in_sizes, int n_in, void* d_out, int out_size, void* d_ws, size_t ws_size, hipStream_t stream) {
    static int grid = 0;
    if (grid == 0) {
        if (n_in != 31 || out_size != M * DM || ws_size < WS_END) { fprintf(stderr, "kernel_launch: unexpected shapes (n_in %d, out %d, ws %zu < %zu)\n", n_in, out_size, ws_size, (size_t)WS_END); grid = -1; return; }
        int dev = 0, cus = 0, per_cu = 0;
        hipGetDevice(&dev); hipDeviceGetAttribute(&cus, hipDeviceAttributeMultiprocessorCount, dev);
        if (hipFuncSetAttribute((const void*)fwd_megakernel, hipFuncAttributeMaxDynamicSharedMemorySize, LDS_BYTES) != hipSuccess) { fprintf(stderr, "kernel_launch: hipFuncSetAttribute failed\n"); grid = -1; return; }
        hipOccupancyMaxActiveBlocksPerMultiprocessor(&per_cu, (const void*)fwd_megakernel, NTHREADS, LDS_BYTES);
        if (per_cu < 1) { fprintf(stderr, "kernel_launch: occupancy query says %d blocks per CU\n", per_cu); per_cu = 1; }
        (void)hipGetLastError();
        grid = cus * 1;
    }
    if (grid < 0) return;
    if (hipMemsetAsync(d_ws, 0, 65536, stream) != hipSuccess) { fprintf(stderr, "kernel_launch: memset failed\n"); return; }
    Args a{};
    for (int i = 0; i < 31; ++i) a.in[i] = (const float*)d_in[i];
    a.out = (float*)d_out; a.ws = (unsigned char*)d_ws;
    void* kargs[] = {&a};
    hipError_t e = hipLaunchCooperativeKernel((const void*)fwd_megakernel, dim3(grid), dim3(NTHREADS), kargs, LDS_BYTES, stream);
    if (e != hipSuccess) fprintf(stderr, "kernel_launch: cooperative launch failed: %s (grid %d)\n", hipGetErrorString(e), grid);
}
```

```cpp
#include <hip/hip_runtime.h>
#include <cstdio>
#include <cstdint>
namespace pg8 {
#define PG8_LAS __attribute__((address_space(3)))
typedef unsigned short bf16_t;
typedef short bf16x8 __attribute__((ext_vector_type(8)));
typedef float f32x4 __attribute__((ext_vector_type(4)));
typedef unsigned u32x4 __attribute__((ext_vector_type(4)));
constexpr int BM = 256, BK = 64, HALF = 128, HTB = HALF * BK * 2  , STAGE_BYTES = 8 * HTB, NXCD = 8, WGM = 8;

__host__ __device__ __forceinline__ int lds_byte(int r, int c) { const int st = (r >> 4) * 2 + (c >> 5), rr = r & 15, cc = c & 31, ob = rr * 64 + cc * 2; return st * 1024 + (ob ^ (((ob >> 9) & 1) << 5)); }
__host__ __device__ __forceinline__ void stage_rc(int b, int& R, int& C) { const int st = b / 1024, sb = b % 1024, swz = sb ^ (((sb >> 9) & 1) << 5); R = (st >> 1) * 16 + swz / 64; C = (st & 1) * 32 + (swz % 64) / 2; }
__host__ __device__ __forceinline__ int perm32(int rho) { const int n = rho >> 4, i = rho & 15; return 8 * (i >> 2) + 4 * n + (i & 3); }

struct Unit { int pm, pn; };
struct Gemm { const bf16_t* A; const bf16_t* Bt; int M, N, K; };

struct StaticOrder {
    int nM, nN, nwg, G, c;
    __host__ __device__ void init(int M, int N, int G_, int c_) { nM = M / BM; nN = N / BM; nwg = nM * nN; G = G_; c = c_; }
    __host__ __device__ bool next(int i, Unit& u) const {
        const long L = (long)i * G + c; if (L >= nwg) return false;
        int wgid = (int)L; { const int q = nwg / NXCD, r = nwg % NXCD, xcd = wgid % NXCD, off = wgid / NXCD; wgid = (xcd < r ? xcd * (q + 1) : r * (q + 1) + (xcd - r) * q) + off; }
        const int nig = WGM * nN, gid = wgid / nig, fm = gid * WGM, gsz = (nM - fm) < WGM ? (nM - fm) : WGM;
        u.pm = fm + ((wgid % nig) % gsz); u.pn = (wgid % nig) / gsz; return true;
    }
    __device__ __forceinline__ void a_ready(const Unit&) const {}
    __device__ __forceinline__ void done(const Unit&) const {}
};

__device__ __forceinline__ unsigned cvt_pk_bf16(float lo, float hi) { unsigned r; asm volatile("v_cvt_pk_bf16_f32 %0, %1, %2" : "=v"(r) : "v"(lo), "v"(hi)); return r; }
typedef float f32x2 __attribute__((ext_vector_type(2)));
__device__ __forceinline__ f32x2 gelu_pk(f32x2 v) {
    const f32x2 av = __builtin_elementwise_abs(v), d = av * 0.2316418882f + 1.0f;
    f32x2 t; t.x = __builtin_amdgcn_rcpf(d.x); t.y = __builtin_amdgcn_rcpf(d.y);
    f32x2 q = t * 0.5307027145f + (-0.7265760135f); q = q * t + 0.7107068705f; q = q * t + (-0.142248368f); q = q * t + 0.127414796f; q = q * t;
    const f32x2 s = (v * v) * (-0.72134752044f);
    f32x2 e; e.x = __builtin_amdgcn_exp2f(s.x); e.y = __builtin_amdgcn_exp2f(s.y);
    const f32x2 m = v * (q * e), r = v - m;
    f32x2 o; o.x = v.x < 0.f ? m.x : r.x; o.y = v.y < 0.f ? m.y : r.y; return o;
}

template <int ACT  > struct EpiBf16 {
    static constexpr bool PERM = true, AFTER_DRAIN = false; static_assert(ACT == 0 || ACT == 1, "EpiBf16: ACT is 0 (none) or 1 (gelu_pk)");
    bf16_t* O; int ldc; const float* bias; int split_cols; size_t split_stride; float scale0;
    __device__ __forceinline__ void operator()(const f32x4 (&acc)[2][2][4][2], const Unit& u, int wr, int wc, int fr, int fq) const {
        const int row0 = u.pm * BM + wr * 64 + fr; int colt = u.pn * BM; bf16_t* base = O;
        float sc = 1.f; if (split_cols) { const int t = colt / split_cols; base += (size_t)t * split_stride; colt -= t * split_cols; if (t == 0) sc = scale0; }
        const int col0 = colt + wc * 32 + 8 * fq, bcol0 = u.pn * BM + wc * 32 + 8 * fq;
        f32x4 bv[2][2];
#pragma unroll
        for (int bj = 0; bj < 2; ++bj)
#pragma unroll
            for (int n = 0; n < 2; ++n) bv[bj][n] = bias ? *(const f32x4*)(bias + bcol0 + bj * HALF + 4 * n) : (f32x4){0.f, 0.f, 0.f, 0.f};
#pragma unroll
        for (int ai = 0; ai < 2; ++ai)
#pragma unroll
            for (int m = 0; m < 4; ++m) { bf16_t* rowp = base + (size_t)(row0 + ai * HALF + m * 16) * ldc + col0;
#pragma unroll
                for (int bj = 0; bj < 2; ++bj) { f32x4 v0 = acc[ai][bj][m][0] + bv[bj][0], v1 = acc[ai][bj][m][1] + bv[bj][1];
                    if (ACT == 1) { f32x2 a = gelu_pk((f32x2){v0[0], v0[1]}), b = gelu_pk((f32x2){v0[2], v0[3]}), c = gelu_pk((f32x2){v1[0], v1[1]}), d = gelu_pk((f32x2){v1[2], v1[3]});
                        v0 = (f32x4){a.x, a.y, b.x, b.y}; v1 = (f32x4){c.x, c.y, d.x, d.y}; }
                    v0 = v0 * sc; v1 = v1 * sc; u32x4 w; w.x = cvt_pk_bf16(v0[0], v0[1]); w.y = cvt_pk_bf16(v0[2], v0[3]); w.z = cvt_pk_bf16(v1[0], v1[1]); w.w = cvt_pk_bf16(v1[2], v1[3]);
                    *(u32x4*)(rowp + bj * HALF) = w; } }
    }
};

template <class Epi, class Sched, bool ALIGN_EPI = false, bool SP2 = false>
__device__ __forceinline__ void gemm_phase(PG8_LAS unsigned char* lds, const Gemm g, const Sched& S, const Epi& E) {
    int tid_o = threadIdx.x; asm volatile("" : "+v"(tid_o));
    const int tid = tid_o, wid = __builtin_amdgcn_readfirstlane(tid >> 6), lane = tid & 63, wr = wid >> 2, wc = wid & 3, fr = lane & 15, fq = lane >> 4;
    const int K = g.K, nt = K / BK;
    unsigned voffA[2], voffB[2];
#pragma unroll
    for (int i = 0; i < 2; ++i) { int R, C; stage_rc(tid * 16 + i * 8192, R, C); const int Rb = Epi::PERM ? ((R & ~31) + perm32(R & 31)) : R;
        voffA[i] = (unsigned)(R * K + C) * 2u; voffB[i] = (unsigned)(Rb * K + C) * 2u; }
    const size_t kstep = (size_t)(BK * 2);
    const size_t hstep = (size_t)HALF * K * 2;
    const size_t tstep = 2 * hstep;
    const unsigned ldsw = (unsigned)wid * 1024u;
    const int aoff = lds_byte(wr * 64 + fr, fq * 8), boff = lds_byte(wc * 32 + fr, fq * 8);
#define PG8_SA(b, h) (((b) * 2 + (h)) * HTB)
#define PG8_SB(b, h) ((4 + (b) * 2 + (h)) * HTB)
#define PG8_STAGE(bufoff, gbase, voff) do { _Pragma("unroll") for (int _i = 0; _i < 2; ++_i) \
        __builtin_amdgcn_global_load_lds((const unsigned*)((const char*)(gbase) + (voff)[_i]), (PG8_LAS unsigned*)(lds + (bufoff) + ldsw + _i * 8192), 16, 0, 0); } while (0)
#define PG8_LDA(dst, b, h) do { _Pragma("unroll") for (int m = 0; m < 4; ++m) _Pragma("unroll") for (int k = 0; k < 2; ++k) dst[m][k] = *(const PG8_LAS bf16x8*)(lds + PG8_SA(b, h) + aoff + m * 2048 + k * 1024); } while (0)
#define PG8_LDB(dst, b, h) do { _Pragma("unroll") for (int n = 0; n < 2; ++n) _Pragma("unroll") for (int k = 0; k < 2; ++k) dst[n][k] = *(const PG8_LAS bf16x8*)(lds + PG8_SB(b, h) + boff + n * 2048 + k * 1024); } while (0)
#define PG8_MMA(ai, bj, At, Bt) do { __builtin_amdgcn_s_setprio(1); _Pragma("unroll") for (int m = 0; m < 4; ++m) _Pragma("unroll") for (int n = 0; n < 2; ++n) _Pragma("unroll") for (int k = 0; k < 2; ++k) \
        acc[ai][bj][m][n] = __builtin_amdgcn_mfma_f32_16x16x32_bf16(Bt[n][k], At[m][k], acc[ai][bj][m][n], 0, 0, 0); __builtin_amdgcn_s_setprio(0); } while (0)
#define PG8_WAIT_V(n) asm volatile("s_waitcnt vmcnt(" #n ")" ::: "memory")
#define PG8_WAIT_L(n) asm volatile("s_waitcnt lgkmcnt(" #n ")" ::: "memory")
#define PG8_BAR __builtin_amdgcn_s_barrier()
#define PG8_SCHED __builtin_amdgcn_sched_barrier(0)
    Unit cur, nxt; int ui = 0;
    if (!S.next(0, cur)) return;
    f32x4 acc[2][2][4][2];
#pragma unroll
    for (int a = 0; a < 2; ++a)
#pragma unroll
        for (int b = 0; b < 2; ++b)
#pragma unroll
            for (int m = 0; m < 4; ++m)
#pragma unroll
                for (int n = 0; n < 2; ++n) acc[a][b][m][n] = (f32x4){0.f, 0.f, 0.f, 0.f};
    bf16x8 At[4][2], B0[2][2], B1[2][2];
    const char* cA = (const char*)g.A + (size_t)cur.pm * tstep; const char* cB = (const char*)g.Bt + (size_t)cur.pn * tstep;
    S.a_ready(cur);
    if constexpr (SP2) {
        PG8_STAGE(PG8_SB(0, 0), cB, voffB); PG8_STAGE(PG8_SB(0, 1), cB + hstep, voffB); PG8_STAGE(PG8_SA(0, 0), cA, voffA); PG8_STAGE(PG8_SA(0, 1), cA + hstep, voffA);
        if (wr == 1) PG8_BAR;
        PG8_WAIT_V(2); PG8_BAR;
        PG8_STAGE(PG8_SB(1, 0), cB + kstep, voffB); PG8_STAGE(PG8_SA(1, 0), cA + kstep, voffA); PG8_STAGE(PG8_SB(1, 1), cB + hstep + kstep, voffB);
        PG8_WAIT_V(6); PG8_BAR;
    } else {
        PG8_STAGE(PG8_SB(0, 0), cB, voffB); PG8_STAGE(PG8_SA(0, 0), cA, voffA); PG8_STAGE(PG8_SB(0, 1), cB + hstep, voffB); PG8_STAGE(PG8_SA(0, 1), cA + hstep, voffA);
        if (wr == 1) PG8_BAR;
        PG8_WAIT_V(4); PG8_BAR;
        PG8_STAGE(PG8_SB(1, 0), cB + kstep, voffB); PG8_STAGE(PG8_SA(1, 0), cA + kstep, voffA); PG8_STAGE(PG8_SB(1, 1), cB + hstep + kstep, voffB);
        PG8_WAIT_V(6); PG8_BAR;
    }
    for (;;) {
        const bool has_next = S.next(ui + 1, nxt);
        const char* nA = has_next ? (const char*)g.A + (size_t)nxt.pm * tstep : cA; const char* nB = has_next ? (const char*)g.Bt + (size_t)nxt.pn * tstep : cB;
        for (int t = 0; t < nt; t += 2) {
            const bool last = (t == nt - 2);
            const char* a1 = cA + (size_t)(t + 1) * kstep;
            const char* a2 = last ? nA : cA + (size_t)(t + 2) * kstep; const char* b2 = last ? nB : cB + (size_t)(t + 2) * kstep;
            const char* a3 = a2 + kstep; const char* b3 = b2 + kstep;
            if (last && has_next) S.a_ready(nxt);
            if constexpr (SP2) {
            PG8_LDB(B0, 0, 0); PG8_LDB(B1, 0, 1); PG8_SCHED; PG8_LDA(At, 0, 0); PG8_STAGE(PG8_SA(1, 1), a1 + hstep, voffA);
            PG8_WAIT_V(8); PG8_WAIT_L(0); PG8_BAR; PG8_MMA(0, 0, At, B0); PG8_MMA(0, 1, At, B1); PG8_BAR; PG8_SCHED;
            PG8_LDA(At, 0, 1); PG8_STAGE(PG8_SB(0, 0), b2, voffB); PG8_STAGE(PG8_SB(0, 1), b2 + hstep, voffB); PG8_STAGE(PG8_SA(0, 0), a2, voffA);
            PG8_WAIT_V(8); PG8_WAIT_L(0); PG8_BAR; PG8_MMA(1, 0, At, B0); PG8_MMA(1, 1, At, B1); PG8_BAR; PG8_SCHED;
            PG8_LDB(B0, 1, 0); PG8_LDB(B1, 1, 1); PG8_SCHED; PG8_LDA(At, 1, 0); PG8_STAGE(PG8_SA(0, 1), a2 + hstep, voffA);
            PG8_WAIT_V(8); PG8_WAIT_L(0); PG8_BAR; PG8_MMA(0, 0, At, B0); PG8_MMA(0, 1, At, B1); PG8_BAR; PG8_SCHED;
            PG8_LDA(At, 1, 1); PG8_STAGE(PG8_SB(1, 0), b3, voffB); PG8_STAGE(PG8_SB(1, 1), b3 + hstep, voffB); PG8_STAGE(PG8_SA(1, 0), a3, voffA);
            PG8_WAIT_V(8); PG8_WAIT_L(0); PG8_BAR; PG8_MMA(1, 0, At, B0); PG8_MMA(1, 1, At, B1); PG8_BAR; PG8_SCHED;
            } else {
            PG8_LDB(B0, 0, 0); PG8_SCHED; PG8_LDA(At, 0, 0); PG8_STAGE(PG8_SA(1, 1), a1 + hstep, voffA);
            PG8_WAIT_L(8); PG8_BAR; PG8_WAIT_L(0); PG8_MMA(0, 0, At, B0); PG8_BAR; PG8_SCHED;
            PG8_LDB(B1, 0, 1); PG8_STAGE(PG8_SB(0, 0), b2, voffB);
            PG8_BAR; PG8_WAIT_L(0); PG8_MMA(0, 1, At, B1); PG8_BAR;
            PG8_LDA(At, 0, 1); PG8_STAGE(PG8_SA(0, 0), a2, voffA);
            PG8_BAR; PG8_WAIT_L(0); PG8_MMA(1, 0, At, B0); PG8_BAR; PG8_SCHED;
            PG8_STAGE(PG8_SB(0, 1), b2 + hstep, voffB);
            PG8_WAIT_V(6); PG8_BAR; PG8_MMA(1, 1, At, B1); PG8_BAR;
            PG8_LDB(B0, 1, 0); PG8_SCHED; PG8_LDA(At, 1, 0); PG8_STAGE(PG8_SA(0, 1), a2 + hstep, voffA);
            PG8_WAIT_L(8); PG8_BAR; PG8_WAIT_L(0); PG8_MMA(0, 0, At, B0); PG8_BAR; PG8_SCHED;
            PG8_LDB(B1, 1, 1); PG8_STAGE(PG8_SB(1, 0), b3, voffB);
            PG8_BAR; PG8_WAIT_L(0); PG8_MMA(0, 1, At, B1); PG8_BAR;
            PG8_LDA(At, 1, 1); PG8_STAGE(PG8_SA(1, 0), a3, voffA);
            PG8_BAR; PG8_WAIT_L(0); PG8_MMA(1, 0, At, B0); PG8_BAR; PG8_SCHED;
            PG8_STAGE(PG8_SB(1, 1), b3 + hstep, voffB);
            PG8_WAIT_V(6); PG8_BAR; PG8_MMA(1, 1, At, B1); PG8_BAR;
            }
        }
        if constexpr (ALIGN_EPI) { if (wr == 0) PG8_BAR; }
        if constexpr (!Epi::AFTER_DRAIN) { E(acc, cur, wr, wc, fr, fq); S.done(cur); }
        if (!has_next) break;
#pragma unroll
        for (int a = 0; a < 2; ++a)
#pragma unroll
            for (int b = 0; b < 2; ++b)
#pragma unroll
                for (int m = 0; m < 4; ++m)
#pragma unroll
                    for (int n = 0; n < 2; ++n) acc[a][b][m][n] = (f32x4){0.f, 0.f, 0.f, 0.f};
        cur = nxt; cA = nA; cB = nB; ++ui;
        if constexpr (ALIGN_EPI) { if (wr == 1) PG8_BAR; }
    }
    PG8_WAIT_V(0);
    if constexpr (!ALIGN_EPI) { if (wr == 0) PG8_BAR; }
    PG8_BAR;
    if constexpr (Epi::AFTER_DRAIN) { E.fused(acc, cur, wr, wc, fr, fq, lds, wid, lane); S.done(cur); }
#undef PG8_SA
#undef PG8_SB
#undef PG8_STAGE
#undef PG8_LDA
#undef PG8_LDB
#undef PG8_MMA
#undef PG8_WAIT_V
#undef PG8_WAIT_L
#undef PG8_BAR
#undef PG8_SCHED
}
}
namespace pg8 {
struct EpiSwiGLU {
    static constexpr bool PERM = true, AFTER_DRAIN = false;
    bf16_t* O; int ldc;
    __device__ __forceinline__ void operator()(const f32x4 (&acc)[2][2][4][2], const Unit& u, int wr, int wc, int fr, int fq) const {
        const int row0 = u.pm * BM + wr * 64 + fr; const int col0 = u.pn * HALF + wc * 32 + 8 * fq;
#pragma unroll
        for (int ai = 0; ai < 2; ++ai)
#pragma unroll
            for (int m = 0; m < 4; ++m) { bf16_t* rowp = O + (size_t)(row0 + ai * HALF + m * 16) * ldc + col0;
                float v[8];
#pragma unroll
                for (int n = 0; n < 2; ++n)
#pragma unroll
                    for (int i = 0; i < 4; ++i) { const float g = acc[ai][0][m][n][i], up = acc[ai][1][m][n][i];
                        const float sg = g * __builtin_amdgcn_rcpf(1.0f + __builtin_amdgcn_exp2f(-1.4426950408889634f * g)); v[4 * n + i] = sg * up; }
                u32x4 w; w.x = cvt_pk_bf16(v[0], v[1]); w.y = cvt_pk_bf16(v[2], v[3]); w.z = cvt_pk_bf16(v[4], v[5]); w.w = cvt_pk_bf16(v[6], v[7]);
                *(u32x4*)rowp = w; }
    }
};
struct EpiF32 {
    static constexpr bool PERM = true, AFTER_DRAIN = false;
    float* O; int ldc;
    __device__ __forceinline__ void operator()(const f32x4 (&acc)[2][2][4][2], const Unit& u, int wr, int wc, int fr, int fq) const {
        const int row0 = u.pm * BM + wr * 64 + fr; const int col0 = u.pn * BM + wc * 32 + 8 * fq;
#pragma unroll
        for (int ai = 0; ai < 2; ++ai)
#pragma unroll
            for (int m = 0; m < 4; ++m) { float* rowp = O + (size_t)(row0 + ai * HALF + m * 16) * ldc + col0;
#pragma unroll
                for (int bj = 0; bj < 2; ++bj) { *(f32x4*)(rowp + bj * HALF) = acc[ai][bj][m][0]; *(f32x4*)(rowp + bj * HALF + 4) = acc[ai][bj][m][1]; } }
    }
};
struct EpiGlu {
    static constexpr bool PERM = true, AFTER_DRAIN = false;
    bf16_t* O; int ldc; const bf16_t* ys; int ldy; const float* bias;
    __device__ __forceinline__ void operator()(const f32x4 (&acc)[2][2][4][2], const Unit& u, int wr, int wc, int fr, int fq) const {
        const int row0 = u.pm * BM + wr * 64 + fr; const int col0 = u.pn * BM + wc * 32 + 8 * fq;
#pragma unroll
        for (int ai = 0; ai < 2; ++ai)
#pragma unroll
            for (int m = 0; m < 4; ++m) { const int row = row0 + ai * HALF + m * 16;
#pragma unroll
                for (int bj = 0; bj < 2; ++bj) { const int col = col0 + bj * HALF;
                    const u32x4 yp = *(const u32x4*)(ys + (size_t)row * ldy + col);
                    const f32x4 b0 = *(const f32x4*)(bias + col), b1 = *(const f32x4*)(bias + col + 4);
                    const float yv[8] = {__uint_as_float(yp.x << 16), __uint_as_float(yp.x & 0xffff0000u), __uint_as_float(yp.y << 16), __uint_as_float(yp.y & 0xffff0000u),
                                         __uint_as_float(yp.z << 16), __uint_as_float(yp.z & 0xffff0000u), __uint_as_float(yp.w << 16), __uint_as_float(yp.w & 0xffff0000u)};
                    float v[8];
#pragma unroll
                    for (int i = 0; i < 4; ++i) { const float z0 = acc[ai][bj][m][0][i] + b0[i], z1 = acc[ai][bj][m][1][i] + b1[i];
                        v[i] = yv[i] * __builtin_amdgcn_rcpf(1.0f + __builtin_amdgcn_exp2f(-1.4426950408889634f * z0));
                        v[4 + i] = yv[4 + i] * __builtin_amdgcn_rcpf(1.0f + __builtin_amdgcn_exp2f(-1.4426950408889634f * z1)); }
                    u32x4 w; w.x = cvt_pk_bf16(v[0], v[1]); w.y = cvt_pk_bf16(v[2], v[3]); w.z = cvt_pk_bf16(v[4], v[5]); w.w = cvt_pk_bf16(v[6], v[7]);
                    *(u32x4*)(O + (size_t)row * ldc + col) = w; } }
    }
};
struct EpiBf16Plain {
    static constexpr bool PERM = true, AFTER_DRAIN = false;
    bf16_t* O; int ldc;
    __device__ __forceinline__ void operator()(const f32x4 (&acc)[2][2][4][2], const Unit& u, int wr, int wc, int fr, int fq) const {
        const int row0 = u.pm * BM + wr * 64 + fr; const int col0 = u.pn * BM + wc * 32 + 8 * fq;
#pragma unroll
        for (int ai = 0; ai < 2; ++ai)
#pragma unroll
            for (int m = 0; m < 4; ++m) { bf16_t* rowp = O + (size_t)(row0 + ai * HALF + m * 16) * ldc + col0;
#pragma unroll
                for (int bj = 0; bj < 2; ++bj) { const f32x4 v0 = acc[ai][bj][m][0], v1 = acc[ai][bj][m][1];
                    u32x4 w; w.x = cvt_pk_bf16(v0[0], v0[1]); w.y = cvt_pk_bf16(v0[2], v0[3]); w.z = cvt_pk_bf16(v1[0], v1[1]); w.w = cvt_pk_bf16(v1[2], v1[3]);
                    *(u32x4*)(rowp + bj * HALF) = w; } }
    }
};
struct GatedUnit {
    Unit un; unsigned* cnt; unsigned want;
    __device__ __forceinline__ bool next(int i, Unit& u) const { u = un; return i == 0; }
    __device__ __forceinline__ void a_ready(const Unit&) const {
        if (threadIdx.x == 0) { unsigned sp = 0;
            while (__hip_atomic_load(cnt, __ATOMIC_RELAXED, __HIP_MEMORY_SCOPE_AGENT) < want) { __builtin_amdgcn_s_sleep(2); if (++sp > (1u << 22)) break; }
            __builtin_amdgcn_fence(__ATOMIC_ACQUIRE, "agent"); asm volatile("s_waitcnt vmcnt(0)" ::: "memory"); }
        __syncthreads();
    }
    __device__ __forceinline__ void done(const Unit&) const {}
};
}
#include <hip/hip_cooperative_groups.h>
namespace cg = cooperative_groups;
#define LAS __attribute__((address_space(3)))
typedef unsigned short bf16;
typedef float f32x4 __attribute__((ext_vector_type(4)));
typedef float f32x16 __attribute__((ext_vector_type(16)));
typedef short bf16x8 __attribute__((ext_vector_type(8)));
typedef short s16x4 __attribute__((ext_vector_type(4)));
typedef unsigned u32x4 __attribute__((ext_vector_type(4)));
typedef unsigned u32x2 __attribute__((ext_vector_type(2)));
typedef float f32x2_t __attribute__((ext_vector_type(2)));
typedef __bf16 bf16x2_t __attribute__((ext_vector_type(2)));

constexpr int NB = 4, SEQ = 2048, DM = 2048, M = NB * SEQ, FF = 5632, INC = 5120, NLAYER = 2;
constexpr int C_SBQ = 0, C_SBK = 768, C_SBV = 1536, C_U = 2304, C_DQ = 2816, C_DK = 3584, C_DV = 4352;
constexpr int MIX_SB = 0, MIX_SSM = 768, MIX_DIFF = 1280;
constexpr float EPS = 1e-6f;
constexpr float LOG2E = 1.4426950408889634f;
constexpr int NTHREADS = 512, NWAVES = 8;
constexpr int LDS_BYTES = 148480;

constexpr size_t SZ_WGU = (size_t)2 * FF * DM * 2, SZ_WD = (size_t)DM * FF * 2, SZ_WIN = (size_t)INC * DM * 2, SZ_WOUT = (size_t)DM * DM * 2, SZ_WGLU = (size_t)512 * 512 * 2;
constexpr size_t LW_GU1 = 0, LW_D1 = LW_GU1 + SZ_WGU, LW_IN = LW_D1 + SZ_WD, LW_OUT = LW_IN + SZ_WIN, LW_GLU = LW_OUT + SZ_WOUT, LW_GU2 = LW_GLU + SZ_WGLU, LW_D2 = LW_GU2 + SZ_WGU, LW_SIZE = LW_D2 + SZ_WD;
constexpr size_t WS_W = 1u << 20;
constexpr size_t WS_XN = WS_W + NLAYER * LW_SIZE;
constexpr size_t WS_BIG = WS_XN + (size_t)M * DM * 2;
constexpr size_t WS_Y = WS_BIG + (size_t)M * FF * 2;
constexpr size_t WS_MIX = WS_Y + (size_t)M * DM * 4;
constexpr size_t WS_YS = WS_MIX + (size_t)M * DM * 2;
constexpr size_t WS_YSB = WS_YS + (size_t)M * 512 * 4;
constexpr size_t WS_END = WS_YSB + (size_t)M * 512 * 2;

struct Args { const float* in[31]; float* out; unsigned char* ws; };
typedef __attribute__((address_space(4))) const Args* KArgs;
__device__ __forceinline__ KArgs kargs_ptr() { KArgs ap = (KArgs)__builtin_amdgcn_kernarg_segment_ptr(); asm volatile("" : "+s"(ap)); return ap; }
#define IN(k) (kargs_ptr()->in[(k)])

__device__ const unsigned char T5B[128] = {0, 1, 2, 3, 4, 5, 6, 7, 8, 9, 10, 11, 12, 13, 14, 15, 16, 16, 16, 17, 17, 18, 18, 18, 19, 19, 19, 20, 20, 20, 20, 21, 21, 21, 21, 22, 22, 22, 22, 22, 23, 23, 23, 23, 23, 23, 24, 24, 24, 24, 24, 24, 25, 25, 25, 25, 25, 25, 25, 26, 26, 26, 26, 26, 26, 26, 26, 27, 27, 27, 27, 27, 27, 27, 27, 27, 27, 28, 28, 28, 28, 28, 28, 28, 28, 28, 28, 29, 29, 29, 29, 29, 29, 29, 29, 29, 29, 29, 29, 30, 30, 30, 30, 30, 30, 30, 30, 30, 30, 30, 30, 30, 30, 31, 31, 31, 31, 31, 31, 31, 31, 31, 31, 31, 31, 31, 31, 31};

#define LDS_WAIT() asm volatile("s_waitcnt lgkmcnt(0)" ::: "memory")
#define WAVE_SYNC() do { asm volatile("s_waitcnt lgkmcnt(0)" ::: "memory"); __builtin_amdgcn_wave_barrier(); } while (0)
#define MFMA32(a, b, c) __builtin_amdgcn_mfma_f32_32x32x16_bf16((a), (b), (c), 0, 0, 0)
__device__ __forceinline__ unsigned f2bf(float f) { unsigned u = __float_as_uint(f); return (u + 0x7fffu + ((u >> 16) & 1u)) >> 16; }
__device__ __forceinline__ unsigned pk2(float lo, float hi) { return f2bf(lo) | (f2bf(hi) << 16); }
__device__ __forceinline__ unsigned cvtpk(float lo, float hi) { f32x2_t v = {lo, hi}; bf16x2_t b = __builtin_convertvector(v, bf16x2_t); return __builtin_bit_cast(unsigned, b); }
__device__ __forceinline__ float bf2f(unsigned short b) { return __uint_as_float(((unsigned)b) << 16); }
__device__ __forceinline__ float wave_sum(float v) {
#pragma unroll
    for (int o = 1; o < 64; o <<= 1) v += __shfl_xor(v, o);
    return v;
}
__device__ __forceinline__ int crow(int i, int h) { return (i & 3) + 8 * (i >> 2) + 4 * h; }

#define XB_TMO      128
#define XB_XCNT(j)  (256  + 64 * (j))
#define XB_XSUB(j)  (1280 + 64 * (j))
#define XB_XGEN(j)  (2304 + 64 * (j))
#define XB_TOP      3328
#define XB_TOPGEN   3392
#define XCD_BAR_WORDS 3456
#define XB_SPIN_CAP (1u << 18)

__device__ __forceinline__ unsigned xb_ld(unsigned* p)              { return __hip_atomic_load(p, __ATOMIC_RELAXED, __HIP_MEMORY_SCOPE_AGENT); }
__device__ __forceinline__ unsigned xb_add(unsigned* p, unsigned v) { return __hip_atomic_fetch_add(p, v, __ATOMIC_RELAXED, __HIP_MEMORY_SCOPE_AGENT); }
__device__ __forceinline__ unsigned xb_xcc_id() { return (unsigned)__builtin_amdgcn_s_getreg((3 << 11) | 20) & 0xFu; }
#define XB_SPIN(cond, bar) do { unsigned _sp = 0; while (cond) { __builtin_amdgcn_s_sleep(1); \
    if ((++_sp & 255u) == 0u) { if (xb_ld(&(bar)[XB_TMO])) break; if (_sp > XB_SPIN_CAP) { atomicAdd(&(bar)[XB_TMO], 1u); break; } } } } while (0)

struct XcdBarrier {
    unsigned* bar; unsigned x;
    volatile LAS unsigned* st;
};

__device__ __forceinline__ XcdBarrier xcd_barrier_post(unsigned* bar, volatile LAS unsigned* st) {
    XcdBarrier b; b.bar = bar; b.x = xb_xcc_id(); b.st = st;
    if (threadIdx.x == 0) (void)xb_add(&bar[XB_XCNT(b.x)], 1u);
    return b;
}
__device__ __forceinline__ void xcd_barrier_complete(unsigned* bar, unsigned x, unsigned& nloc, unsigned& nx) {
    const unsigned G = gridDim.x * gridDim.y * gridDim.z;
    unsigned sum, cnt, mine, sp = 0u;
    for (;;) {
        sum = 0u; cnt = 0u; mine = 0u;
#pragma unroll
        for (unsigned j = 0; j < 16; ++j) { const unsigned c = xb_ld(&bar[XB_XCNT(j)]); sum += c; cnt += (c > 0u) ? 1u : 0u; mine = (j == x) ? c : mine; }
        if (sum == G) break;
        __builtin_amdgcn_s_sleep(1);
        if ((++sp & 255u) == 0u) { if (xb_ld(&bar[XB_TMO])) break; if (sp > XB_SPIN_CAP) { atomicAdd(&bar[XB_TMO], 1u); break; } }
    }
    nloc = mine > 0u ? mine : 1u; nx = cnt > 0u ? cnt : 1u;
}

__device__ __forceinline__ void xcd_barrier(const XcdBarrier& b) {
    asm volatile("s_waitcnt vmcnt(0)" ::: "memory");
    __syncthreads();
    if (threadIdx.x == 0) {
        unsigned* bar = b.bar;
        __builtin_amdgcn_s_waitcnt(0);
        unsigned nloc = b.st[0], nx = b.st[1];
        if (nloc == 0u) { xcd_barrier_complete(bar, b.x, nloc, nx); b.st[0] = nloc; b.st[1] = nx; }
        const unsigned old = xb_add(&bar[XB_XSUB(b.x)], 1u);
        const unsigned gen = old / nloc;
        if (old + 1u == (gen + 1u) * nloc) {
            __builtin_amdgcn_fence(__ATOMIC_RELEASE, "agent");
            asm volatile("s_waitcnt vmcnt(0)" ::: "memory");
            const unsigned og = xb_add(&bar[XB_TOP], 1u);
            const unsigned tg = og / nx;
            if (og + 1u == (tg + 1u) * nx) xb_add(&bar[XB_TOPGEN], 1u);
            else XB_SPIN(xb_ld(&bar[XB_TOPGEN]) == tg, bar);
            __builtin_amdgcn_fence(__ATOMIC_ACQUIRE, "agent");
            xb_add(&bar[XB_XGEN(b.x)], 1u);
            asm volatile("s_waitcnt vmcnt(0)" ::: "memory");
        } else {
            XB_SPIN(xb_ld(&bar[XB_XGEN(b.x)]) == gen, bar);
            __builtin_amdgcn_fence(__ATOMIC_ACQUIRE, "agent");
            asm volatile("s_waitcnt vmcnt(0)" ::: "memory");
        }
    }
    __syncthreads();
}

__device__ __forceinline__ void transpose_item(const float* __restrict__ W, int K, int N, bf16* WT, int mode, LAS float* scr, int item, int lane) {
    const int nblk = N / 32, kb = item / nblk, nb = item % nblk, k0 = 64 * kb, n0 = 32 * nb;
#pragma unroll 8
    for (int i = 0; i < 32; ++i) { const int kk = 2 * i + (lane >> 5); scr[kk * 33 + (lane & 31)] = __builtin_nontemporal_load(&W[(size_t)(k0 + kk) * N + n0 + (lane & 31)]); }
    LDS_WAIT();
    const int rb = mode == 0 ? n0 : ((n0 >> 7) * 256 + (n0 & 127) + (mode == 2 ? 128 : 0));
    const int c = lane & 7;
#pragma unroll
    for (int j = 0; j < 4; ++j) { const int n = (lane >> 3) + 8 * j; const LAS float* s = scr + (8 * c) * 33 + n;
        u32x4 o; o.x = pk2(s[0 * 33], s[1 * 33]); o.y = pk2(s[2 * 33], s[3 * 33]); o.z = pk2(s[4 * 33], s[5 * 33]); o.w = pk2(s[6 * 33], s[7 * 33]);
        *(u32x4*)(WT + (size_t)(rb + n) * K + k0 + 8 * c) = o; }
    LDS_WAIT();
}

__device__ __forceinline__ void row_pass(const bf16* Y, const float* Hin, float* Hout, bf16* XN, const float* gpost, float wres, const float* gpre, int gw, int ngw, int lane) {
    for (int m = gw; m < M; m += ngw) {
        f32x4 hv[8];
        const f32x4* hr = (const f32x4*)(Hin + (size_t)m * DM) + 2 * lane;
#pragma unroll
        for (int j = 0; j < 4; ++j) { hv[2 * j] = hr[128 * j]; hv[2 * j + 1] = hr[128 * j + 1]; }
        if (Y) {
            f32x4 yv[8]; const u32x4* yr = (const u32x4*)(Y + (size_t)m * DM) + lane; float ss = 0.f;
#pragma unroll
            for (int j = 0; j < 4; ++j) { const u32x4 p = yr[64 * j];
                yv[2 * j] = (f32x4){__uint_as_float(p.x << 16), __uint_as_float(p.x & 0xffff0000u), __uint_as_float(p.y << 16), __uint_as_float(p.y & 0xffff0000u)};
                yv[2 * j + 1] = (f32x4){__uint_as_float(p.z << 16), __uint_as_float(p.z & 0xffff0000u), __uint_as_float(p.w << 16), __uint_as_float(p.w & 0xffff0000u)}; }
#pragma unroll
            for (int j = 0; j < 8; ++j) ss += (yv[j].x * yv[j].x + yv[j].y * yv[j].y) + (yv[j].z * yv[j].z + yv[j].w * yv[j].w);
            ss = wave_sum(ss);
            const float rstd = wres / sqrtf(ss * (1.0f / DM) + EPS);
#pragma unroll
            for (int j = 0; j < 4; ++j) { const f32x4 g0 = ((const f32x4*)gpost)[2 * lane + 128 * j], g1 = ((const f32x4*)gpost)[2 * lane + 128 * j + 1];
                hv[2 * j] = hv[2 * j] + yv[2 * j] * g0 * rstd; hv[2 * j + 1] = hv[2 * j + 1] + yv[2 * j + 1] * g1 * rstd; }
        }
        if (Hout) { f32x4* ho = (f32x4*)(Hout + (size_t)m * DM) + 2 * lane;
#pragma unroll
            for (int j = 0; j < 4; ++j) { ho[128 * j] = hv[2 * j]; ho[128 * j + 1] = hv[2 * j + 1]; } }
        if (gpre) {
            float s2 = 0.f;
#pragma unroll
            for (int j = 0; j < 8; ++j) s2 += (hv[j].x * hv[j].x + hv[j].y * hv[j].y) + (hv[j].z * hv[j].z + hv[j].w * hv[j].w);
            s2 = wave_sum(s2);
            const float r2 = 1.0f / sqrtf(s2 * (1.0f / DM) + EPS);
            u32x4* xo = (u32x4*)(XN + (size_t)m * DM) + lane;
#pragma unroll
            for (int j = 0; j < 4; ++j) { const f32x4 g0 = ((const f32x4*)gpre)[2 * lane + 128 * j], g1 = ((const f32x4*)gpre)[2 * lane + 128 * j + 1];
                const f32x4 v0 = hv[2 * j] * g0 * r2, v1 = hv[2 * j + 1] * g1 * r2; u32x4 o; o.x = pk2(v0.x, v0.y); o.y = pk2(v0.z, v0.w); o.z = pk2(v1.x, v1.y); o.w = pk2(v1.z, v1.w); xo[64 * j] = o; }
        }
    }
}

constexpr int KP = 272, VP = 320;
constexpr int KBYTES = 64 * KP, VBYTES = 64 * VP;
constexpr int A_K = 0, A_V = 2 * KBYTES, A_BIAS = A_V + 2 * VBYTES, A_FLAG = A_BIAS + 1024, A_Q = A_FLAG + 1024, A_END = A_Q + 8 * 32 * KP;

__device__ __forceinline__ void tile_prefetch(u32x4 (&rg)[2], const bf16* g, int tid) {
#pragma unroll
    for (int i = 0; i < 2; ++i) { const int chunk = tid + 512 * i, row = chunk >> 4, ch = chunk & 15; rg[i] = *(const u32x4*)(g + (size_t)row * INC + ch * 8); }
}
__device__ __forceinline__ void tile_store(LAS char* dst, int pitch, const u32x4 (&rg)[2], int tid) {
#pragma unroll
    for (int i = 0; i < 2; ++i) { const int chunk = tid + 512 * i, row = chunk >> 4, ch = chunk & 15; *(LAS u32x4*)(dst + row * pitch + ch * 16) = rg[i]; }
}
__device__ __forceinline__ void pv_half(f32x16 (&o)[4], const LAS char* Vb, int kh, bf16x8 P0, bf16x8 P1, int lane) {
    const int h = lane >> 5, i16 = lane & 15, qq = i16 >> 2, p = i16 & 3, blk = (lane >> 4) & 1;
    const LAS char* vb = Vb + (32 * kh + 4 * h + qq) * VP + (16 * blk + 4 * p) * 2;
#pragma unroll
    for (int s2 = 0; s2 < 2; ++s2)
#pragma unroll
        for (int db = 0; db < 4; ++db) {
            const s16x4 lo = __builtin_bit_cast(s16x4, __builtin_amdgcn_ds_read_tr16_b64_v4i16((LAS s16x4*)(vb + (16 * s2) * VP + db * 64)));
            const s16x4 hi = __builtin_bit_cast(s16x4, __builtin_amdgcn_ds_read_tr16_b64_v4i16((LAS s16x4*)(vb + (16 * s2 + 8) * VP + db * 64)));
            const bf16x8 vf = __builtin_shufflevector(lo, hi, 0, 1, 2, 3, 4, 5, 6, 7);
            o[db] = MFMA32(vf, s2 == 0 ? P0 : P1, o[db]);
        }
}

__device__ __forceinline__ void sb_unit(LAS char* lds, const bf16* PROJ, bf16* MIX, int b, int hd, int qb) {
    int tid_o = threadIdx.x; asm volatile("" : "+v"(tid_o)); const int tid = tid_o, lane = tid & 63, r = lane & 31, h = lane >> 5, w = __builtin_amdgcn_readfirstlane(tid >> 6);
    const int q0 = qb * 256, qw = q0 + 32 * w, q = qw + r;
    const size_t rowb = (size_t)b * SEQ;
    const float SCALE = 0.08838834764831845f;
    bf16x8 qf[8];
    { const bf16* Qg = PROJ + (rowb + q) * INC + C_SBQ + hd * 128 + 8 * h;
#pragma unroll
      for (int s = 0; s < 8; ++s) qf[s] = *(const bf16x8*)(Qg + 16 * s); }
    const bf16* Kg = PROJ + rowb * INC + C_SBK + hd * 128; const bf16* Vg = PROJ + rowb * INC + C_SBV + hd * 128;
    f32x16 o[4];
#pragma unroll
    for (int d = 0; d < 4; ++d)
#pragma unroll
        for (int i = 0; i < 16; ++i) o[d][i] = 0.f;
    float R = 0.f; bool wdone = false;
    const int kt_hi = (q0 + 255) >> 6;
    volatile LAS int* flags = (volatile LAS int*)(lds + A_FLAG);
    u32x4 kr[2], vr[2];
    tile_prefetch(kr, Kg + (size_t)(kt_hi * 64) * INC, tid); tile_prefetch(vr, Vg + (size_t)(kt_hi * 64) * INC, tid);
    int it = 0;
    for (int kt = kt_hi; kt >= 0; --kt, ++it) {
        const int buf = it & 1;
        LAS char* Kb = lds + A_K + buf * KBYTES; LAS char* Vb = lds + A_V + buf * VBYTES;
        tile_store(Kb, KP, kr, tid); tile_store(Vb, VP, vr, tid);
        __syncthreads();
        if (it > 0) { int alld = 1;
#pragma unroll
            for (int ww = 0; ww < 8; ++ww) alld &= flags[((it - 1) & 1) * 8 + ww];
            if (alld) break; }
        if (kt > 0) { tile_prefetch(kr, Kg + (size_t)((kt - 1) * 64) * INC, tid); tile_prefetch(vr, Vg + (size_t)((kt - 1) * 64) * INC, tid); }
        const int k0 = kt * 64;
        if (k0 < qw + 31 && !wdone) {
#pragma unroll
            for (int kh = 1; kh >= 0; --kh) {
                f32x16 c;
#pragma unroll
                for (int i = 0; i < 16; ++i) c[i] = 0.f;
                const LAS char* kp = Kb + (32 * kh + r) * KP + 16 * h;
#pragma unroll
                for (int s = 0; s < 8; ++s) { const bf16x8 kf = *(const LAS bf16x8*)(kp + 32 * s); c = MFMA32(kf, qf[s], c); }
                const int keyb = k0 + 32 * kh + 4 * h;
                float lk[16], lb[16], gs[4], og[4];
#pragma unroll
                for (int i = 0; i < 16; ++i) { const int key = keyb + (i & 3) + 8 * (i >> 2); const float z = c[i] * SCALE;
                    const float e = __expf(-fabsf(z)); const float ls = fminf(z, 0.f) - __logf(1.0f + e);
                    lb[i] = ls; lk[i] = (key < q) ? (ls - z) : 0.f; }
#pragma unroll
                for (int g = 0; g < 4; ++g) { gs[g] = (lk[4 * g] + lk[4 * g + 1]) + (lk[4 * g + 2] + lk[4 * g + 3]); og[g] = __shfl_xor(gs[g], 32); }
                const float sg = (gs[0] + gs[1]) + (gs[2] + gs[3]), so = (og[0] + og[1]) + (og[2] + og[3]);
                float after[4];
                after[3] = (h ? 0.f : og[3]);
                after[2] = gs[3] + og[3] + (h ? 0.f : og[2]);
                after[1] = gs[3] + gs[2] + og[3] + og[2] + (h ? 0.f : og[1]);
                after[0] = gs[3] + gs[2] + gs[1] + og[3] + og[2] + og[1] + (h ? 0.f : og[0]);
                float wv[16];
#pragma unroll
                for (int g = 0; g < 4; ++g) { const float base = R + after[g];
                    const float s3 = 0.f, s2 = lk[4 * g + 3], s1 = s2 + lk[4 * g + 2], s0 = s1 + lk[4 * g + 1];
                    const float bt[4] = {s0, s1, s2, s3};
#pragma unroll
                    for (int j = 0; j < 4; ++j) { const int i = 4 * g + j; const int key = keyb + j + 8 * g;
                        wv[i] = (key < q) ? __expf(lb[i] + base + bt[j]) : 0.f; } }
                R += sg + so;
                u32x4 p0, p1;
                p0.x = cvtpk(wv[0], wv[1]); p0.y = cvtpk(wv[2], wv[3]); p0.z = cvtpk(wv[4], wv[5]); p0.w = cvtpk(wv[6], wv[7]);
                p1.x = cvtpk(wv[8], wv[9]); p1.y = cvtpk(wv[10], wv[11]); p1.z = cvtpk(wv[12], wv[13]); p1.w = cvtpk(wv[14], wv[15]);
                pv_half(o, Vb, kh, __builtin_bit_cast(bf16x8, p0), __builtin_bit_cast(bf16x8, p1), lane);
            }
            wdone = __all(R < -110.f);
        }
        if (lane == 0) flags[(it & 1) * 8 + w] = wdone ? 1 : 0;
    }
    bf16* Og = MIX + (rowb + q) * DM + MIX_SB + hd * 128 + 4 * h;
#pragma unroll
    for (int db = 0; db < 4; ++db)
#pragma unroll
        for (int g = 0; g < 4; ++g) { u32x2 ov; ov.x = cvtpk(o[db][4 * g], o[db][4 * g + 1]); ov.y = cvtpk(o[db][4 * g + 2], o[db][4 * g + 3]); *(u32x2*)(Og + 32 * db + 8 * g) = ov; }
    __syncthreads();
}

__device__ __forceinline__ f32x16 diff_qk(const LAS char* kp, const LAS char* qp) {
    f32x16 c;
#pragma unroll
    for (int i = 0; i < 16; ++i) c[i] = 0.f;
#pragma unroll
    for (int s = 0; s < 4; ++s) { const bf16x8 kf = *(const LAS bf16x8*)(kp + 32 * s); const bf16x8 qf = *(const LAS bf16x8*)(qp + 32 * s); c = MFMA32(kf, qf, c); }
    return c;
}
__device__ __forceinline__ void diff_sm(f32x16& c, bool far, float bfar, const LAS float* bt, int q, int keyb, float& m, float& l, f32x16 (&o)[4], bf16x8& P0, bf16x8& P1) {
    const float SC2 = 0.125f * LOG2E;
    if (far) {
#pragma unroll
        for (int i = 0; i < 16; ++i) c[i] = c[i] * SC2 + bfar;
    } else {
#pragma unroll
        for (int i = 0; i < 16; ++i) { const int key = keyb + (i & 3) + 8 * (i >> 2); const int n = q - key; const int ni = n < 0 ? 0 : (n > 128 ? 128 : n);
            c[i] = (n < 0) ? -INFINITY : (c[i] * SC2 + bt[ni]); }
    }
    float mx = fmaxf(fmaxf(c[0], c[1]), fmaxf(c[2], c[3]));
#pragma unroll
    for (int i = 4; i < 16; i += 4) mx = fmaxf(mx, fmaxf(fmaxf(c[i], c[i + 1]), fmaxf(c[i + 2], c[i + 3])));
    mx = fmaxf(mx, __shfl_xor(mx, 32));
    const float mnew = fmaxf(m, mx);
    if (__any(mx > m + 8.0f)) {
        const float sc = __builtin_amdgcn_exp2f(m - mnew); l *= sc;
#pragma unroll
        for (int d = 0; d < 4; ++d)
#pragma unroll
            for (int i = 0; i < 16; ++i) o[d][i] *= sc;
        m = mnew;
    }
    float a = 0.f;
#pragma unroll
    for (int i = 0; i < 16; ++i) { c[i] = __builtin_amdgcn_exp2f(c[i] - m); a += c[i]; }
    l += a;
    u32x4 p0, p1;
    p0.x = cvtpk(c[0], c[1]); p0.y = cvtpk(c[2], c[3]); p0.z = cvtpk(c[4], c[5]); p0.w = cvtpk(c[6], c[7]);
    p1.x = cvtpk(c[8], c[9]); p1.y = cvtpk(c[10], c[11]); p1.z = cvtpk(c[12], c[13]); p1.w = cvtpk(c[14], c[15]);
    P0 = __builtin_bit_cast(bf16x8, p0); P1 = __builtin_bit_cast(bf16x8, p1);
}
__device__ __forceinline__ void diff_unit(LAS char* lds, const bf16* PROJ, bf16* MIX, const float* relb, float lam, float outscale, const float* subg, int b, int hd, int qb) {
    int tid_o = threadIdx.x; asm volatile("" : "+v"(tid_o)); const int tid = tid_o, lane = tid & 63, r = lane & 31, h = lane >> 5, w = __builtin_amdgcn_readfirstlane(tid >> 6);
    const int rg = w & 3, mp = w >> 2;
    const int q0 = qb * 128, qw = q0 + 32 * rg, q = qw + r;
    const size_t rowb = (size_t)b * SEQ;
    LAS float* bt = (LAS float*)(lds + A_BIAS);
    if (tid < 129) { const int bucket = tid < 128 ? (int)T5B[tid] : 31; bt[tid] = relb[bucket * 6 + hd] * LOG2E; }
    LAS char* qp = lds + A_Q + w * (32 * KP) + r * KP + 16 * h;
    { const bf16* Qg = PROJ + (rowb + q) * INC + C_DQ + hd * 128 + 64 * mp + 8 * h;
#pragma unroll
      for (int s = 0; s < 4; ++s) *(LAS u32x4*)(qp + 32 * s) = *(const u32x4*)(Qg + 16 * s); }
    const bf16* Kg = PROJ + rowb * INC + C_DK + hd * 128; const bf16* Vg = PROJ + rowb * INC + C_DV + hd * 128;
    float m = -1e30f, l = 0.f;
    f32x16 o[4];
#pragma unroll
    for (int d = 0; d < 4; ++d)
#pragma unroll
        for (int i = 0; i < 16; ++i) o[d][i] = 0.f;
    const int nt = ((q0 + 127) >> 6) + 1;
    u32x4 krA[2], vrA[2], krB[2], vrB[2];
    tile_prefetch(krA, Kg, tid); tile_prefetch(vrA, Vg, tid);
    tile_prefetch(krB, Kg + (size_t)64 * INC, tid); tile_prefetch(vrB, Vg + (size_t)64 * INC, tid);
#define DIFF_TILE(kt_, KR, VR) do { \
        const int buf = (kt_) & 1; \
        LAS char* Kb = lds + A_K + buf * KBYTES; LAS char* Vb = lds + A_V + buf * VBYTES; \
        tile_store(Kb, KP, KR, tid); tile_store(Vb, VP, VR, tid); \
        __syncthreads(); \
        if ((kt_) + 2 < nt) { tile_prefetch(KR, Kg + (size_t)(((kt_) + 2) * 64) * INC, tid); tile_prefetch(VR, Vg + (size_t)(((kt_) + 2) * 64) * INC, tid); } \
        const int k0 = (kt_) * 64; \
        if (k0 <= qw + 31) { \
            const bool far = (qw - (k0 + 63)) >= 128; const float bfar = bt[128]; \
            const bool two = (k0 + 32 <= qw + 31); \
            const LAS char* kp = Kb + r * KP + 16 * h + 128 * mp; \
            bf16x8 Pa, Pb, Pc, Pd; \
            f32x16 c0 = diff_qk(kp, qp), c1; \
            if (two) c1 = diff_qk(kp + 32 * KP, qp); \
            diff_sm(c0, far, bfar, bt, q, k0 + 4 * h, m, l, o, Pa, Pb); \
            pv_half(o, Vb, 0, Pa, Pb, lane); \
            if (two) { diff_sm(c1, far, bfar, bt, q, k0 + 32 + 4 * h, m, l, o, Pc, Pd); pv_half(o, Vb, 1, Pc, Pd, lane); } \
            __builtin_amdgcn_sched_barrier(0); \
        } } while (0)
#pragma unroll 1
    for (int kt = 0; kt < nt; kt += 2) { DIFF_TILE(kt, krA, vrA); DIFF_TILE(kt + 1, krB, vrB); }
#undef DIFF_TILE
    l += __shfl_xor(l, 32);
    const float inv = (mp ? lam : 1.0f) / l;
    __syncthreads();
    LAS float* EX = (LAS float*)(lds + rg * 16384) + lane;
    if (mp == 1) {
#pragma unroll
        for (int d = 0; d < 4; ++d)
#pragma unroll
            for (int i = 0; i < 16; ++i) EX[(16 * d + i) * 64] = o[d][i] * inv; }
    __syncthreads();
    if (mp == 0) {
        float ss = 0.f;
#pragma unroll
        for (int db = 0; db < 4; ++db)
#pragma unroll
            for (int i = 0; i < 16; ++i) { const float v = o[db][i] * inv - EX[(16 * db + i) * 64]; o[db][i] = v; ss += v * v; }
        ss += __shfl_xor(ss, 32);
        const float rs = outscale / sqrtf(ss * (1.0f / 128.0f) + EPS);
        bf16* Og = MIX + (rowb + q) * DM + MIX_DIFF + hd * 128 + 4 * h;
#pragma unroll
        for (int db = 0; db < 4; ++db)
#pragma unroll
            for (int g = 0; g < 4; ++g) { const f32x4 gg = *(const f32x4*)(subg + 32 * db + 8 * g + 4 * h);
                u32x2 ov; ov.x = cvtpk(o[db][4 * g] * rs * gg.x, o[db][4 * g + 1] * rs * gg.y); ov.y = cvtpk(o[db][4 * g + 2] * rs * gg.z, o[db][4 * g + 3] * rs * gg.w); *(u32x2*)(Og + 32 * db + 8 * g) = ov; }
    }
    __syncthreads();
}

constexpr int S_E = 0, S_XT = 16384, S_XTB = 32 * KP;
__device__ __forceinline__ float gelu_tanh(float y) {
    const float a = 0.7978845608028654f * (y + 0.044715f * y * y * y);
    const float t = 1.0f - 2.0f / (__expf(2.0f * a) + 1.0f);
    return 0.5f * y * (1.0f + t);
}
#define SSM_BU(uf_) \
    f32x16 a_re, b_re, a_im, b_im; \
    { f32x16 z; _Pragma("unroll") for (int i = 0; i < 16; ++i) z[i] = 0.f; \
      a_re = MFMA32(uf_, bfrag[0], z); b_re = MFMA32(uf_, bfrag[1], z); a_im = MFMA32(uf_, bfrag[2], z); b_im = MFMA32(uf_, bfrag[3], z); \
      _Pragma("unroll") for (int i = 0; i < 16; ++i) { \
          auto s1 = __builtin_amdgcn_permlane32_swap(__float_as_uint(a_re[i]), __float_as_uint(b_re[i]), false, false); a_re[i] = __uint_as_float(s1[0]); b_re[i] = __uint_as_float(s1[1]); \
          auto s2 = __builtin_amdgcn_permlane32_swap(__float_as_uint(a_im[i]), __float_as_uint(b_im[i]), false, false); a_im[i] = __uint_as_float(s2[0]); b_im[i] = __uint_as_float(s2[1]); } }
#define SSM_ADV(bur_, bui_) do { const float nxr = lr * xr - li * xi + (bur_), nxi = lr * xi + li * xr + (bui_); xr = nxr; xi = nxi; } while (0)
__device__ __forceinline__ void ssm_unit(LAS char* lds, int l, const bf16* PROJ, bf16* YSB, int b, int g, unsigned* done_cnt) {
    int tid_o = threadIdx.x; asm volatile("" : "+v"(tid_o)); const int tid = tid_o, lane = tid & 63, r = lane & 31, h = lane >> 5, w = __builtin_amdgcn_readfirstlane(tid >> 6);
    const int lg = l * 32 + g;
    const size_t rowb = (size_t)b * SEQ;
    LAS float* E = (LAS float*)(lds + S_E);
    LAS char* XT = lds + S_XT + w * S_XTB;
    const int trow = 16 * ((r >> 2) & 1) + (r & 3) + 4 * (r >> 3);
    const float ar = IN(8)[lg * 64 + lane], ai = IN(9)[lg * 64 + lane], dt = expf(IN(10)[lg]);
    const float mag = expf(ar * dt); const float lr = mag * cosf(ai * dt), li = mag * sinf(ai * dt);
    const float den = ar * ar + ai * ai;
    const float fr = ((lr - 1.0f) * ar + li * ai) / den, fi = (li * ar - (lr - 1.0f) * ai) / den;
    bf16x8 bfrag[4];
    { float bbr[16], bbi[16], pbr[16], pbi[16];
      const f32x4* br4 = (const f32x4*)(IN(11) + ((size_t)lg * 64 + lane) * 16); const f32x4* bi4 = (const f32x4*)(IN(12) + ((size_t)lg * 64 + lane) * 16);
#pragma unroll
      for (int j = 0; j < 4; ++j) { const f32x4 br = br4[j], bi = bi4[j];
#pragma unroll
          for (int e = 0; e < 4; ++e) { bbr[4 * j + e] = fr * br[e] - fi * bi[e]; bbi[4 * j + e] = fr * bi[e] + fi * br[e]; } }
#pragma unroll
      for (int c = 0; c < 16; ++c) { pbr[c] = __shfl_xor(bbr[c], 32); pbi[c] = __shfl_xor(bbi[c], 32); }
#pragma unroll
      for (int nb = 0; nb < 4; ++nb) { const bool own = ((nb & 1) == h); float v[8];
#pragma unroll
          for (int j = 0; j < 8; ++j) { const float o_ = (nb < 2) ? (h ? bbr[8 + j] : bbr[j]) : (h ? bbi[8 + j] : bbi[j]); const float p_ = (nb < 2) ? (h ? pbr[8 + j] : pbr[j]) : (h ? pbi[8 + j] : pbi[j]); v[j] = own ? o_ : p_; }
          u32x4 pk; pk.x = cvtpk(v[0], v[1]); pk.y = cvtpk(v[2], v[3]); pk.z = cvtpk(v[4], v[5]); pk.w = cvtpk(v[6], v[7]); bfrag[nb] = __builtin_bit_cast(bf16x8, pk); } }
    bf16x8 cmf[9];
#pragma unroll
    for (int s = 0; s < 8; ++s) { u32x4 pk = {0u, 0u, 0u, 0u};
        if (r < 16) { const float* src = (s < 4 ? IN(13) : IN(14)) + ((size_t)lg * 16 + r) * 64 + 16 * (s & 3) + 8 * h; const float sg = s < 4 ? 1.0f : -1.0f;
            const f32x4 a = *(const f32x4*)src * sg, c = *(const f32x4*)(src + 4) * sg;
            pk.x = cvtpk(a.x, a.y); pk.y = cvtpk(a.z, a.w); pk.z = cvtpk(c.x, c.y); pk.w = cvtpk(c.z, c.w); }
        cmf[s] = __builtin_bit_cast(bf16x8, pk); }
    { const float dsk = IN(15)[lg * 16 + (r & 15)]; float v[8];
#pragma unroll
      for (int j = 0; j < 8; ++j) v[j] = (r < 16 && (8 * h + j) == r) ? dsk : 0.f;
      u32x4 pk; pk.x = cvtpk(v[0], v[1]); pk.y = cvtpk(v[2], v[3]); pk.z = cvtpk(v[4], v[5]); pk.w = cvtpk(v[6], v[7]); cmf[8] = __builtin_bit_cast(bf16x8, pk); }
    float l64r = lr, l64i = li;
#pragma unroll
    for (int s = 0; s < 6; ++s) { const float nr = l64r * l64r - l64i * l64i, ni = 2.0f * l64r * l64i; l64r = nr; l64i = ni; }
#define SSM_UADDR(bi_) (PROJ + (rowb + 64 * (w + 8 * ((bi_) >> 1)) + 32 * ((bi_) & 1) + trow) * INC + C_U + g * 16 + 8 * h)
    {
        bf16x8 ufc = *(const bf16x8*)SSM_UADDR(0);
        float xr = 0.f, xi = 0.f;
#pragma unroll 1
        for (int bi = 0; bi < 8; ++bi) {
            const bf16x8 ufn = *(const bf16x8*)SSM_UADDR(bi < 7 ? bi + 1 : 7);
            SSM_BU(ufc)
#pragma unroll
            for (int i = 0; i < 16; ++i) SSM_ADV(a_re[i], a_im[i]);
#pragma unroll
            for (int i = 0; i < 16; ++i) SSM_ADV(b_re[i], b_im[i]);
            if (bi & 1) { const int k = w + 8 * (bi >> 1); E[k * 128 + lane] = xr; E[k * 128 + 64 + lane] = xi; xr = 0.f; xi = 0.f; }
            ufc = ufn;
        }
    }
    __syncthreads();
    LAS char* xw = XT + 2 * lane;
    const LAS char* xrd = XT + r * KP + 16 * h;
    {
        float cr = 0.f, ci = 0.f;
#pragma unroll 1
        for (int k = 0; k < w; ++k) { const float er = E[k * 128 + lane], ei = E[k * 128 + 64 + lane]; const float nr = l64r * cr - l64i * ci + er, ni = l64r * ci + l64i * cr + ei; cr = nr; ci = ni; }
        bf16x8 ufc = *(const bf16x8*)SSM_UADDR(0);
        float xr = cr, xi = ci;
#pragma unroll 1
        for (int bi = 0; bi < 8; ++bi) {
            const bf16x8 ufn = *(const bf16x8*)SSM_UADDR(bi < 7 ? bi + 1 : 7);
            const size_t row0 = rowb + 64 * (w + 8 * (bi >> 1)) + 32 * (bi & 1);
            { SSM_BU(ufc)
#pragma unroll
              for (int i = 0; i < 16; ++i) { SSM_ADV(a_re[i], a_im[i]); const unsigned pk = cvtpk(xr, xi); const int rho = 8 * (i >> 2) + (i & 3);
                  *(LAS unsigned short*)(xw + rho * KP) = (unsigned short)pk; *(LAS unsigned short*)(xw + rho * KP + 128) = (unsigned short)(pk >> 16); }
#pragma unroll
              for (int i = 0; i < 16; ++i) { SSM_ADV(b_re[i], b_im[i]); const unsigned pk = cvtpk(xr, xi); const int rho = 8 * (i >> 2) + 4 + (i & 3);
                  *(LAS unsigned short*)(xw + rho * KP) = (unsigned short)pk; *(LAS unsigned short*)(xw + rho * KP + 128) = (unsigned short)(pk >> 16); } }
            WAVE_SYNC();
            f32x16 y;
#pragma unroll
            for (int i = 0; i < 16; ++i) y[i] = 0.f;
            y = MFMA32(cmf[8], ufc, y);
#pragma unroll
            for (int s = 0; s < 8; ++s) { const bf16x8 xa = *(const LAS bf16x8*)(xrd + 32 * s); y = MFMA32(cmf[s], xa, y); }
            {
                bf16* yo = YSB + (row0 + trow) * 512 + g * 16 + 4 * h;
                u32x2 w0, w1;
                w0.x = pk2(gelu_tanh(y[0]), gelu_tanh(y[1])); w0.y = pk2(gelu_tanh(y[2]), gelu_tanh(y[3]));
                w1.x = pk2(gelu_tanh(y[4]), gelu_tanh(y[5])); w1.y = pk2(gelu_tanh(y[6]), gelu_tanh(y[7]));
                *(u32x2*)yo = w0; *(u32x2*)(yo + 8) = w1;
            }
            WAVE_SYNC();
            if ((bi & 1) && bi < 7) {
                const int k0c = w + 8 * (bi >> 1);
#pragma unroll 1
                for (int k = k0c; k < k0c + 8; ++k) { const float er = E[k * 128 + lane], ei = E[k * 128 + 64 + lane]; const float nr = l64r * cr - l64i * ci + er, ni = l64r * ci + l64i * cr + ei; cr = nr; ci = ni; }
                xr = cr; xi = ci;
            }
            ufc = ufn;
        }
    }
    asm volatile("s_waitcnt vmcnt(0)" ::: "memory");
    __syncthreads();
    if (tid == 0) { __builtin_amdgcn_fence(__ATOMIC_RELEASE, "agent"); asm volatile("s_waitcnt vmcnt(0)" ::: "memory"); __hip_atomic_fetch_add(done_cnt, 1u, __ATOMIC_RELAXED, __HIP_MEMORY_SCOPE_AGENT); }
}
#undef SSM_UADDR
#undef SSM_BU
#undef SSM_ADV
constexpr int I_G = (DM / 64) * (FF / 32), I_D = (FF / 64) * (DM / 32), I_IN = (DM / 64) * (INC / 32), I_OUT = (DM / 64) * (DM / 32), I_GLU = (512 / 64) * (512 / 32);
constexpr int CV_PER_LAYER = 4 * I_G + 2 * I_D + I_IN + I_OUT + I_GLU, CV_TOTAL = NLAYER * CV_PER_LAYER;
static_assert(CV_TOTAL % 8 == 0 && (2 * I_G) % 8 == 0, "batches of 8");
__device__ __forceinline__ void convert_item(int it, unsigned char* wsb, LAS float* scr, int lane) {
    const int l = it / CV_PER_LAYER; int r = it % CV_PER_LAYER;
    unsigned char* lw0 = wsb + WS_W + (size_t)l * LW_SIZE;
    if (r < I_G) { transpose_item(IN(2) + (size_t)l * DM * FF, DM, FF, (bf16*)(lw0 + LW_GU1), 1, scr, r, lane); return; } r -= I_G;
    if (r < I_G) { transpose_item(IN(3) + (size_t)l * DM * FF, DM, FF, (bf16*)(lw0 + LW_GU1), 2, scr, r, lane); return; } r -= I_G;
    if (r < I_D) { transpose_item(IN(4) + (size_t)l * FF * DM, FF, DM, (bf16*)(lw0 + LW_D1), 0, scr, r, lane); return; } r -= I_D;
    if (r < I_IN) { transpose_item(IN(7) + (size_t)l * DM * INC, DM, INC, (bf16*)(lw0 + LW_IN), 0, scr, r, lane); return; } r -= I_IN;
    if (r < I_OUT) { transpose_item(IN(24) + (size_t)l * DM * DM, DM, DM, (bf16*)(lw0 + LW_OUT), 0, scr, r, lane); return; } r -= I_OUT;
    if (r < I_GLU) { transpose_item(IN(16) + (size_t)l * 512 * 512, 512, 512, (bf16*)(lw0 + LW_GLU), 0, scr, r, lane); return; } r -= I_GLU;
    if (r < I_G) { transpose_item(IN(27) + (size_t)l * DM * FF, DM, FF, (bf16*)(lw0 + LW_GU2), 1, scr, r, lane); return; } r -= I_G;
    if (r < I_G) { transpose_item(IN(28) + (size_t)l * DM * FF, DM, FF, (bf16*)(lw0 + LW_GU2), 2, scr, r, lane); return; } r -= I_G;
    transpose_item(IN(29) + (size_t)l * FF * DM, FF, DM, (bf16*)(lw0 + LW_D2), 0, scr, r, lane);
}
__device__ __forceinline__ void convert_static(int start, int end, int b0, int nb, unsigned char* wsb, LAS unsigned char* lds) {
    const int ib = (int)blockIdx.x - b0; if (ib < 0 || ib >= nb) return;
    int tid_o = threadIdx.x; asm volatile("" : "+v"(tid_o)); const int lane = tid_o & 63, wave = __builtin_amdgcn_readfirstlane(tid_o >> 6);
    LAS float* scr = (LAS float*)(lds + wave * 16384);
#pragma unroll 1
    for (int it = start + ib * NWAVES + wave; it < end; it += nb * NWAVES) convert_item(it, wsb, scr, lane);
}
__device__ __forceinline__ void convert_batch64(int c0, unsigned char* wsb, LAS unsigned char* lds) {
    int tid_o = threadIdx.x; asm volatile("" : "+v"(tid_o)); const int lane = tid_o & 63, wave = __builtin_amdgcn_readfirstlane(tid_o >> 6);
    LAS float* scr = (LAS float*)(lds + wave * 16384);
#pragma unroll 1
    for (int j = 0; j < 8; ++j) convert_item(c0 + 8 * wave + j, wsb, scr, lane);
}
#ifndef CV_UPFRONT
#define CV_UPFRONT 1
#endif
#if CV_UPFRONT
constexpr int CV_P0_END = CV_TOTAL, CV_A_END = CV_TOTAL, CV_B_END = CV_TOTAL, CV_M_END = CV_TOTAL, CV_MB = 0;
#else
constexpr int CV_P0_END = 2 * I_G;
constexpr int CV_A_END = 4 * I_G + I_D + I_IN + I_OUT + I_GLU - 2 * I_G + 2048;
constexpr int CV_B_END = CV_PER_LAYER;
constexpr int CV_M_END = CV_PER_LAYER + 2 * I_G + I_D + I_IN + I_OUT + I_GLU;
constexpr int CV_MB = (CV_M_END - CV_B_END) / 64;
#endif
static_assert((CV_M_END - CV_B_END) % 64 == 0, "mixer-phase conversion batches");
#ifndef PHASE_MASK
#define PHASE_MASK 0xFFFF
#endif
#define PH(k) if constexpr (((PHASE_MASK) >> (k)) & 1)
#ifndef MK_SYNC
#define MK_SYNC() do { XcdBarrier xb_; xb_.bar = (unsigned*)ws + 1024; xb_.x = xb_xcc_id(); xb_.st = (volatile LAS unsigned*)(lds + LDS_BYTES - 32); xcd_barrier(xb_); } while (0)
#endif
#ifndef CV_P0_LIM
#define CV_P0_LIM (2 * I_G)
#endif
#ifndef CV_LIM_GU1
#define CV_LIM_GU1 32000
#endif
#ifndef CV_LIM_WIN
#define CV_LIM_WIN 52000
#endif
#ifndef CV_LIM_MIX
#define CV_LIM_MIX 64000
#endif
__global__ void __launch_bounds__(NTHREADS, 2) fwd_megakernel(Args args) {
    extern __shared__ __attribute__((aligned(16))) unsigned char lds_raw[];
    cg::grid_group grid = cg::this_grid();
    LAS unsigned char* lds = (LAS unsigned char*)lds_raw;
    const int G = gridDim.x, bid = blockIdx.x, ngw = G * NWAVES;
    if (threadIdx.x < 2) ((volatile LAS unsigned*)(lds + LDS_BYTES - 32))[threadIdx.x] = 0u;
    __syncthreads();
    (void)xcd_barrier_post((unsigned*)(kargs_ptr()->ws) + 1024, (volatile LAS unsigned*)(lds + LDS_BYTES - 32));
#define LANE_SETUP() int tid_o = threadIdx.x; asm volatile("" : "+v"(tid_o)); const int lane = tid_o & 63, wave = __builtin_amdgcn_readfirstlane(tid_o >> 6), gw = bid * NWAVES + wave; (void)gw; (void)lane
#define ws (kargs_ptr()->ws)
#define XN ((bf16*)(ws + WS_XN))
#define BIG ((bf16*)(ws + WS_BIG))
#define Y ((bf16*)(ws + WS_Y))
#define MIX ((bf16*)(ws + WS_MIX))
#define YS ((float*)(ws + WS_YS))
#define YSB ((bf16*)(ws + WS_YSB))
#define H (kargs_ptr()->out)

    { convert_static(0, CV_P0_END, 0, G, ws, lds);
      PH(0) { LANE_SETUP();
        row_pass(nullptr, IN(0), nullptr, XN, nullptr, 0.f, IN(1), gw, ngw, lane); }
    }
    if (__builtin_expect(kargs_ptr()->out == nullptr, 0)) grid.sync();
    MK_SYNC();

#pragma unroll 1
    for (int l = 0; l < NLAYER; ++l) {
#define lw (ws + WS_W + (size_t)l * LW_SIZE)
#pragma unroll 1
        for (int f = 0; f < 2; ++f) {
            PH(1) { pg8::Gemm g{XN, (const bf16*)(lw + (f ? LW_GU2 : LW_GU1)), M, 2 * FF, DM}; pg8::StaticOrder S; S.init(M, 2 * FF, G, bid);
              pg8::EpiSwiGLU E{BIG, FF};
              pg8::gemm_phase<pg8::EpiSwiGLU, pg8::StaticOrder, true, true>(lds, g, S, E); }
            MK_SYNC();
            PH(2) { pg8::Gemm g{BIG, (const bf16*)(lw + (f ? LW_D2 : LW_D1)), M, DM, FF}; pg8::StaticOrder S; S.init(M, DM, G, bid);
              pg8::EpiBf16Plain E{Y, DM};
              pg8::gemm_phase<pg8::EpiBf16Plain, pg8::StaticOrder, true, true>(lds, g, S, E); }
            MK_SYNC();
            PH(3) { LANE_SETUP(); const float* gpost = (f ? IN(30) : IN(5)) + (size_t)l * DM;
              const float* gpre = f == 0 ? IN(6) + (size_t)l * DM : (l + 1 < NLAYER ? IN(1) + (size_t)(l + 1) * DM : nullptr);
              row_pass(Y, (l == 0 && f == 0) ? IN(0) : (const float*)H, H, XN, gpost, 0.5f, gpre, gw, ngw, lane); }
            if (f == 1) break;
            MK_SYNC();
            PH(4) { pg8::Gemm g{XN, (const bf16*)(lw + LW_IN), M, INC, DM}; pg8::StaticOrder S; S.init(M, INC, G, bid);
              pg8::EpiBf16Plain E{BIG, INC};
              pg8::gemm_phase<pg8::EpiBf16Plain, pg8::StaticOrder, true, true>(lds, g, S, E); }
            MK_SYNC();
#ifndef MIX_REPS
#define MIX_REPS 1
#endif
            {
                LANE_SETUP();
                const float lambda_init = 0.8f - 0.6f * expf(-0.3f * (float)l);
                const float d1 = wave_sum(IN(18)[l * 64 + lane] * IN(19)[l * 64 + lane]);
                const float d2 = wave_sum(IN(20)[l * 64 + lane] * IN(21)[l * 64 + lane]);
                const float lam = expf(d1) - expf(d2) + lambda_init;
                volatile LAS int* slot = (volatile LAS int*)(lds + LDS_BYTES - 64);
                const unsigned myx = xb_xcc_id() & 7u;
#pragma unroll 1
                for (unsigned xo = 0; xo < 8; ++xo) {
                    const int x = (int)((myx + xo) & 7u);
                    unsigned* ctr = (unsigned*)ws + 64 * (l * 8 + x);
                    for (;;) {
                        if (tid_o == 0) *slot = (int)atomicAdd(ctr, 1u);
                        __syncthreads();
                        const int item = *slot;
                        __syncthreads();
                        if (item >= 64) break;
                        if (item < 24 || item >= 40) { PH(5) { const int di = item < 24 ? item : item - 16; const int qb = 15 - (di / 3), bh = 8 * (di % 3) + x;
                            diff_unit((LAS char*)lds, BIG, MIX, IN(23), lam, 1.0f - lambda_init, IN(22) + (size_t)l * 128, bh / 6, bh % 6, qb); } }
                        else { PH(6) { const int u = 8 * (item - 24) + x; ssm_unit((LAS char*)lds, l, BIG, YSB, u / 32, u % 32, (unsigned*)ws + 6144 + 64 * (l * 4 + u / 32)); } }
                    }
                }
            }
            PH(7) { int tid_o = threadIdx.x; asm volatile("" : "+v"(tid_o));
                volatile LAS int* slot = (volatile LAS int*)(lds + LDS_BYTES - 64);
                const unsigned myx = xb_xcc_id() & 7u;
#pragma unroll 1
                for (unsigned xo = 0; xo < 8; ++xo) {
                    const int x = (int)((myx + xo) & 7u);
                    unsigned* ctr = (unsigned*)ws + 4608 + 64 * (l * 8 + x);
                    for (;;) {
                        if (tid_o == 0) *slot = (int)atomicAdd(ctr, 1u);
                        __syncthreads();
                        const int item = *slot;
                        __syncthreads();
                        if (item >= 24) break;
                        const int qb = 7 - (item / 3), bh = 8 * (item % 3) + x; sb_unit((LAS char*)lds, BIG, MIX, bh / 6, bh % 6, qb);
                    }
                }
            }
            PH(8) { int tid_o = threadIdx.x; asm volatile("" : "+v"(tid_o));
                volatile LAS int* slot = (volatile LAS int*)(lds + LDS_BYTES - 64);
                unsigned* ctr = (unsigned*)ws + 5632 + 64 * l;
                for (;;) {
                    if (tid_o == 0) *slot = (int)atomicAdd(ctr, 1u);
                    __syncthreads();
                    const int item = *slot;
                    __syncthreads();
                    if (item >= 64) break;
                    pg8::Gemm g{YSB, (const bf16*)(lw + LW_GLU), M, 512, 512};
                    pg8::GatedUnit S1{pg8::Unit{item >> 1, item & 1}, (unsigned*)ws + 6144 + 64 * (l * 4 + (item >> 4)), 32u};
                    pg8::EpiGlu E{MIX + MIX_SSM, DM, YSB, 512, IN(17) + (size_t)l * 512};
                    pg8::gemm_phase<pg8::EpiGlu, pg8::GatedUnit, true, true>(lds, g, S1, E);
                    __syncthreads();
                }
            }
            MK_SYNC();
            PH(9) { pg8::Gemm g{MIX, (const bf16*)(lw + LW_OUT), M, DM, DM}; pg8::StaticOrder S; S.init(M, DM, G, bid);
              pg8::EpiBf16Plain E{Y, DM};
              pg8::gemm_phase<pg8::EpiBf16Plain, pg8::StaticOrder, true, true>(lds, g, S, E); }
            MK_SYNC();
            PH(3) { LANE_SETUP(); row_pass(Y, H, H, XN, IN(25) + (size_t)l * DM, 1.0f, IN(26) + (size_t)l * DM, gw, ngw, lane); }
            MK_SYNC();
        }
        if (l + 1 < NLAYER) MK_SYNC();
    }
}

#undef ws
#undef XN
#undef BIG
#undef Y
#undef MIX
#undef YS
#undef YSB
#undef H
#undef lw
extern "C" void kernel_launch(void* const* d_in, const int* in_sizes, int n_in, void* d_out, int out_size, void* d_ws, size_t ws_size, hipStream_t stream) {
    static int grid = 0;
    if (grid == 0) {
        if (n_in != 31 || out_size != M * DM || ws_size < WS_END) { fprintf(stderr, "kernel_launch: unexpected shapes (n_in %d, out %d, ws %zu < %zu)\n", n_in, out_size, ws_size, (size_t)WS_END); grid = -1; return; }
        int dev = 0, cus = 0, per_cu = 0;
        hipGetDevice(&dev); hipDeviceGetAttribute(&cus, hipDeviceAttributeMultiprocessorCount, dev);
        if (hipFuncSetAttribute((const void*)fwd_megakernel, hipFuncAttributeMaxDynamicSharedMemorySize, LDS_BYTES) != hipSuccess) { fprintf(stderr, "kernel_launch: hipFuncSetAttribute failed\n"); grid = -1; return; }
        hipOccupancyMaxActiveBlocksPerMultiprocessor(&per_cu, (const void*)fwd_megakernel, NTHREADS, LDS_BYTES);
        if (per_cu < 1) { fprintf(stderr, "kernel_launch: occupancy query says %d blocks per CU\n", per_cu); per_cu = 1; }
        (void)hipGetLastError();
        grid = cus * 1;
    }
    if (grid < 0) return;
    if (hipMemsetAsync(d_ws, 0, 65536, stream) != hipSuccess) { fprintf(stderr, "kernel_launch: memset failed\n"); return; }
    Args a{};
    for (int i = 0; i < 31; ++i) a.in[i] = (const float*)d_in[i];
    a.out = (float*)d_out; a.ws = (unsigned char*)d_ws;
    void* kargs[] = {&a};
    hipError_t e = hipLaunchCooperativeKernel((const void*)fwd_megakernel, dim3(grid), dim3(NTHREADS), kargs, LDS_BYTES, stream);
    if (e != hipSuccess) fprintf(stderr, "kernel_launch: cooperative launch failed: %s (grid %d)\n", hipGetErrorString(e), grid);
}
```

```cpp
#include <hip/hip_runtime.h>
#include <cstdio>
#include <cstdint>
namespace pg8 {
#define PG8_LAS __attribute__((address_space(3)))
typedef unsigned short bf16_t;
typedef short bf16x8 __attribute__((ext_vector_type(8)));
typedef float f32x4 __attribute__((ext_vector_type(4)));
typedef unsigned u32x4 __attribute__((ext_vector_type(4)));
constexpr int BM = 256, BK = 64, HALF = 128, HTB = HALF * BK * 2  , STAGE_BYTES = 8 * HTB, NXCD = 8, WGM = 8;

__host__ __device__ __forceinline__ int lds_byte(int r, int c) { const int st = (r >> 4) * 2 + (c >> 5), rr = r & 15, cc = c & 31, ob = rr * 64 + cc * 2; return st * 1024 + (ob ^ (((ob >> 9) & 1) << 5)); }
__host__ __device__ __forceinline__ void stage_rc(int b, int& R, int& C) { const int st = b / 1024, sb = b % 1024, swz = sb ^ (((sb >> 9) & 1) << 5); R = (st >> 1) * 16 + swz / 64; C = (st & 1) * 32 + (swz % 64) / 2; }
__host__ __device__ __forceinline__ int perm32(int rho) { const int n = rho >> 4, i = rho & 15; return 8 * (i >> 2) + 4 * n + (i & 3); }

struct Unit { int pm, pn; };
struct Gemm { const bf16_t* A; const bf16_t* Bt; int M, N, K; };

struct StaticOrder {
    int nM, nN, nwg, G, c;
    __host__ __device__ void init(int M, int N, int G_, int c_) { nM = M / BM; nN = N / BM; nwg = nM * nN; G = G_; c = c_; }
    __host__ __device__ bool next(int i, Unit& u) const {
        const long L = (long)i * G + c; if (L >= nwg) return false;
        int wgid = (int)L; { const int q = nwg / NXCD, r = nwg % NXCD, xcd = wgid % NXCD, off = wgid / NXCD; wgid = (xcd < r ? xcd * (q + 1) : r * (q + 1) + (xcd - r) * q) + off; }
        const int nig = WGM * nN, gid = wgid / nig, fm = gid * WGM, gsz = (nM - fm) < WGM ? (nM - fm) : WGM;
        u.pm = fm + ((wgid % nig) % gsz); u.pn = (wgid % nig) / gsz; return true;
    }
    __device__ __forceinline__ void a_ready(const Unit&) const {}
    __device__ __forceinline__ void done(const Unit&) const {}
};

__device__ __forceinline__ unsigned cvt_pk_bf16(float lo, float hi) { unsigned r; asm volatile("v_cvt_pk_bf16_f32 %0, %1, %2" : "=v"(r) : "v"(lo), "v"(hi)); return r; }
typedef float f32x2 __attribute__((ext_vector_type(2)));
__device__ __forceinline__ f32x2 gelu_pk(f32x2 v) {
    const f32x2 av = __builtin_elementwise_abs(v), d = av * 0.2316418882f + 1.0f;
    f32x2 t; t.x = __builtin_amdgcn_rcpf(d.x); t.y = __builtin_amdgcn_rcpf(d.y);
    f32x2 q = t * 0.5307027145f + (-0.7265760135f); q = q * t + 0.7107068705f; q = q * t + (-0.142248368f); q = q * t + 0.127414796f; q = q * t;
    const f32x2 s = (v * v) * (-0.72134752044f);
    f32x2 e; e.x = __builtin_amdgcn_exp2f(s.x); e.y = __builtin_amdgcn_exp2f(s.y);
    const f32x2 m = v * (q * e), r = v - m;
    f32x2 o; o.x = v.x < 0.f ? m.x : r.x; o.y = v.y < 0.f ? m.y : r.y; return o;
}

template <int ACT  > struct EpiBf16 {
    static constexpr bool PERM = true, AFTER_DRAIN = false; static_assert(ACT == 0 || ACT == 1, "EpiBf16: ACT is 0 (none) or 1 (gelu_pk)");
    bf16_t* O; int ldc; const float* bias; int split_cols; size_t split_stride; float scale0;
    __device__ __forceinline__ void operator()(const f32x4 (&acc)[2][2][4][2], const Unit& u, int wr, int wc, int fr, int fq) const {
        const int row0 = u.pm * BM + wr * 64 + fr; int colt = u.pn * BM; bf16_t* base = O;
        float sc = 1.f; if (split_cols) { const int t = colt / split_cols; base += (size_t)t * split_stride; colt -= t * split_cols; if (t == 0) sc = scale0; }
        const int col0 = colt + wc * 32 + 8 * fq, bcol0 = u.pn * BM + wc * 32 + 8 * fq;
        f32x4 bv[2][2];
#pragma unroll
        for (int bj = 0; bj < 2; ++bj)
#pragma unroll
            for (int n = 0; n < 2; ++n) bv[bj][n] = bias ? *(const f32x4*)(bias + bcol0 + bj * HALF + 4 * n) : (f32x4){0.f, 0.f, 0.f, 0.f};
#pragma unroll
        for (int ai = 0; ai < 2; ++ai)
#pragma unroll
            for (int m = 0; m < 4; ++m) { bf16_t* rowp = base + (size_t)(row0 + ai * HALF + m * 16) * ldc + col0;
#pragma unroll
                for (int bj = 0; bj < 2; ++bj) { f32x4 v0 = acc[ai][bj][m][0] + bv[bj][0], v1 = acc[ai][bj][m][1] + bv[bj][1];
                    if (ACT == 1) { f32x2 a = gelu_pk((f32x2){v0[0], v0[1]}), b = gelu_pk((f32x2){v0[2], v0[3]}), c = gelu_pk((f32x2){v1[0], v1[1]}), d = gelu_pk((f32x2){v1[2], v1[3]});
                        v0 = (f32x4){a.x, a.y, b.x, b.y}; v1 = (f32x4){c.x, c.y, d.x, d.y}; }
                    v0 = v0 * sc; v1 = v1 * sc; u32x4 w; w.x = cvt_pk_bf16(v0[0], v0[1]); w.y = cvt_pk_bf16(v0[2], v0[3]); w.z = cvt_pk_bf16(v1[0], v1[1]); w.w = cvt_pk_bf16(v1[2], v1[3]);
                    *(u32x4*)(rowp + bj * HALF) = w; } }
    }
};

template <class Epi, class Sched, bool ALIGN_EPI = false, bool SP2 = false>
__device__ __forceinline__ void gemm_phase(PG8_LAS unsigned char* lds, const Gemm g, const Sched& S, const Epi& E) {
    int tid_o = threadIdx.x; asm volatile("" : "+v"(tid_o));
    const int tid = tid_o, wid = __builtin_amdgcn_readfirstlane(tid >> 6), lane = tid & 63, wr = wid >> 2, wc = wid & 3, fr = lane & 15, fq = lane >> 4;
    const int K = g.K, nt = K / BK;
    unsigned voffA[2], voffB[2];
#pragma unroll
    for (int i = 0; i < 2; ++i) { int R, C; stage_rc(tid * 16 + i * 8192, R, C); const int Rb = Epi::PERM ? ((R & ~31) + perm32(R & 31)) : R;
        voffA[i] = (unsigned)(R * K + C) * 2u; voffB[i] = (unsigned)(Rb * K + C) * 2u; }
    const size_t kstep = (size_t)(BK * 2);
    const size_t hstep = (size_t)HALF * K * 2;
    const size_t tstep = 2 * hstep;
    const unsigned ldsw = (unsigned)wid * 1024u;
    const int aoff = lds_byte(wr * 64 + fr, fq * 8), boff = lds_byte(wc * 32 + fr, fq * 8);
#define PG8_SA(b, h) (((b) * 2 + (h)) * HTB)
#define PG8_SB(b, h) ((4 + (b) * 2 + (h)) * HTB)
#define PG8_STAGE(bufoff, gbase, voff) do { _Pragma("unroll") for (int _i = 0; _i < 2; ++_i) \
        __builtin_amdgcn_global_load_lds((const unsigned*)((const char*)(gbase) + (voff)[_i]), (PG8_LAS unsigned*)(lds + (bufoff) + ldsw + _i * 8192), 16, 0, 0); } while (0)
#define PG8_LDA(dst, b, h) do { _Pragma("unroll") for (int m = 0; m < 4; ++m) _Pragma("unroll") for (int k = 0; k < 2; ++k) dst[m][k] = *(const PG8_LAS bf16x8*)(lds + PG8_SA(b, h) + aoff + m * 2048 + k * 1024); } while (0)
#define PG8_LDB(dst, b, h) do { _Pragma("unroll") for (int n = 0; n < 2; ++n) _Pragma("unroll") for (int k = 0; k < 2; ++k) dst[n][k] = *(const PG8_LAS bf16x8*)(lds + PG8_SB(b, h) + boff + n * 2048 + k * 1024); } while (0)
#define PG8_MMA(ai, bj, At, Bt) do { __builtin_amdgcn_s_setprio(1); _Pragma("unroll") for (int m = 0; m < 4; ++m) _Pragma("unroll") for (int n = 0; n < 2; ++n) _Pragma("unroll") for (int k = 0; k < 2; ++k) \
        acc[ai][bj][m][n] = __builtin_amdgcn_mfma_f32_16x16x32_bf16(Bt[n][k], At[m][k], acc[ai][bj][m][n], 0, 0, 0); __builtin_amdgcn_s_setprio(0); } while (0)
#define PG8_WAIT_V(n) asm volatile("s_waitcnt vmcnt(" #n ")" ::: "memory")
#define PG8_WAIT_L(n) asm volatile("s_waitcnt lgkmcnt(" #n ")" ::: "memory")
#define PG8_BAR __builtin_amdgcn_s_barrier()
#define PG8_SCHED __builtin_amdgcn_sched_barrier(0)
    Unit cur, nxt; int ui = 0;
    if (!S.next(0, cur)) return;
    f32x4 acc[2][2][4][2];
#pragma unroll
    for (int a = 0; a < 2; ++a)
#pragma unroll
        for (int b = 0; b < 2; ++b)
#pragma unroll
            for (int m = 0; m < 4; ++m)
#pragma unroll
                for (int n = 0; n < 2; ++n) acc[a][b][m][n] = (f32x4){0.f, 0.f, 0.f, 0.f};
    bf16x8 At[4][2], B0[2][2], B1[2][2];
    const char* cA = (const char*)g.A + (size_t)cur.pm * tstep; const char* cB = (const char*)g.Bt + (size_t)cur.pn * tstep;
    S.a_ready(cur);
    if constexpr (SP2) {
        PG8_STAGE(PG8_SB(0, 0), cB, voffB); PG8_STAGE(PG8_SB(0, 1), cB + hstep, voffB); PG8_STAGE(PG8_SA(0, 0), cA, voffA); PG8_STAGE(PG8_SA(0, 1), cA + hstep, voffA);
        if (wr == 1) PG8_BAR;
        PG8_WAIT_V(2); PG8_BAR;
        PG8_STAGE(PG8_SB(1, 0), cB + kstep, voffB); PG8_STAGE(PG8_SA(1, 0), cA + kstep, voffA); PG8_STAGE(PG8_SB(1, 1), cB + hstep + kstep, voffB);
        PG8_WAIT_V(6); PG8_BAR;
    } else {
        PG8_STAGE(PG8_SB(0, 0), cB, voffB); PG8_STAGE(PG8_SA(0, 0), cA, voffA); PG8_STAGE(PG8_SB(0, 1), cB + hstep, voffB); PG8_STAGE(PG8_SA(0, 1), cA + hstep, voffA);
        if (wr == 1) PG8_BAR;
        PG8_WAIT_V(4); PG8_BAR;
        PG8_STAGE(PG8_SB(1, 0), cB + kstep, voffB); PG8_STAGE(PG8_SA(1, 0), cA + kstep, voffA); PG8_STAGE(PG8_SB(1, 1), cB + hstep + kstep, voffB);
        PG8_WAIT_V(6); PG8_BAR;
    }
    for (;;) {
        const bool has_next = S.next(ui + 1, nxt);
        const char* nA = has_next ? (const char*)g.A + (size_t)nxt.pm * tstep : cA; const char* nB = has_next ? (const char*)g.Bt + (size_t)nxt.pn * tstep : cB;
        for (int t = 0; t < nt; t += 2) {
            const bool last = (t == nt - 2);
            const char* a1 = cA + (size_t)(t + 1) * kstep;
            const char* a2 = last ? nA : cA + (size_t)(t + 2) * kstep; const char* b2 = last ? nB : cB + (size_t)(t + 2) * kstep;
            const char* a3 = a2 + kstep; const char* b3 = b2 + kstep;
            if (last && has_next) S.a_ready(nxt);
            if constexpr (SP2) {
            PG8_LDB(B0, 0, 0); PG8_LDB(B1, 0, 1); PG8_SCHED; PG8_LDA(At, 0, 0); PG8_STAGE(PG8_SA(1, 1), a1 + hstep, voffA);
            PG8_WAIT_V(8); PG8_WAIT_L(0); PG8_BAR; PG8_MMA(0, 0, At, B0); PG8_MMA(0, 1, At, B1); PG8_BAR; PG8_SCHED;
            PG8_LDA(At, 0, 1); PG8_STAGE(PG8_SB(0, 0), b2, voffB); PG8_STAGE(PG8_SB(0, 1), b2 + hstep, voffB); PG8_STAGE(PG8_SA(0, 0), a2, voffA);
            PG8_WAIT_V(8); PG8_WAIT_L(0); PG8_BAR; PG8_MMA(1, 0, At, B0); PG8_MMA(1, 1, At, B1); PG8_BAR; PG8_SCHED;
            PG8_LDB(B0, 1, 0); PG8_LDB(B1, 1, 1); PG8_SCHED; PG8_LDA(At, 1, 0); PG8_STAGE(PG8_SA(0, 1), a2 + hstep, voffA);
            PG8_WAIT_V(8); PG8_WAIT_L(0); PG8_BAR; PG8_MMA(0, 0, At, B0); PG8_MMA(0, 1, At, B1); PG8_BAR; PG8_SCHED;
            PG8_LDA(At, 1, 1); PG8_STAGE(PG8_SB(1, 0), b3, voffB); PG8_STAGE(PG8_SB(1, 1), b3 + hstep, voffB); PG8_STAGE(PG8_SA(1, 0), a3, voffA);
            PG8_WAIT_V(8); PG8_WAIT_L(0); PG8_BAR; PG8_MMA(1, 0, At, B0); PG8_MMA(1, 1, At, B1); PG8_BAR; PG8_SCHED;
            } else {
            PG8_LDB(B0, 0, 0); PG8_SCHED; PG8_LDA(At, 0, 0); PG8_STAGE(PG8_SA(1, 1), a1 + hstep, voffA);
            PG8_WAIT_L(8); PG8_BAR; PG8_WAIT_L(0); PG8_MMA(0, 0, At, B0); PG8_BAR; PG8_SCHED;
            PG8_LDB(B1, 0, 1); PG8_STAGE(PG8_SB(0, 0), b2, voffB);
            PG8_BAR; PG8_WAIT_L(0); PG8_MMA(0, 1, At, B1); PG8_BAR;
            PG8_LDA(At, 0, 1); PG8_STAGE(PG8_SA(0, 0), a2, voffA);
            PG8_BAR; PG8_WAIT_L(0); PG8_MMA(1, 0, At, B0); PG8_BAR; PG8_SCHED;
            PG8_STAGE(PG8_SB(0, 1), b2 + hstep, voffB);
            PG8_WAIT_V(6); PG8_BAR; PG8_MMA(1, 1, At, B1); PG8_BAR;
            PG8_LDB(B0, 1, 0); PG8_SCHED; PG8_LDA(At, 1, 0); PG8_STAGE(PG8_SA(0, 1), a2 + hstep, voffA);
            PG8_WAIT_L(8); PG8_BAR; PG8_WAIT_L(0); PG8_MMA(0, 0, At, B0); PG8_BAR; PG8_SCHED;
            PG8_LDB(B1, 1, 1); PG8_STAGE(PG8_SB(1, 0), b3, voffB);
            PG8_BAR; PG8_WAIT_L(0); PG8_MMA(0, 1, At, B1); PG8_BAR;
            PG8_LDA(At, 1, 1); PG8_STAGE(PG8_SA(1, 0), a3, voffA);
            PG8_BAR; PG8_WAIT_L(0); PG8_MMA(1, 0, At, B0); PG8_BAR; PG8_SCHED;
            PG8_STAGE(PG8_SB(1, 1), b3 + hstep, voffB);
            PG8_WAIT_V(6); PG8_BAR; PG8_MMA(1, 1, At, B1); PG8_BAR;
            }
        }
        if constexpr (ALIGN_EPI) { if (wr == 0) PG8_BAR; }
        if constexpr (!Epi::AFTER_DRAIN) { E(acc, cur, wr, wc, fr, fq); S.done(cur); }
        if (!has_next) break;
#pragma unroll
        for (int a = 0; a < 2; ++a)
#pragma unroll
            for (int b = 0; b < 2; ++b)
#pragma unroll
                for (int m = 0; m < 4; ++m)
#pragma unroll
                    for (int n = 0; n < 2; ++n) acc[a][b][m][n] = (f32x4){0.f, 0.f, 0.f, 0.f};
        cur = nxt; cA = nA; cB = nB; ++ui;
        if constexpr (ALIGN_EPI) { if (wr == 1) PG8_BAR; }
    }
    PG8_WAIT_V(0);
    if constexpr (!ALIGN_EPI) { if (wr == 0) PG8_BAR; }
    PG8_BAR;
    if constexpr (Epi::AFTER_DRAIN) { E.fused(acc, cur, wr, wc, fr, fq, lds, wid, lane); S.done(cur); }
#undef PG8_SA
#undef PG8_SB
#undef PG8_STAGE
#undef PG8_LDA
#undef PG8_LDB
#undef PG8_MMA
#undef PG8_WAIT_V
#undef PG8_WAIT_L
#undef PG8_BAR
#undef PG8_SCHED
}
}
namespace pg8 {
struct EpiSwiGLU {
    static constexpr bool PERM = true, AFTER_DRAIN = false;
    bf16_t* O; int ldc;
    __device__ __forceinline__ void operator()(const f32x4 (&acc)[2][2][4][2], const Unit& u, int wr, int wc, int fr, int fq) const {
        const int row0 = u.pm * BM + wr * 64 + fr; const int col0 = u.pn * HALF + wc * 32 + 8 * fq;
#pragma unroll
        for (int ai = 0; ai < 2; ++ai)
#pragma unroll
            for (int m = 0; m < 4; ++m) { bf16_t* rowp = O + (size_t)(row0 + ai * HALF + m * 16) * ldc + col0;
                float v[8];
#pragma unroll
                for (int n = 0; n < 2; ++n)
#pragma unroll
                    for (int i = 0; i < 4; ++i) { const float g = acc[ai][0][m][n][i], up = acc[ai][1][m][n][i];
                        const float sg = g * __builtin_amdgcn_rcpf(1.0f + __builtin_amdgcn_exp2f(-1.4426950408889634f * g)); v[4 * n + i] = sg * up; }
                u32x4 w; w.x = cvt_pk_bf16(v[0], v[1]); w.y = cvt_pk_bf16(v[2], v[3]); w.z = cvt_pk_bf16(v[4], v[5]); w.w = cvt_pk_bf16(v[6], v[7]);
                *(u32x4*)rowp = w; }
    }
};
struct EpiF32 {
    static constexpr bool PERM = true, AFTER_DRAIN = false;
    float* O; int ldc;
    __device__ __forceinline__ void operator()(const f32x4 (&acc)[2][2][4][2], const Unit& u, int wr, int wc, int fr, int fq) const {
        const int row0 = u.pm * BM + wr * 64 + fr; const int col0 = u.pn * BM + wc * 32 + 8 * fq;
#pragma unroll
        for (int ai = 0; ai < 2; ++ai)
#pragma unroll
            for (int m = 0; m < 4; ++m) { float* rowp = O + (size_t)(row0 + ai * HALF + m * 16) * ldc + col0;
#pragma unroll
                for (int bj = 0; bj < 2; ++bj) { *(f32x4*)(rowp + bj * HALF) = acc[ai][bj][m][0]; *(f32x4*)(rowp + bj * HALF + 4) = acc[ai][bj][m][1]; } }
    }
};
struct EpiGlu {
    static constexpr bool PERM = true, AFTER_DRAIN = false;
    bf16_t* O; int ldc; const bf16_t* ys; int ldy; const float* bias;
    __device__ __forceinline__ void operator()(const f32x4 (&acc)[2][2][4][2], const Unit& u, int wr, int wc, int fr, int fq) const {
        const int row0 = u.pm * BM + wr * 64 + fr; const int col0 = u.pn * BM + wc * 32 + 8 * fq;
#pragma unroll
        for (int ai = 0; ai < 2; ++ai)
#pragma unroll
            for (int m = 0; m < 4; ++m) { const int row = row0 + ai * HALF + m * 16;
#pragma unroll
                for (int bj = 0; bj < 2; ++bj) { const int col = col0 + bj * HALF;
                    const u32x4 yp = *(const u32x4*)(ys + (size_t)row * ldy + col);
                    const f32x4 b0 = *(const f32x4*)(bias + col), b1 = *(const f32x4*)(bias + col + 4);
                    const float yv[8] = {__uint_as_float(yp.x << 16), __uint_as_float(yp.x & 0xffff0000u), __uint_as_float(yp.y << 16), __uint_as_float(yp.y & 0xffff0000u),
                                         __uint_as_float(yp.z << 16), __uint_as_float(yp.z & 0xffff0000u), __uint_as_float(yp.w << 16), __uint_as_float(yp.w & 0xffff0000u)};
                    float v[8];
#pragma unroll
                    for (int i = 0; i < 4; ++i) { const float z0 = acc[ai][bj][m][0][i] + b0[i], z1 = acc[ai][bj][m][1][i] + b1[i];
                        v[i] = yv[i] * __builtin_amdgcn_rcpf(1.0f + __builtin_amdgcn_exp2f(-1.4426950408889634f * z0));
                        v[4 + i] = yv[4 + i] * __builtin_amdgcn_rcpf(1.0f + __builtin_amdgcn_exp2f(-1.4426950408889634f * z1)); }
                    u32x4 w; w.x = cvt_pk_bf16(v[0], v[1]); w.y = cvt_pk_bf16(v[2], v[3]); w.z = cvt_pk_bf16(v[4], v[5]); w.w = cvt_pk_bf16(v[6], v[7]);
                    *(u32x4*)(O + (size_t)row * ldc + col) = w; } }
    }
};
struct EpiBf16Plain {
    static constexpr bool PERM = true, AFTER_DRAIN = false;
    bf16_t* O; int ldc;
    __device__ __forceinline__ void operator()(const f32x4 (&acc)[2][2][4][2], const Unit& u, int wr, int wc, int fr, int fq) const {
        const int row0 = u.pm * BM + wr * 64 + fr; const int col0 = u.pn * BM + wc * 32 + 8 * fq;
#pragma unroll
        for (int ai = 0; ai < 2; ++ai)
#pragma unroll
            for (int m = 0; m < 4; ++m) { bf16_t* rowp = O + (size_t)(row0 + ai * HALF + m * 16) * ldc + col0;
#pragma unroll
                for (int bj = 0; bj < 2; ++bj) { const f32x4 v0 = acc[ai][bj][m][0], v1 = acc[ai][bj][m][1];
                    u32x4 w; w.x = cvt_pk_bf16(v0[0], v0[1]); w.y = cvt_pk_bf16(v0[2], v0[3]); w.z = cvt_pk_bf16(v1[0], v1[1]); w.w = cvt_pk_bf16(v1[2], v1[3]);
                    *(u32x4*)(rowp + bj * HALF) = w; } }
    }
};
struct GatedUnit {
    Unit un; unsigned* cnt; unsigned want;
    __device__ __forceinline__ bool next(int i, Unit& u) const { u = un; return i == 0; }
    __device__ __forceinline__ void a_ready(const Unit&) const {
        if (threadIdx.x == 0) { unsigned sp = 0;
            while (__hip_atomic_load(cnt, __ATOMIC_RELAXED, __HIP_MEMORY_SCOPE_AGENT) < want) { __builtin_amdgcn_s_sleep(2); if (++sp > (1u << 22)) break; }
            __builtin_amdgcn_fence(__ATOMIC_ACQUIRE, "agent"); asm volatile("s_waitcnt vmcnt(0)" ::: "memory"); }
        __syncthreads();
    }
    __device__ __forceinline__ void done(const Unit&) const {}
};
}
#include <hip/hip_cooperative_groups.h>
namespace cg = cooperative_groups;
#define LAS __attribute__((address_space(3)))
typedef unsigned short bf16;
typedef float f32x4 __attribute__((ext_vector_type(4)));
typedef float f32x16 __attribute__((ext_vector_type(16)));
typedef short bf16x8 __attribute__((ext_vector_type(8)));
typedef short s16x4 __attribute__((ext_vector_type(4)));
typedef unsigned u32x4 __attribute__((ext_vector_type(4)));
typedef unsigned u32x2 __attribute__((ext_vector_type(2)));
typedef float f32x2_t __attribute__((ext_vector_type(2)));
typedef __bf16 bf16x2_t __attribute__((ext_vector_type(2)));

constexpr int NB = 4, SEQ = 2048, DM = 2048, M = NB * SEQ, FF = 5632, INC = 5120, NLAYER = 2;
constexpr int C_SBQ = 0, C_SBK = 768, C_SBV = 1536, C_U = 2304, C_DQ = 2816, C_DK = 3584, C_DV = 4352;
constexpr int MIX_SB = 0, MIX_SSM = 768, MIX_DIFF = 1280;
constexpr float EPS = 1e-6f;
constexpr float LOG2E = 1.4426950408889634f;
constexpr int NTHREADS = 512, NWAVES = 8;
constexpr int LDS_BYTES = 148480;

constexpr size_t SZ_WGU = (size_t)2 * FF * DM * 2, SZ_WD = (size_t)DM * FF * 2, SZ_WIN = (size_t)INC * DM * 2, SZ_WOUT = (size_t)DM * DM * 2, SZ_WGLU = (size_t)512 * 512 * 2;
constexpr size_t LW_GU1 = 0, LW_D1 = LW_GU1 + SZ_WGU, LW_IN = LW_D1 + SZ_WD, LW_OUT = LW_IN + SZ_WIN, LW_GLU = LW_OUT + SZ_WOUT, LW_GU2 = LW_GLU + SZ_WGLU, LW_D2 = LW_GU2 + SZ_WGU, LW_SIZE = LW_D2 + SZ_WD;
constexpr size_t WS_W = 1u << 20;
constexpr size_t WS_XN = WS_W + NLAYER * LW_SIZE;
constexpr size_t WS_BIG = WS_XN + (size_t)M * DM * 2;
constexpr size_t WS_Y = WS_BIG + (size_t)M * FF * 2;
constexpr size_t WS_MIX = WS_Y + (size_t)M * DM * 4;
constexpr size_t WS_YS = WS_MIX + (size_t)M * DM * 2;
constexpr size_t WS_YSB = WS_YS + (size_t)M * 512 * 4;
constexpr size_t WS_END = WS_YSB + (size_t)M * 512 * 2;

struct Args { const float* in[31]; float* out; unsigned char* ws; };
typedef __attribute__((address_space(4))) const Args* KArgs;
__device__ __forceinline__ KArgs kargs_ptr() { KArgs ap = (KArgs)__builtin_amdgcn_kernarg_segment_ptr(); asm volatile("" : "+s"(ap)); return ap; }
#define IN(k) (kargs_ptr()->in[(k)])

__device__ const unsigned char T5B[128] = {0, 1, 2, 3, 4, 5, 6, 7, 8, 9, 10, 11, 12, 13, 14, 15, 16, 16, 16, 17, 17, 18, 18, 18, 19, 19, 19, 20, 20, 20, 20, 21, 21, 21, 21, 22, 22, 22, 22, 22, 23, 23, 23, 23, 23, 23, 24, 24, 24, 24, 24, 24, 25, 25, 25, 25, 25, 25, 25, 26, 26, 26, 26, 26, 26, 26, 26, 27, 27, 27, 27, 27, 27, 27, 27, 27, 27, 28, 28, 28, 28, 28, 28, 28, 28, 28, 28, 29, 29, 29, 29, 29, 29, 29, 29, 29, 29, 29, 29, 30, 30, 30, 30, 30, 30, 30, 30, 30, 30, 30, 30, 30, 30, 31, 31, 31, 31, 31, 31, 31, 31, 31, 31, 31, 31, 31, 31, 31};

#define LDS_WAIT() asm volatile("s_waitcnt lgkmcnt(0)" ::: "memory")
#define WAVE_SYNC() do { asm volatile("s_waitcnt lgkmcnt(0)" ::: "memory"); __builtin_amdgcn_wave_barrier(); } while (0)
#define MFMA32(a, b, c) __builtin_amdgcn_mfma_f32_32x32x16_bf16((a), (b), (c), 0, 0, 0)
__device__ __forceinline__ unsigned f2bf(float f) { unsigned u = __float_as_uint(f); return (u + 0x7fffu + ((u >> 16) & 1u)) >> 16; }
__device__ __forceinline__ unsigned pk2(float lo, float hi) { return f2bf(lo) | (f2bf(hi) << 16); }
__device__ __forceinline__ unsigned cvtpk(float lo, float hi) { f32x2_t v = {lo, hi}; bf16x2_t b = __builtin_convertvector(v, bf16x2_t); return __builtin_bit_cast(unsigned, b); }
__device__ __forceinline__ float bf2f(unsigned short b) { return __uint_as_float(((unsigned)b) << 16); }
__device__ __forceinline__ float wave_sum(float v) {
#pragma unroll
    for (int o = 1; o < 64; o <<= 1) v += __shfl_xor(v, o);
    return v;
}
__device__ __forceinline__ int crow(int i, int h) { return (i & 3) + 8 * (i >> 2) + 4 * h; }

#define XB_TMO      128
#define XB_XCNT(j)  (256  + 64 * (j))
#define XB_XSUB(j)  (1280 + 64 * (j))
#define XB_XGEN(j)  (2304 + 64 * (j))
#define XB_TOP      3328
#define XB_TOPGEN   3392
#define XCD_BAR_WORDS 3456
#define XB_SPIN_CAP (1u << 18)

__device__ __forceinline__ unsigned xb_ld(unsigned* p)              { return __hip_atomic_load(p, __ATOMIC_RELAXED, __HIP_MEMORY_SCOPE_AGENT); }
__device__ __forceinline__ unsigned xb_add(unsigned* p, unsigned v) { return __hip_atomic_fetch_add(p, v, __ATOMIC_RELAXED, __HIP_MEMORY_SCOPE_AGENT); }
__device__ __forceinline__ unsigned xb_xcc_id() { return (unsigned)__builtin_amdgcn_s_getreg((3 << 11) | 20) & 0xFu; }
#define XB_SPIN(cond, bar) do { unsigned _sp = 0; while (cond) { __builtin_amdgcn_s_sleep(1); \
    if ((++_sp & 255u) == 0u) { if (xb_ld(&(bar)[XB_TMO])) break; if (_sp > XB_SPIN_CAP) { atomicAdd(&(bar)[XB_TMO], 1u); break; } } } } while (0)

struct XcdBarrier {
    unsigned* bar; unsigned x;
    volatile LAS unsigned* st;
};

__device__ __forceinline__ XcdBarrier xcd_barrier_post(unsigned* bar, volatile LAS unsigned* st) {
    XcdBarrier b; b.bar = bar; b.x = xb_xcc_id(); b.st = st;
    if (threadIdx.x == 0) (void)xb_add(&bar[XB_XCNT(b.x)], 1u);
    return b;
}
__device__ __forceinline__ void xcd_barrier_complete(unsigned* bar, unsigned x, unsigned& nloc, unsigned& nx) {
    const unsigned G = gridDim.x * gridDim.y * gridDim.z;
    unsigned sum, cnt, mine, sp = 0u;
    for (;;) {
        sum = 0u; cnt = 0u; mine = 0u;
#pragma unroll
        for (unsigned j = 0; j < 16; ++j) { const unsigned c = xb_ld(&bar[XB_XCNT(j)]); sum += c; cnt += (c > 0u) ? 1u : 0u; mine = (j == x) ? c : mine; }
        if (sum == G) break;
        __builtin_amdgcn_s_sleep(1);
        if ((++sp & 255u) == 0u) { if (xb_ld(&bar[XB_TMO])) break; if (sp > XB_SPIN_CAP) { atomicAdd(&bar[XB_TMO], 1u); break; } }
    }
    nloc = mine > 0u ? mine : 1u; nx = cnt > 0u ? cnt : 1u;
}

__device__ __forceinline__ void xcd_barrier(const XcdBarrier& b) {
    asm volatile("s_waitcnt vmcnt(0)" ::: "memory");
    __syncthreads();
    if (threadIdx.x == 0) {
        unsigned* bar = b.bar;
        __builtin_amdgcn_s_waitcnt(0);
        unsigned nloc = b.st[0], nx = b.st[1];
        if (nloc == 0u) { xcd_barrier_complete(bar, b.x, nloc, nx); b.st[0] = nloc; b.st[1] = nx; }
        const unsigned old = xb_add(&bar[XB_XSUB(b.x)], 1u);
        const unsigned gen = old / nloc;
        if (old + 1u == (gen + 1u) * nloc) {
            __builtin_amdgcn_fence(__ATOMIC_RELEASE, "agent");
            asm volatile("s_waitcnt vmcnt(0)" ::: "memory");
            const unsigned og = xb_add(&bar[XB_TOP], 1u);
            const unsigned tg = og / nx;
            if (og + 1u == (tg + 1u) * nx) xb_add(&bar[XB_TOPGEN], 1u);
            else XB_SPIN(xb_ld(&bar[XB_TOPGEN]) == tg, bar);
            __builtin_amdgcn_fence(__ATOMIC_ACQUIRE, "agent");
            xb_add(&bar[XB_XGEN(b.x)], 1u);
            asm volatile("s_waitcnt vmcnt(0)" ::: "memory");
        } else {
            XB_SPIN(xb_ld(&bar[XB_XGEN(b.x)]) == gen, bar);
            __builtin_amdgcn_fence(__ATOMIC_ACQUIRE, "agent");
            asm volatile("s_waitcnt vmcnt(0)" ::: "memory");
        }
    }
    __syncthreads();
}

__device__ __forceinline__ void transpose_item(const float* __restrict__ W, int K, int N, bf16* WT, int mode, LAS float* scr, int item, int lane) {
    const int nblk = N / 32, kb = item / nblk, nb = item % nblk, k0 = 64 * kb, n0 = 32 * nb;
#pragma unroll 8
    for (int i = 0; i < 32; ++i) { const int kk = 2 * i + (lane >> 5); scr[kk * 33 + (lane & 31)] = __builtin_nontemporal_load(&W[(size_t)(k0 + kk) * N + n0 + (lane & 31)]); }
    LDS_WAIT();
    const int rb = mode == 0 ? n0 : ((n0 >> 7) * 256 + (n0 & 127) + (mode == 2 ? 128 : 0));
    const int c = lane & 7;
#pragma unroll
    for (int j = 0; j < 4; ++j) { const int n = (lane >> 3) + 8 * j; const LAS float* s = scr + (8 * c) * 33 + n;
        u32x4 o; o.x = pk2(s[0 * 33], s[1 * 33]); o.y = pk2(s[2 * 33], s[3 * 33]); o.z = pk2(s[4 * 33], s[5 * 33]); o.w = pk2(s[6 * 33], s[7 * 33]);
        *(u32x4*)(WT + (size_t)(rb + n) * K + k0 + 8 * c) = o; }
    LDS_WAIT();
}

__device__ __forceinline__ void row_pass(const bf16* Y, const float* Hin, float* Hout, bf16* XN, const float* gpost, float wres, const float* gpre, int gw, int ngw, int lane) {
    for (int m = gw; m < M; m += ngw) {
        f32x4 hv[8];
        const f32x4* hr = (const f32x4*)(Hin + (size_t)m * DM) + 2 * lane;
#pragma unroll
        for (int j = 0; j < 4; ++j) { hv[2 * j] = hr[128 * j]; hv[2 * j + 1] = hr[128 * j + 1]; }
        if (Y) {
            f32x4 yv[8]; const u32x4* yr = (const u32x4*)(Y + (size_t)m * DM) + lane; float ss = 0.f;
#pragma unroll
            for (int j = 0; j < 4; ++j) { const u32x4 p = yr[64 * j];
                yv[2 * j] = (f32x4){__uint_as_float(p.x << 16), __uint_as_float(p.x & 0xffff0000u), __uint_as_float(p.y << 16), __uint_as_float(p.y & 0xffff0000u)};
                yv[2 * j + 1] = (f32x4){__uint_as_float(p.z << 16), __uint_as_float(p.z & 0xffff0000u), __uint_as_float(p.w << 16), __uint_as_float(p.w & 0xffff0000u)}; }
#pragma unroll
            for (int j = 0; j < 8; ++j) ss += (yv[j].x * yv[j].x + yv[j].y * yv[j].y) + (yv[j].z * yv[j].z + yv[j].w * yv[j].w);
            ss = wave_sum(ss);
            const float rstd = wres / sqrtf(ss * (1.0f / DM) + EPS);
#pragma unroll
            for (int j = 0; j < 4; ++j) { const f32x4 g0 = ((const f32x4*)gpost)[2 * lane + 128 * j], g1 = ((const f32x4*)gpost)[2 * lane + 128 * j + 1];
                hv[2 * j] = hv[2 * j] + yv[2 * j] * g0 * rstd; hv[2 * j + 1] = hv[2 * j + 1] + yv[2 * j + 1] * g1 * rstd; }
        }
        if (Hout) { f32x4* ho = (f32x4*)(Hout + (size_t)m * DM) + 2 * lane;
#pragma unroll
            for (int j = 0; j < 4; ++j) { ho[128 * j] = hv[2 * j]; ho[128 * j + 1] = hv[2 * j + 1]; } }
        if (gpre) {
            float s2 = 0.f;
#pragma unroll
            for (int j = 0; j < 8; ++j) s2 += (hv[j].x * hv[j].x + hv[j].y * hv[j].y) + (hv[j].z * hv[j].z + hv[j].w * hv[j].w);
            s2 = wave_sum(s2);
            const float r2 = 1.0f / sqrtf(s2 * (1.0f / DM) + EPS);
            u32x4* xo = (u32x4*)(XN + (size_t)m * DM) + lane;
#pragma unroll
            for (int j = 0; j < 4; ++j) { const f32x4 g0 = ((const f32x4*)gpre)[2 * lane + 128 * j], g1 = ((const f32x4*)gpre)[2 * lane + 128 * j + 1];
                const f32x4 v0 = hv[2 * j] * g0 * r2, v1 = hv[2 * j + 1] * g1 * r2; u32x4 o; o.x = pk2(v0.x, v0.y); o.y = pk2(v0.z, v0.w); o.z = pk2(v1.x, v1.y); o.w = pk2(v1.z, v1.w); xo[64 * j] = o; }
        }
    }
}

constexpr int KP = 272, VP = 320;
constexpr int KBYTES = 64 * KP, VBYTES = 64 * VP;
constexpr int A_K = 0, A_V = 2 * KBYTES, A_BIAS = A_V + 2 * VBYTES, A_FLAG = A_BIAS + 1024, A_Q = A_FLAG + 1024, A_END = A_Q + 8 * 32 * KP;

__device__ __forceinline__ void tile_prefetch(u32x4 (&rg)[2], const bf16* g, int tid) {
#pragma unroll
    for (int i = 0; i < 2; ++i) { const int chunk = tid + 512 * i, row = chunk >> 4, ch = chunk & 15; rg[i] = *(const u32x4*)(g + (size_t)row * INC + ch * 8); }
}
__device__ __forceinline__ void tile_store(LAS char* dst, int pitch, const u32x4 (&rg)[2], int tid) {
#pragma unroll
    for (int i = 0; i < 2; ++i) { const int chunk = tid + 512 * i, row = chunk >> 4, ch = chunk & 15; *(LAS u32x4*)(dst + row * pitch + ch * 16) = rg[i]; }
}
__device__ __forceinline__ void pv_half(f32x16 (&o)[4], const LAS char* Vb, int kh, bf16x8 P0, bf16x8 P1, int lane) {
    const int h = lane >> 5, i16 = lane & 15, qq = i16 >> 2, p = i16 & 3, blk = (lane >> 4) & 1;
    const LAS char* vb = Vb + (32 * kh + 4 * h + qq) * VP + (16 * blk + 4 * p) * 2;
#pragma unroll
    for (int s2 = 0; s2 < 2; ++s2)
#pragma unroll
        for (int db = 0; db < 4; ++db) {
            const s16x4 lo = __builtin_bit_cast(s16x4, __builtin_amdgcn_ds_read_tr16_b64_v4i16((LAS s16x4*)(vb + (16 * s2) * VP + db * 64)));
            const s16x4 hi = __builtin_bit_cast(s16x4, __builtin_amdgcn_ds_read_tr16_b64_v4i16((LAS s16x4*)(vb + (16 * s2 + 8) * VP + db * 64)));
            const bf16x8 vf = __builtin_shufflevector(lo, hi, 0, 1, 2, 3, 4, 5, 6, 7);
            o[db] = MFMA32(vf, s2 == 0 ? P0 : P1, o[db]);
        }
}

__device__ __forceinline__ void sb_unit(LAS char* lds, const bf16* PROJ, bf16* MIX, int b, int hd, int qb) {
    int tid_o = threadIdx.x; asm volatile("" : "+v"(tid_o)); const int tid = tid_o, lane = tid & 63, r = lane & 31, h = lane >> 5, w = __builtin_amdgcn_readfirstlane(tid >> 6);
    const int q0 = qb * 256, qw = q0 + 32 * w, q = qw + r;
    const size_t rowb = (size_t)b * SEQ;
    const float SCALE = 0.08838834764831845f;
    bf16x8 qf[8];
    { const bf16* Qg = PROJ + (rowb + q) * INC + C_SBQ + hd * 128 + 8 * h;
#pragma unroll
      for (int s = 0; s < 8; ++s) qf[s] = *(const bf16x8*)(Qg + 16 * s); }
    const bf16* Kg = PROJ + rowb * INC + C_SBK + hd * 128; const bf16* Vg = PROJ + rowb * INC + C_SBV + hd * 128;
    f32x16 o[4];
#pragma unroll
    for (int d = 0; d < 4; ++d)
#pragma unroll
        for (int i = 0; i < 16; ++i) o[d][i] = 0.f;
    float R = 0.f; bool wdone = false;
    const int kt_hi = (q0 + 255) >> 6;
    volatile LAS int* flags = (volatile LAS int*)(lds + A_FLAG);
    u32x4 kr[2], vr[2];
    tile_prefetch(kr, Kg + (size_t)(kt_hi * 64) * INC, tid); tile_prefetch(vr, Vg + (size_t)(kt_hi * 64) * INC, tid);
    int it = 0;
    for (int kt = kt_hi; kt >= 0; --kt, ++it) {
        const int buf = it & 1;
        LAS char* Kb = lds + A_K + buf * KBYTES; LAS char* Vb = lds + A_V + buf * VBYTES;
        tile_store(Kb, KP, kr, tid); tile_store(Vb, VP, vr, tid);
        __syncthreads();
        if (it > 0) { int alld = 1;
#pragma unroll
            for (int ww = 0; ww < 8; ++ww) alld &= flags[((it - 1) & 1) * 8 + ww];
            if (alld) break; }
        if (kt > 0) { tile_prefetch(kr, Kg + (size_t)((kt - 1) * 64) * INC, tid); tile_prefetch(vr, Vg + (size_t)((kt - 1) * 64) * INC, tid); }
        const int k0 = kt * 64;
        if (k0 < qw + 31 && !wdone) {
#pragma unroll
            for (int kh = 1; kh >= 0; --kh) {
                f32x16 c;
#pragma unroll
                for (int i = 0; i < 16; ++i) c[i] = 0.f;
                const LAS char* kp = Kb + (32 * kh + r) * KP + 16 * h;
#pragma unroll
                for (int s = 0; s < 8; ++s) { const bf16x8 kf = *(const LAS bf16x8*)(kp + 32 * s); c = MFMA32(kf, qf[s], c); }
                const int keyb = k0 + 32 * kh + 4 * h;
                float lk[16], lb[16], gs[4], og[4];
#pragma unroll
                for (int i = 0; i < 16; ++i) { const int key = keyb + (i & 3) + 8 * (i >> 2); const float z = c[i] * SCALE;
                    const float e = __expf(-fabsf(z)); const float ls = fminf(z, 0.f) - __logf(1.0f + e);
                    lb[i] = ls; lk[i] = (key < q) ? (ls - z) : 0.f; }
#pragma unroll
                for (int g = 0; g < 4; ++g) { gs[g] = (lk[4 * g] + lk[4 * g + 1]) + (lk[4 * g + 2] + lk[4 * g + 3]); og[g] = __shfl_xor(gs[g], 32); }
                const float sg = (gs[0] + gs[1]) + (gs[2] + gs[3]), so = (og[0] + og[1]) + (og[2] + og[3]);
                float after[4];
                after[3] = (h ? 0.f : og[3]);
                after[2] = gs[3] + og[3] + (h ? 0.f : og[2]);
                after[1] = gs[3] + gs[2] + og[3] + og[2] + (h ? 0.f : og[1]);
                after[0] = gs[3] + gs[2] + gs[1] + og[3] + og[2] + og[1] + (h ? 0.f : og[0]);
                float wv[16];
#pragma unroll
                for (int g = 0; g < 4; ++g) { const float base = R + after[g];
                    const float s3 = 0.f, s2 = lk[4 * g + 3], s1 = s2 + lk[4 * g + 2], s0 = s1 + lk[4 * g + 1];
                    const float bt[4] = {s0, s1, s2, s3};
#pragma unroll
                    for (int j = 0; j < 4; ++j) { const int i = 4 * g + j; const int key = keyb + j + 8 * g;
                        wv[i] = (key < q) ? __expf(lb[i] + base + bt[j]) : 0.f; } }
                R += sg + so;
                u32x4 p0, p1;
                p0.x = cvtpk(wv[0], wv[1]); p0.y = cvtpk(wv[2], wv[3]); p0.z = cvtpk(wv[4], wv[5]); p0.w = cvtpk(wv[6], wv[7]);
                p1.x = cvtpk(wv[8], wv[9]); p1.y = cvtpk(wv[10], wv[11]); p1.z = cvtpk(wv[12], wv[13]); p1.w = cvtpk(wv[14], wv[15]);
                pv_half(o, Vb, kh, __builtin_bit_cast(bf16x8, p0), __builtin_bit_cast(bf16x8, p1), lane);
            }
            wdone = __all(R < -110.f);
        }
        if (lane == 0) flags[(it & 1) * 8 + w] = wdone ? 1 : 0;
    }
    bf16* Og = MIX + (rowb + q) * DM + MIX_SB + hd * 128 + 4 * h;
#pragma unroll
    for (int db = 0; db < 4; ++db)
#pragma unroll
        for (int g = 0; g < 4; ++g) { u32x2 ov; ov.x = cvtpk(o[db][4 * g], o[db][4 * g + 1]); ov.y = cvtpk(o[db][4 * g + 2], o[db][4 * g + 3]); *(u32x2*)(Og + 32 * db + 8 * g) = ov; }
    __syncthreads();
}

__device__ __forceinline__ f32x16 diff_qk(const LAS char* kp, const LAS char* qp) {
    f32x16 c;
#pragma unroll
    for (int i = 0; i < 16; ++i) c[i] = 0.f;
#pragma unroll
    for (int s = 0; s < 4; ++s) { const bf16x8 kf = *(const LAS bf16x8*)(kp + 32 * s); const bf16x8 qf = *(const LAS bf16x8*)(qp + 32 * s); c = MFMA32(kf, qf, c); }
    return c;
}
__device__ __forceinline__ void diff_sm(f32x16& c, bool far, float bfar, const LAS float* bt, int q, int keyb, float& m, float& l, f32x16 (&o)[4], bf16x8& P0, bf16x8& P1) {
    const float SC2 = 0.125f * LOG2E;
    if (far) {
#pragma unroll
        for (int i = 0; i < 16; ++i) c[i] = c[i] * SC2 + bfar;
    } else {
#pragma unroll
        for (int i = 0; i < 16; ++i) { const int key = keyb + (i & 3) + 8 * (i >> 2); const int n = q - key; const int ni = n < 0 ? 0 : (n > 128 ? 128 : n);
            c[i] = (n < 0) ? -INFINITY : (c[i] * SC2 + bt[ni]); }
    }
    float mx = fmaxf(fmaxf(c[0], c[1]), fmaxf(c[2], c[3]));
#pragma unroll
    for (int i = 4; i < 16; i += 4) mx = fmaxf(mx, fmaxf(fmaxf(c[i], c[i + 1]), fmaxf(c[i + 2], c[i + 3])));
    mx = fmaxf(mx, __shfl_xor(mx, 32));
    const float mnew = fmaxf(m, mx);
    if (__any(mx > m + 8.0f)) {
        const float sc = __builtin_amdgcn_exp2f(m - mnew); l *= sc;
#pragma unroll
        for (int d = 0; d < 4; ++d)
#pragma unroll
            for (int i = 0; i < 16; ++i) o[d][i] *= sc;
        m = mnew;
    }
    float a = 0.f;
#pragma unroll
    for (int i = 0; i < 16; ++i) { c[i] = __builtin_amdgcn_exp2f(c[i] - m); a += c[i]; }
    l += a;
    u32x4 p0, p1;
    p0.x = cvtpk(c[0], c[1]); p0.y = cvtpk(c[2], c[3]); p0.z = cvtpk(c[4], c[5]); p0.w = cvtpk(c[6], c[7]);
    p1.x = cvtpk(c[8], c[9]); p1.y = cvtpk(c[10], c[11]); p1.z = cvtpk(c[12], c[13]); p1.w = cvtpk(c[14], c[15]);
    P0 = __builtin_bit_cast(bf16x8, p0); P1 = __builtin_bit_cast(bf16x8, p1);
}
__device__ __forceinline__ void diff_unit(LAS char* lds, const bf16* PROJ, bf16* MIX, const float* relb, float lam, float outscale, const float* subg, int b, int hd, int qb) {
    int tid_o = threadIdx.x; asm volatile("" : "+v"(tid_o)); const int tid = tid_o, lane = tid & 63, r = lane & 31, h = lane >> 5, w = __builtin_amdgcn_readfirstlane(tid >> 6);
    const int rg = w & 3, mp = w >> 2;
    const int q0 = qb * 128, qw = q0 + 32 * rg, q = qw + r;
    const size_t rowb = (size_t)b * SEQ;
    LAS float* bt = (LAS float*)(lds + A_BIAS);
    if (tid < 129) { const int bucket = tid < 128 ? (int)T5B[tid] : 31; bt[tid] = relb[bucket * 6 + hd] * LOG2E; }
    LAS char* qp = lds + A_Q + w * (32 * KP) + r * KP + 16 * h;
    { const bf16* Qg = PROJ + (rowb + q) * INC + C_DQ + hd * 128 + 64 * mp + 8 * h;
#pragma unroll
      for (int s = 0; s < 4; ++s) *(LAS u32x4*)(qp + 32 * s) = *(const u32x4*)(Qg + 16 * s); }
    const bf16* Kg = PROJ + rowb * INC + C_DK + hd * 128; const bf16* Vg = PROJ + rowb * INC + C_DV + hd * 128;
    float m = -1e30f, l = 0.f;
    f32x16 o[4];
#pragma unroll
    for (int d = 0; d < 4; ++d)
#pragma unroll
        for (int i = 0; i < 16; ++i) o[d][i] = 0.f;
    const int nt = ((q0 + 127) >> 6) + 1;
    u32x4 krA[2], vrA[2], krB[2], vrB[2];
    tile_prefetch(krA, Kg, tid); tile_prefetch(vrA, Vg, tid);
    tile_prefetch(krB, Kg + (size_t)64 * INC, tid); tile_prefetch(vrB, Vg + (size_t)64 * INC, tid);
#define DIFF_TILE(kt_, KR, VR) do { \
        const int buf = (kt_) & 1; \
        LAS char* Kb = lds + A_K + buf * KBYTES; LAS char* Vb = lds + A_V + buf * VBYTES; \
        tile_store(Kb, KP, KR, tid); tile_store(Vb, VP, VR, tid); \
        __syncthreads(); \
        if ((kt_) + 2 < nt) { tile_prefetch(KR, Kg + (size_t)(((kt_) + 2) * 64) * INC, tid); tile_prefetch(VR, Vg + (size_t)(((kt_) + 2) * 64) * INC, tid); } \
        const int k0 = (kt_) * 64; \
        if (k0 <= qw + 31) { \
            const bool far = (qw - (k0 + 63)) >= 128; const float bfar = bt[128]; \
            const bool two = (k0 + 32 <= qw + 31); \
            const LAS char* kp = Kb + r * KP + 16 * h + 128 * mp; \
            bf16x8 Pa, Pb, Pc, Pd; \
            f32x16 c0 = diff_qk(kp, qp), c1; \
            if (two) c1 = diff_qk(kp + 32 * KP, qp); \
            diff_sm(c0, far, bfar, bt, q, k0 + 4 * h, m, l, o, Pa, Pb); \
            pv_half(o, Vb, 0, Pa, Pb, lane); \
            if (two) { diff_sm(c1, far, bfar, bt, q, k0 + 32 + 4 * h, m, l, o, Pc, Pd); pv_half(o, Vb, 1, Pc, Pd, lane); } \
            __builtin_amdgcn_sched_barrier(0); \
        } } while (0)
#pragma unroll 1
    for (int kt = 0; kt < nt; kt += 2) { DIFF_TILE(kt, krA, vrA); DIFF_TILE(kt + 1, krB, vrB); }
#undef DIFF_TILE
    l += __shfl_xor(l, 32);
    const float inv = (mp ? lam : 1.0f) / l;
    __syncthreads();
    LAS float* EX = (LAS float*)(lds + rg * 16384) + lane;
    if (mp == 1) {
#pragma unroll
        for (int d = 0; d < 4; ++d)
#pragma unroll
            for (int i = 0; i < 16; ++i) EX[(16 * d + i) * 64] = o[d][i] * inv; }
    __syncthreads();
    if (mp == 0) {
        float ss = 0.f;
#pragma unroll
        for (int db = 0; db < 4; ++db)
#pragma unroll
            for (int i = 0; i < 16; ++i) { const float v = o[db][i] * inv - EX[(16 * db + i) * 64]; o[db][i] = v; ss += v * v; }
        ss += __shfl_xor(ss, 32);
        const float rs = outscale / sqrtf(ss * (1.0f / 128.0f) + EPS);
        bf16* Og = MIX + (rowb + q) * DM + MIX_DIFF + hd * 128 + 4 * h;
#pragma unroll
        for (int db = 0; db < 4; ++db)
#pragma unroll
            for (int g = 0; g < 4; ++g) { const f32x4 gg = *(const f32x4*)(subg + 32 * db + 8 * g + 4 * h);
                u32x2 ov; ov.x = cvtpk(o[db][4 * g] * rs * gg.x, o[db][4 * g + 1] * rs * gg.y); ov.y = cvtpk(o[db][4 * g + 2] * rs * gg.z, o[db][4 * g + 3] * rs * gg.w); *(u32x2*)(Og + 32 * db + 8 * g) = ov; }
    }
    __syncthreads();
}

constexpr int S_E = 0, S_XT = 16384, S_XTB = 32 * KP;
__device__ __forceinline__ float gelu_tanh(float y) {
    const float a = 0.7978845608028654f * (y + 0.044715f * y * y * y);
    const float t = 1.0f - 2.0f / (__expf(2.0f * a) + 1.0f);
    return 0.5f * y * (1.0f + t);
}
#define SSM_BU(uf_) \
    f32x16 a_re, b_re, a_im, b_im; \
    { f32x16 z; _Pragma("unroll") for (int i = 0; i < 16; ++i) z[i] = 0.f; \
      a_re = MFMA32(uf_, bfrag[0], z); b_re = MFMA32(uf_, bfrag[1], z); a_im = MFMA32(uf_, bfrag[2], z); b_im = MFMA32(uf_, bfrag[3], z); \
      _Pragma("unroll") for (int i = 0; i < 16; ++i) { \
          auto s1 = __builtin_amdgcn_permlane32_swap(__float_as_uint(a_re[i]), __float_as_uint(b_re[i]), false, false); a_re[i] = __uint_as_float(s1[0]); b_re[i] = __uint_as_float(s1[1]); \
          auto s2 = __builtin_amdgcn_permlane32_swap(__float_as_uint(a_im[i]), __float_as_uint(b_im[i]), false, false); a_im[i] = __uint_as_float(s2[0]); b_im[i] = __uint_as_float(s2[1]); } }
#define SSM_ADV(bur_, bui_) do { const float nxr = lr * xr - li * xi + (bur_), nxi = lr * xi + li * xr + (bui_); xr = nxr; xi = nxi; } while (0)
__device__ __forceinline__ void ssm_unit(LAS char* lds, int l, const bf16* PROJ, bf16* YSB, int b, int g, unsigned* done_cnt) {
    int tid_o = threadIdx.x; asm volatile("" : "+v"(tid_o)); const int tid = tid_o, lane = tid & 63, r = lane & 31, h = lane >> 5, w = __builtin_amdgcn_readfirstlane(tid >> 6);
    const int lg = l * 32 + g;
    const size_t rowb = (size_t)b * SEQ;
    LAS float* E = (LAS float*)(lds + S_E);
    LAS char* XT = lds + S_XT + w * S_XTB;
    const int trow = 16 * ((r >> 2) & 1) + (r & 3) + 4 * (r >> 3);
    const float ar = IN(8)[lg * 64 + lane], ai = IN(9)[lg * 64 + lane], dt = expf(IN(10)[lg]);
    const float mag = expf(ar * dt); const float lr = mag * cosf(ai * dt), li = mag * sinf(ai * dt);
    const float den = ar * ar + ai * ai;
    const float fr = ((lr - 1.0f) * ar + li * ai) / den, fi = (li * ar - (lr - 1.0f) * ai) / den;
    bf16x8 bfrag[4];
    { float bbr[16], bbi[16], pbr[16], pbi[16];
      const f32x4* br4 = (const f32x4*)(IN(11) + ((size_t)lg * 64 + lane) * 16); const f32x4* bi4 = (const f32x4*)(IN(12) + ((size_t)lg * 64 + lane) * 16);
#pragma unroll
      for (int j = 0; j < 4; ++j) { const f32x4 br = br4[j], bi = bi4[j];
#pragma unroll
          for (int e = 0; e < 4; ++e) { bbr[4 * j + e] = fr * br[e] - fi * bi[e]; bbi[4 * j + e] = fr * bi[e] + fi * br[e]; } }
#pragma unroll
      for (int c = 0; c < 16; ++c) { pbr[c] = __shfl_xor(bbr[c], 32); pbi[c] = __shfl_xor(bbi[c], 32); }
#pragma unroll
      for (int nb = 0; nb < 4; ++nb) { const bool own = ((nb & 1) == h); float v[8];
#pragma unroll
          for (int j = 0; j < 8; ++j) { const float o_ = (nb < 2) ? (h ? bbr[8 + j] : bbr[j]) : (h ? bbi[8 + j] : bbi[j]); const float p_ = (nb < 2) ? (h ? pbr[8 + j] : pbr[j]) : (h ? pbi[8 + j] : pbi[j]); v[j] = own ? o_ : p_; }
          u32x4 pk; pk.x = cvtpk(v[0], v[1]); pk.y = cvtpk(v[2], v[3]); pk.z = cvtpk(v[4], v[5]); pk.w = cvtpk(v[6], v[7]); bfrag[nb] = __builtin_bit_cast(bf16x8, pk); } }
    bf16x8 cmf[9];
#pragma unroll
    for (int s = 0; s < 8; ++s) { u32x4 pk = {0u, 0u, 0u, 0u};
        if (r < 16) { const float* src = (s < 4 ? IN(13) : IN(14)) + ((size_t)lg * 16 + r) * 64 + 16 * (s & 3) + 8 * h; const float sg = s < 4 ? 1.0f : -1.0f;
            const f32x4 a = *(const f32x4*)src * sg, c = *(const f32x4*)(src + 4) * sg;
            pk.x = cvtpk(a.x, a.y); pk.y = cvtpk(a.z, a.w); pk.z = cvtpk(c.x, c.y); pk.w = cvtpk(c.z, c.w); }
        cmf[s] = __builtin_bit_cast(bf16x8, pk); }
    { const float dsk = IN(15)[lg * 16 + (r & 15)]; float v[8];
#pragma unroll
      for (int j = 0; j < 8; ++j) v[j] = (r < 16 && (8 * h + j) == r) ? dsk : 0.f;
      u32x4 pk; pk.x = cvtpk(v[0], v[1]); pk.y = cvtpk(v[2], v[3]); pk.z = cvtpk(v[4], v[5]); pk.w = cvtpk(v[6], v[7]); cmf[8] = __builtin_bit_cast(bf16x8, pk); }
    float l64r = lr, l64i = li;
#pragma unroll
    for (int s = 0; s < 6; ++s) { const float nr = l64r * l64r - l64i * l64i, ni = 2.0f * l64r * l64i; l64r = nr; l64i = ni; }
#define SSM_UADDR(bi_) (PROJ + (rowb + 64 * (w + 8 * ((bi_) >> 1)) + 32 * ((bi_) & 1) + trow) * INC + C_U + g * 16 + 8 * h)
    {
        bf16x8 ufc = *(const bf16x8*)SSM_UADDR(0);
        float xr = 0.f, xi = 0.f;
#pragma unroll 1
        for (int bi = 0; bi < 8; ++bi) {
            const bf16x8 ufn = *(const bf16x8*)SSM_UADDR(bi < 7 ? bi + 1 : 7);
            SSM_BU(ufc)
#pragma unroll
            for (int i = 0; i < 16; ++i) SSM_ADV(a_re[i], a_im[i]);
#pragma unroll
            for (int i = 0; i < 16; ++i) SSM_ADV(b_re[i], b_im[i]);
            if (bi & 1) { const int k = w + 8 * (bi >> 1); E[k * 128 + lane] = xr; E[k * 128 + 64 + lane] = xi; xr = 0.f; xi = 0.f; }
            ufc = ufn;
        }
    }
    __syncthreads();
    LAS char* xw = XT + 2 * lane;
    const LAS char* xrd = XT + r * KP + 16 * h;
    {
        float cr = 0.f, ci = 0.f;
#pragma unroll 1
        for (int k = 0; k < w; ++k) { const float er = E[k * 128 + lane], ei = E[k * 128 + 64 + lane]; const float nr = l64r * cr - l64i * ci + er, ni = l64r * ci + l64i * cr + ei; cr = nr; ci = ni; }
        bf16x8 ufc = *(const bf16x8*)SSM_UADDR(0);
        float xr = cr, xi = ci;
#pragma unroll 1
        for (int bi = 0; bi < 8; ++bi) {
            const bf16x8 ufn = *(const bf16x8*)SSM_UADDR(bi < 7 ? bi + 1 : 7);
            const size_t row0 = rowb + 64 * (w + 8 * (bi >> 1)) + 32 * (bi & 1);
            { SSM_BU(ufc)
#pragma unroll
              for (int i = 0; i < 16; ++i) { SSM_ADV(a_re[i], a_im[i]); const unsigned pk = cvtpk(xr, xi); const int rho = 8 * (i >> 2) + (i & 3);
                  *(LAS unsigned short*)(xw + rho * KP) = (unsigned short)pk; *(LAS unsigned short*)(xw + rho * KP + 128) = (unsigned short)(pk >> 16); }
#pragma unroll
              for (int i = 0; i < 16; ++i) { SSM_ADV(b_re[i], b_im[i]); const unsigned pk = cvtpk(xr, xi); const int rho = 8 * (i >> 2) + 4 + (i & 3);
                  *(LAS unsigned short*)(xw + rho * KP) = (unsigned short)pk; *(LAS unsigned short*)(xw + rho * KP + 128) = (unsigned short)(pk >> 16); } }
            WAVE_SYNC();
            f32x16 y;
#pragma unroll
            for (int i = 0; i < 16; ++i) y[i] = 0.f;
            y = MFMA32(cmf[8], ufc, y);
#pragma unroll
            for (int s = 0; s < 8; ++s) { const bf16x8 xa = *(const LAS bf16x8*)(xrd + 32 * s); y = MFMA32(cmf[s], xa, y); }
            {
                bf16* yo = YSB + (row0 + trow) * 512 + g * 16 + 4 * h;
                u32x2 w0, w1;
                w0.x = pk2(gelu_tanh(y[0]), gelu_tanh(y[1])); w0.y = pk2(gelu_tanh(y[2]), gelu_tanh(y[3]));
                w1.x = pk2(gelu_tanh(y[4]), gelu_tanh(y[5])); w1.y = pk2(gelu_tanh(y[6]), gelu_tanh(y[7]));
                *(u32x2*)yo = w0; *(u32x2*)(yo + 8) = w1;
            }
            WAVE_SYNC();
            if ((bi & 1) && bi < 7) {
                const int k0c = w + 8 * (bi >> 1);
#pragma unroll 1
                for (int k = k0c; k < k0c + 8; ++k) { const float er = E[k * 128 + lane], ei = E[k * 128 + 64 + lane]; const float nr = l64r * cr - l64i * ci + er, ni = l64r * ci + l64i * cr + ei; cr = nr; ci = ni; }
                xr = cr; xi = ci;
            }
            ufc = ufn;
        }
    }
    asm volatile("s_waitcnt vmcnt(0)" ::: "memory");
    __syncthreads();
    if (tid == 0) { __builtin_amdgcn_fence(__ATOMIC_RELEASE, "agent"); asm volatile("s_waitcnt vmcnt(0)" ::: "memory"); __hip_atomic_fetch_add(done_cnt, 1u, __ATOMIC_RELAXED, __HIP_MEMORY_SCOPE_AGENT); }
}
#undef SSM_UADDR
#undef SSM_BU
#undef SSM_ADV
constexpr int I_G = (DM / 64) * (FF / 32), I_D = (FF / 64) * (DM / 32), I_IN = (DM / 64) * (INC / 32), I_OUT = (DM / 64) * (DM / 32), I_GLU = (512 / 64) * (512 / 32);
constexpr int CV_PER_LAYER = 4 * I_G + 2 * I_D + I_IN + I_OUT + I_GLU, CV_TOTAL = NLAYER * CV_PER_LAYER;
static_assert(CV_TOTAL % 8 == 0 && (2 * I_G) % 8 == 0, "batches of 8");
__device__ __forceinline__ void convert_item(int it, unsigned char* wsb, LAS float* scr, int lane) {
    const int l = it / CV_PER_LAYER; int r = it % CV_PER_LAYER;
    unsigned char* lw0 = wsb + WS_W + (size_t)l * LW_SIZE;
    if (r < I_G) { transpose_item(IN(2) + (size_t)l * DM * FF, DM, FF, (bf16*)(lw0 + LW_GU1), 1, scr, r, lane); return; } r -= I_G;
    if (r < I_G) { transpose_item(IN(3) + (size_t)l * DM * FF, DM, FF, (bf16*)(lw0 + LW_GU1), 2, scr, r, lane); return; } r -= I_G;
    if (r < I_D) { transpose_item(IN(4) + (size_t)l * FF * DM, FF, DM, (bf16*)(lw0 + LW_D1), 0, scr, r, lane); return; } r -= I_D;
    if (r < I_IN) { transpose_item(IN(7) + (size_t)l * DM * INC, DM, INC, (bf16*)(lw0 + LW_IN), 0, scr, r, lane); return; } r -= I_IN;
    if (r < I_OUT) { transpose_item(IN(24) + (size_t)l * DM * DM, DM, DM, (bf16*)(lw0 + LW_OUT), 0, scr, r, lane); return; } r -= I_OUT;
    if (r < I_GLU) { transpose_item(IN(16) + (size_t)l * 512 * 512, 512, 512, (bf16*)(lw0 + LW_GLU), 0, scr, r, lane); return; } r -= I_GLU;
    if (r < I_G) { transpose_item(IN(27) + (size_t)l * DM * FF, DM, FF, (bf16*)(lw0 + LW_GU2), 1, scr, r, lane); return; } r -= I_G;
    if (r < I_G) { transpose_item(IN(28) + (size_t)l * DM * FF, DM, FF, (bf16*)(lw0 + LW_GU2), 2, scr, r, lane); return; } r -= I_G;
    transpose_item(IN(29) + (size_t)l * FF * DM, FF, DM, (bf16*)(lw0 + LW_D2), 0, scr, r, lane);
}
__device__ __forceinline__ void convert_static(int start, int end, int b0, int nb, unsigned char* wsb, LAS unsigned char* lds) {
    const int ib = (int)blockIdx.x - b0; if (ib < 0 || ib >= nb) return;
    int tid_o = threadIdx.x; asm volatile("" : "+v"(tid_o)); const int lane = tid_o & 63, wave = __builtin_amdgcn_readfirstlane(tid_o >> 6);
    LAS float* scr = (LAS float*)(lds + wave * 16384);
#pragma unroll 1
    for (int it = start + ib * NWAVES + wave; it < end; it += nb * NWAVES) convert_item(it, wsb, scr, lane);
}
__device__ __forceinline__ void convert_batch64(int c0, unsigned char* wsb, LAS unsigned char* lds) {
    int tid_o = threadIdx.x; asm volatile("" : "+v"(tid_o)); const int lane = tid_o & 63, wave = __builtin_amdgcn_readfirstlane(tid_o >> 6);
    LAS float* scr = (LAS float*)(lds + wave * 16384);
#pragma unroll 1
    for (int j = 0; j < 8; ++j) convert_item(c0 + 8 * wave + j, wsb, scr, lane);
}
#ifndef CV_UPFRONT
#define CV_UPFRONT 1
#endif
#if CV_UPFRONT
constexpr int CV_P0_END = CV_TOTAL, CV_A_END = CV_TOTAL, CV_B_END = CV_TOTAL, CV_M_END = CV_TOTAL, CV_MB = 0;
#else
constexpr int CV_P0_END = 2 * I_G;
constexpr int CV_A_END = 4 * I_G + I_D + I_IN + I_OUT + I_GLU - 2 * I_G + 2048;
constexpr int CV_B_END = CV_PER_LAYER;
constexpr int CV_M_END = CV_PER_LAYER + 2 * I_G + I_D + I_IN + I_OUT + I_GLU;
constexpr int CV_MB = (CV_M_END - CV_B_END) / 64;
#endif
static_assert((CV_M_END - CV_B_END) % 64 == 0, "mixer-phase conversion batches");
#ifndef PHASE_MASK
#define PHASE_MASK 0xFFFF
#endif
#define PH(k) if constexpr (((PHASE_MASK) >> (k)) & 1)
#ifndef MK_SYNC
#define MK_SYNC() do { XcdBarrier xb_; xb_.bar = (unsigned*)ws + 1024; xb_.x = xb_xcc_id(); xb_.st = (volatile LAS unsigned*)(lds + LDS_BYTES - 32); xcd_barrier(xb_); } while (0)
#endif
#ifndef CV_P0_LIM
#define CV_P0_LIM (2 * I_G)
#endif
#ifndef CV_LIM_GU1
#define CV_LIM_GU1 32000
#endif
#ifndef CV_LIM_WIN
#define CV_LIM_WIN 52000
#endif
#ifndef CV_LIM_MIX
#define CV_LIM_MIX 64000
#endif
__global__ void __launch_bounds__(NTHREADS, 2) fwd_megakernel(Args args) {
    extern __shared__ __attribute__((aligned(16))) unsigned char lds_raw[];
    cg::grid_group grid = cg::this_grid();
    LAS unsigned char* lds = (LAS unsigned char*)lds_raw;
    const int G = gridDim.x, bid = blockIdx.x, ngw = G * NWAVES;
    if (threadIdx.x < 2) ((volatile LAS unsigned*)(lds + LDS_BYTES - 32))[threadIdx.x] = 0u;
    __syncthreads();
    (void)xcd_barrier_post((unsigned*)(kargs_ptr()->ws) + 1024, (volatile LAS unsigned*)(lds + LDS_BYTES - 32));
#define LANE_SETUP() int tid_o = threadIdx.x; asm volatile("" : "+v"(tid_o)); const int lane = tid_o & 63, wave = __builtin_amdgcn_readfirstlane(tid_o >> 6), gw = bid * NWAVES + wave; (void)gw; (void)lane
#define ws (kargs_ptr()->ws)
#define XN ((bf16*)(ws + WS_XN))
#define BIG ((bf16*)(ws + WS_BIG))
#define Y ((bf16*)(ws + WS_Y))
#define MIX ((bf16*)(ws + WS_MIX))
#define YS ((float*)(ws + WS_YS))
#define YSB ((bf16*)(ws + WS_YSB))
#define H (kargs_ptr()->out)

    { convert_static(0, CV_P0_END, 0, G, ws, lds);
      PH(0) { LANE_SETUP();
        row_pass(nullptr, IN(0), nullptr, XN, nullptr, 0.f, IN(1), gw, ngw, lane); }
    }
    if (__builtin_expect(kargs_ptr()->out == nullptr, 0)) grid.sync();
    MK_SYNC();

#pragma unroll 1
    for (int l = 0; l < NLAYER; ++l) {
#define lw (ws + WS_W + (size_t)l * LW_SIZE)
#pragma unroll 1
        for (int f = 0; f < 2; ++f) {
            PH(1) { pg8::Gemm g{XN, (const bf16*)(lw + (f ? LW_GU2 : LW_GU1)), M, 2 * FF, DM}; pg8::StaticOrder S; S.init(M, 2 * FF, G, bid);
              pg8::EpiSwiGLU E{BIG, FF};
              pg8::gemm_phase<pg8::EpiSwiGLU, pg8::StaticOrder, true, true>(lds, g, S, E); }
            MK_SYNC();
            PH(2) { pg8::Gemm g{BIG, (const bf16*)(lw + (f ? LW_D2 : LW_D1)), M, DM, FF}; pg8::StaticOrder S; S.init(M, DM, G, bid);
              pg8::EpiBf16Plain E{Y, DM};
              pg8::gemm_phase<pg8::EpiBf16Plain, pg8::StaticOrder, true, true>(lds, g, S, E); }
            MK_SYNC();
            PH(3) { LANE_SETUP(); const float* gpost = (f ? IN(30) : IN(5)) + (size_t)l * DM;
              const float* gpre = f == 0 ? IN(6) + (size_t)l * DM : (l + 1 < NLAYER ? IN(1) + (size_t)(l + 1) * DM : nullptr);
              row_pass(Y, (l == 0 && f == 0) ? IN(0) : (const float*)H, H, XN, gpost, 0.5f, gpre, gw, ngw, lane); }
            if (f == 1) break;
            MK_SYNC();
            PH(4) { pg8::Gemm g{XN, (const bf16*)(lw + LW_IN), M, INC, DM}; pg8::StaticOrder S; S.init(M, INC, G, bid);
              pg8::EpiBf16Plain E{BIG, INC};
              pg8::gemm_phase<pg8::EpiBf16Plain, pg8::StaticOrder, true, true>(lds, g, S, E); }
            MK_SYNC();
#ifndef MIX_REPS
#define MIX_REPS 1
#endif
            {
                LANE_SETUP();
                const float lambda_init = 0.8f - 0.6f * expf(-0.3f * (float)l);
                const float d1 = wave_sum(IN(18)[l * 64 + lane] * IN(19)[l * 64 + lane]);
                const float d2 = wave_sum(IN(20)[l * 64 + lane] * IN(21)[l * 64 + lane]);
                const float lam = expf(d1) - expf(d2) + lambda_init;
                volatile LAS int* slot = (volatile LAS int*)(lds + LDS_BYTES - 64);
                const unsigned myx = xb_xcc_id() & 7u;
#pragma unroll 1
                for (int stage = 0; stage < 4; ++stage) {
                    const unsigned nlists = (stage == 2) ? 1u : 8u;
                    const int limit = stage == 0 ? 55 : (stage == 1 ? 24 : (stage == 2 ? 64 : 9));
#pragma unroll 1
                    for (unsigned xo = 0; xo < nlists; ++xo) {
                        const int x = (int)((myx + xo) & 7u);
                        unsigned* ctr = (unsigned*)ws + (stage == 0 ? 64 * (l * 8 + x) : (stage == 1 ? 4608 + 64 * (l * 8 + x) : (stage == 2 ? 5632 + 64 * l : 12288 + 64 * (l * 8 + x))));
                        for (;;) {
                            if (tid_o == 0) *slot = (int)atomicAdd(ctr, 1u);
                            __syncthreads();
                            int item = *slot;
                            __syncthreads();
                            if (item >= limit) break;
                            if (stage == 0 || stage == 3) {
                                if (stage == 3) item += 55;
                                if (item < 24 || item >= 40) { PH(5) { const int di = item < 24 ? item : item - 16; const int qb = 15 - (di / 3), bh = 8 * (di % 3) + x;
                                    diff_unit((LAS char*)lds, BIG, MIX, IN(23), lam, 1.0f - lambda_init, IN(22) + (size_t)l * 128, bh / 6, bh % 6, qb); } }
                                else { PH(6) { const int u = 8 * (item - 24) + x; ssm_unit((LAS char*)lds, l, BIG, YSB, u / 32, u % 32, (unsigned*)ws + 6144 + 64 * (l * 4 + u / 32)); } }
                            } else if (stage == 1) { PH(7) { const int qb = 7 - (item / 3), bh = 8 * (item % 3) + x; sb_unit((LAS char*)lds, BIG, MIX, bh / 6, bh % 6, qb); } }
                            else { PH(8) {
                                pg8::Gemm g{YSB, (const bf16*)(lw + LW_GLU), M, 512, 512};
                                pg8::GatedUnit S1{pg8::Unit{item >> 1, item & 1}, (unsigned*)ws + 6144 + 64 * (l * 4 + (item >> 4)), 32u};
                                pg8::EpiGlu E{MIX + MIX_SSM, DM, YSB, 512, IN(17) + (size_t)l * 512};
                                pg8::gemm_phase<pg8::EpiGlu, pg8::GatedUnit, true, true>(lds, g, S1, E);
                                __syncthreads(); } }
                        }
                    }
                }
            }
            MK_SYNC();
            PH(9) { pg8::Gemm g{MIX, (const bf16*)(lw + LW_OUT), M, DM, DM}; pg8::StaticOrder S; S.init(M, DM, G, bid);
              pg8::EpiBf16Plain E{Y, DM};
              pg8::gemm_phase<pg8::EpiBf16Plain, pg8::StaticOrder, true, true>(lds, g, S, E); }
            MK_SYNC();
            PH(3) { LANE_SETUP(); row_pass(Y, H, H, XN, IN(25) + (size_t)l * DM, 1.0f, IN(26) + (size_t)l * DM, gw, ngw, lane); }
            MK_SYNC();
        }
        if (l + 1 < NLAYER) MK_SYNC();
    }
}

#undef ws
#undef XN
#undef BIG
#undef Y
#undef MIX
#undef YS
#undef YSB
#undef H
#undef lw
extern "C" void kernel_launch(void* const* d_in, const int* in_sizes, int n_in, void* d_out, int out_size, void* d_ws, size_t ws_size, hipStream_t stream) {
    static int grid = 0;
    if (grid == 0) {
        if (n_in != 31 || out_size != M * DM || ws_size < WS_END) { fprintf(stderr, "kernel_launch: unexpected shapes (n_in %d, out %d, ws %zu < %zu)\n", n_in, out_size, ws_size, (size_t)WS_END); grid = -1; return; }
        int dev = 0, cus = 0, per_cu = 0;
        hipGetDevice(&dev); hipDeviceGetAttribute(&cus, hipDeviceAttributeMultiprocessorCount, dev);
        if (hipFuncSetAttribute((const void*)fwd_megakernel, hipFuncAttributeMaxDynamicSharedMemorySize, LDS_BYTES) != hipSuccess) { fprintf(stderr, "kernel_launch: hipFuncSetAttribute failed\n"); grid = -1; return; }
        hipOccupancyMaxActiveBlocksPerMultiprocessor(&per_cu, (const void*)fwd_megakernel, NTHREADS, LDS_BYTES);
        if (per_cu < 1) { fprintf(stderr, "kernel_launch: occupancy query says %d blocks per CU\n", per_cu); per_cu = 1; }
        (void)hipGetLastError();
        grid = cus * 1;
    }
    if (grid < 0) return;
    if (hipMemsetAsync(d_ws, 0, 65536, stream) != hipSuccess) { fprintf(stderr, "kernel_launch: memset failed\n"); return; }
    Args a{};
    for (int i = 0; i < 31; ++i) a.in[i] = (const float*)d_in[i];
    a.out = (float*)d_out; a.ws = (unsigned char*)d_ws;
    void* kargs[] = {&a};
    hipError_t e = hipLaunchCooperativeKernel((const void*)fwd_megakernel, dim3(grid), dim3(NTHREADS), kargs, LDS_BYTES, stream);
    if (e != hipSuccess) fprintf(stderr, "kernel_launch: cooperative launch failed: %s (grid %d)\n", hipGetErrorString(e), grid);
}
```

```cpp
#include <hip/hip_runtime.h>
#include <cstdio>
#include <cstdint>
namespace pg8 {
#define PG8_LAS __attribute__((address_space(3)))
typedef unsigned short bf16_t;
typedef short bf16x8 __attribute__((ext_vector_type(8)));
typedef float f32x4 __attribute__((ext_vector_type(4)));
typedef unsigned u32x4 __attribute__((ext_vector_type(4)));
constexpr int BM = 256, BK = 64, HALF = 128, HTB = HALF * BK * 2  , STAGE_BYTES = 8 * HTB, NXCD = 8, WGM = 8;

__host__ __device__ __forceinline__ int lds_byte(int r, int c) { const int st = (r >> 4) * 2 + (c >> 5), rr = r & 15, cc = c & 31, ob = rr * 64 + cc * 2; return st * 1024 + (ob ^ (((ob >> 9) & 1) << 5)); }
__host__ __device__ __forceinline__ void stage_rc(int b, int& R, int& C) { const int st = b / 1024, sb = b % 1024, swz = sb ^ (((sb >> 9) & 1) << 5); R = (st >> 1) * 16 + swz / 64; C = (st & 1) * 32 + (swz % 64) / 2; }
__host__ __device__ __forceinline__ int perm32(int rho) { const int n = rho >> 4, i = rho & 15; return 8 * (i >> 2) + 4 * n + (i & 3); }

struct Unit { int pm, pn; };
struct Gemm { const bf16_t* A; const bf16_t* Bt; int M, N, K; };

struct StaticOrder {
    int nM, nN, nwg, G, c;
    __host__ __device__ void init(int M, int N, int G_, int c_) { nM = M / BM; nN = N / BM; nwg = nM * nN; G = G_; c = c_; }
    __host__ __device__ bool next(int i, Unit& u) const {
        const long L = (long)i * G + c; if (L >= nwg) return false;
        int wgid = (int)L; { const int q = nwg / NXCD, r = nwg % NXCD, xcd = wgid % NXCD, off = wgid / NXCD; wgid = (xcd < r ? xcd * (q + 1) : r * (q + 1) + (xcd - r) * q) + off; }
        const int nig = WGM * nN, gid = wgid / nig, fm = gid * WGM, gsz = (nM - fm) < WGM ? (nM - fm) : WGM;
        u.pm = fm + ((wgid % nig) % gsz); u.pn = (wgid % nig) / gsz; return true;
    }
    __device__ __forceinline__ void a_ready(const Unit&) const {}
    __device__ __forceinline__ void done(const Unit&) const {}
};

__device__ __forceinline__ unsigned cvt_pk_bf16(float lo, float hi) { unsigned r; asm volatile("v_cvt_pk_bf16_f32 %0, %1, %2" : "=v"(r) : "v"(lo), "v"(hi)); return r; }
typedef float f32x2 __attribute__((ext_vector_type(2)));
__device__ __forceinline__ f32x2 gelu_pk(f32x2 v) {
    const f32x2 av = __builtin_elementwise_abs(v), d = av * 0.2316418882f + 1.0f;
    f32x2 t; t.x = __builtin_amdgcn_rcpf(d.x); t.y = __builtin_amdgcn_rcpf(d.y);
    f32x2 q = t * 0.5307027145f + (-0.7265760135f); q = q * t + 0.7107068705f; q = q * t + (-0.142248368f); q = q * t + 0.127414796f; q = q * t;
    const f32x2 s = (v * v) * (-0.72134752044f);
    f32x2 e; e.x = __builtin_amdgcn_exp2f(s.x); e.y = __builtin_amdgcn_exp2f(s.y);
    const f32x2 m = v * (q * e), r = v - m;
    f32x2 o; o.x = v.x < 0.f ? m.x : r.x; o.y = v.y < 0.f ? m.y : r.y; return o;
}

template <int ACT  > struct EpiBf16 {
    static constexpr bool PERM = true, AFTER_DRAIN = false; static_assert(ACT == 0 || ACT == 1, "EpiBf16: ACT is 0 (none) or 1 (gelu_pk)");
    bf16_t* O; int ldc; const float* bias; int split_cols; size_t split_stride; float scale0;
    __device__ __forceinline__ void operator()(const f32x4 (&acc)[2][2][4][2], const Unit& u, int wr, int wc, int fr, int fq) const {
        const int row0 = u.pm * BM + wr * 64 + fr; int colt = u.pn * BM; bf16_t* base = O;
        float sc = 1.f; if (split_cols) { const int t = colt / split_cols; base += (size_t)t * split_stride; colt -= t * split_cols; if (t == 0) sc = scale0; }
        const int col0 = colt + wc * 32 + 8 * fq, bcol0 = u.pn * BM + wc * 32 + 8 * fq;
        f32x4 bv[2][2];
#pragma unroll
        for (int bj = 0; bj < 2; ++bj)
#pragma unroll
            for (int n = 0; n < 2; ++n) bv[bj][n] = bias ? *(const f32x4*)(bias + bcol0 + bj * HALF + 4 * n) : (f32x4){0.f, 0.f, 0.f, 0.f};
#pragma unroll
        for (int ai = 0; ai < 2; ++ai)
#pragma unroll
            for (int m = 0; m < 4; ++m) { bf16_t* rowp = base + (size_t)(row0 + ai * HALF + m * 16) * ldc + col0;
#pragma unroll
                for (int bj = 0; bj < 2; ++bj) { f32x4 v0 = acc[ai][bj][m][0] + bv[bj][0], v1 = acc[ai][bj][m][1] + bv[bj][1];
                    if (ACT == 1) { f32x2 a = gelu_pk((f32x2){v0[0], v0[1]}), b = gelu_pk((f32x2){v0[2], v0[3]}), c = gelu_pk((f32x2){v1[0], v1[1]}), d = gelu_pk((f32x2){v1[2], v1[3]});
                        v0 = (f32x4){a.x, a.y, b.x, b.y}; v1 = (f32x4){c.x, c.y, d.x, d.y}; }
                    v0 = v0 * sc; v1 = v1 * sc; u32x4 w; w.x = cvt_pk_bf16(v0[0], v0[1]); w.y = cvt_pk_bf16(v0[2], v0[3]); w.z = cvt_pk_bf16(v1[0], v1[1]); w.w = cvt_pk_bf16(v1[2], v1[3]);
                    *(u32x4*)(rowp + bj * HALF) = w; } }
    }
};

template <class Epi, class Sched, bool ALIGN_EPI = false, bool SP2 = false>
__device__ __forceinline__ void gemm_phase(PG8_LAS unsigned char* lds, const Gemm g, const Sched& S, const Epi& E) {
    int tid_o = threadIdx.x; asm volatile("" : "+v"(tid_o));
    const int tid = tid_o, wid = __builtin_amdgcn_readfirstlane(tid >> 6), lane = tid & 63, wr = wid >> 2, wc = wid & 3, fr = lane & 15, fq = lane >> 4;
    const int K = g.K, nt = K / BK;
    unsigned voffA[2], voffB[2];
#pragma unroll
    for (int i = 0; i < 2; ++i) { int R, C; stage_rc(tid * 16 + i * 8192, R, C); const int Rb = Epi::PERM ? ((R & ~31) + perm32(R & 31)) : R;
        voffA[i] = (unsigned)(R * K + C) * 2u; voffB[i] = (unsigned)(Rb * K + C) * 2u; }
    const size_t kstep = (size_t)(BK * 2);
    const size_t hstep = (size_t)HALF * K * 2;
    const size_t tstep = 2 * hstep;
    const unsigned ldsw = (unsigned)wid * 1024u;
    const int aoff = lds_byte(wr * 64 + fr, fq * 8), boff = lds_byte(wc * 32 + fr, fq * 8);
#define PG8_SA(b, h) (((b) * 2 + (h)) * HTB)
#define PG8_SB(b, h) ((4 + (b) * 2 + (h)) * HTB)
#define PG8_STAGE(bufoff, gbase, voff) do { _Pragma("unroll") for (int _i = 0; _i < 2; ++_i) \
        __builtin_amdgcn_global_load_lds((const unsigned*)((const char*)(gbase) + (voff)[_i]), (PG8_LAS unsigned*)(lds + (bufoff) + ldsw + _i * 8192), 16, 0, 0); } while (0)
#define PG8_LDA(dst, b, h) do { _Pragma("unroll") for (int m = 0; m < 4; ++m) _Pragma("unroll") for (int k = 0; k < 2; ++k) dst[m][k] = *(const PG8_LAS bf16x8*)(lds + PG8_SA(b, h) + aoff + m * 2048 + k * 1024); } while (0)
#define PG8_LDB(dst, b, h) do { _Pragma("unroll") for (int n = 0; n < 2; ++n) _Pragma("unroll") for (int k = 0; k < 2; ++k) dst[n][k] = *(const PG8_LAS bf16x8*)(lds + PG8_SB(b, h) + boff + n * 2048 + k * 1024); } while (0)
#define PG8_MMA(ai, bj, At, Bt) do { __builtin_amdgcn_s_setprio(1); _Pragma("unroll") for (int m = 0; m < 4; ++m) _Pragma("unroll") for (int n = 0; n < 2; ++n) _Pragma("unroll") for (int k = 0; k < 2; ++k) \
        acc[ai][bj][m][n] = __builtin_amdgcn_mfma_f32_16x16x32_bf16(Bt[n][k], At[m][k], acc[ai][bj][m][n], 0, 0, 0); __builtin_amdgcn_s_setprio(0); } while (0)
#define PG8_WAIT_V(n) asm volatile("s_waitcnt vmcnt(" #n ")" ::: "memory")
#define PG8_WAIT_L(n) asm volatile("s_waitcnt lgkmcnt(" #n ")" ::: "memory")
#define PG8_BAR __builtin_amdgcn_s_barrier()
#define PG8_SCHED __builtin_amdgcn_sched_barrier(0)
    Unit cur, nxt; int ui = 0;
    if (!S.next(0, cur)) return;
    f32x4 acc[2][2][4][2];
#pragma unroll
    for (int a = 0; a < 2; ++a)
#pragma unroll
        for (int b = 0; b < 2; ++b)
#pragma unroll
            for (int m = 0; m < 4; ++m)
#pragma unroll
                for (int n = 0; n < 2; ++n) acc[a][b][m][n] = (f32x4){0.f, 0.f, 0.f, 0.f};
    bf16x8 At[4][2], B0[2][2], B1[2][2];
    const char* cA = (const char*)g.A + (size_t)cur.pm * tstep; const char* cB = (const char*)g.Bt + (size_t)cur.pn * tstep;
    S.a_ready(cur);
    if constexpr (SP2) {
        PG8_STAGE(PG8_SB(0, 0), cB, voffB); PG8_STAGE(PG8_SB(0, 1), cB + hstep, voffB); PG8_STAGE(PG8_SA(0, 0), cA, voffA); PG8_STAGE(PG8_SA(0, 1), cA + hstep, voffA);
        if (wr == 1) PG8_BAR;
        PG8_WAIT_V(2); PG8_BAR;
        PG8_STAGE(PG8_SB(1, 0), cB + kstep, voffB); PG8_STAGE(PG8_SA(1, 0), cA + kstep, voffA); PG8_STAGE(PG8_SB(1, 1), cB + hstep + kstep, voffB);
        PG8_WAIT_V(6); PG8_BAR;
    } else {
        PG8_STAGE(PG8_SB(0, 0), cB, voffB); PG8_STAGE(PG8_SA(0, 0), cA, voffA); PG8_STAGE(PG8_SB(0, 1), cB + hstep, voffB); PG8_STAGE(PG8_SA(0, 1), cA + hstep, voffA);
        if (wr == 1) PG8_BAR;
        PG8_WAIT_V(4); PG8_BAR;
        PG8_STAGE(PG8_SB(1, 0), cB + kstep, voffB); PG8_STAGE(PG8_SA(1, 0), cA + kstep, voffA); PG8_STAGE(PG8_SB(1, 1), cB + hstep + kstep, voffB);
        PG8_WAIT_V(6); PG8_BAR;
    }
    for (;;) {
        const bool has_next = S.next(ui + 1, nxt);
        const char* nA = has_next ? (const char*)g.A + (size_t)nxt.pm * tstep : cA; const char* nB = has_next ? (const char*)g.Bt + (size_t)nxt.pn * tstep : cB;
        for (int t = 0; t < nt; t += 2) {
            const bool last = (t == nt - 2);
            const char* a1 = cA + (size_t)(t + 1) * kstep;
            const char* a2 = last ? nA : cA + (size_t)(t + 2) * kstep; const char* b2 = last ? nB : cB + (size_t)(t + 2) * kstep;
            const char* a3 = a2 + kstep; const char* b3 = b2 + kstep;
            if (last && has_next) S.a_ready(nxt);
            if constexpr (SP2) {
            PG8_LDB(B0, 0, 0); PG8_LDB(B1, 0, 1); PG8_SCHED; PG8_LDA(At, 0, 0); PG8_STAGE(PG8_SA(1, 1), a1 + hstep, voffA);
            PG8_WAIT_V(8); PG8_WAIT_L(0); PG8_BAR; PG8_MMA(0, 0, At, B0); PG8_MMA(0, 1, At, B1); PG8_BAR; PG8_SCHED;
            PG8_LDA(At, 0, 1); PG8_STAGE(PG8_SB(0, 0), b2, voffB); PG8_STAGE(PG8_SB(0, 1), b2 + hstep, voffB); PG8_STAGE(PG8_SA(0, 0), a2, voffA);
            PG8_WAIT_V(8); PG8_WAIT_L(0); PG8_BAR; PG8_MMA(1, 0, At, B0); PG8_MMA(1, 1, At, B1); PG8_BAR; PG8_SCHED;
            PG8_LDB(B0, 1, 0); PG8_LDB(B1, 1, 1); PG8_SCHED; PG8_LDA(At, 1, 0); PG8_STAGE(PG8_SA(0, 1), a2 + hstep, voffA);
            PG8_WAIT_V(8); PG8_WAIT_L(0); PG8_BAR; PG8_MMA(0, 0, At, B0); PG8_MMA(0, 1, At, B1); PG8_BAR; PG8_SCHED;
            PG8_LDA(At, 1, 1); PG8_STAGE(PG8_SB(1, 0), b3, voffB); PG8_STAGE(PG8_SB(1, 1), b3 + hstep, voffB); PG8_STAGE(PG8_SA(1, 0), a3, voffA);
            PG8_WAIT_V(8); PG8_WAIT_L(0); PG8_BAR; PG8_MMA(1, 0, At, B0); PG8_MMA(1, 1, At, B1); PG8_BAR; PG8_SCHED;
            } else {
            PG8_LDB(B0, 0, 0); PG8_SCHED; PG8_LDA(At, 0, 0); PG8_STAGE(PG8_SA(1, 1), a1 + hstep, voffA);
            PG8_WAIT_L(8); PG8_BAR; PG8_WAIT_L(0); PG8_MMA(0, 0, At, B0); PG8_BAR; PG8_SCHED;
            PG8_LDB(B1, 0, 1); PG8_STAGE(PG8_SB(0, 0), b2, voffB);
            PG8_BAR; PG8_WAIT_L(0); PG8_MMA(0, 1, At, B1); PG8_BAR;
            PG8_LDA(At, 0, 1); PG8_STAGE(PG8_SA(0, 0), a2, voffA);
            PG8_BAR; PG8_WAIT_L(0); PG8_MMA(1, 0, At, B0); PG8_BAR; PG8_SCHED;
            PG8_STAGE(PG8_SB(0, 1), b2 + hstep, voffB);
            PG8_WAIT_V(6); PG8_BAR; PG8_MMA(1, 1, At, B1); PG8_BAR;
            PG8_LDB(B0, 1, 0); PG8_SCHED; PG8_LDA(At, 1, 0); PG8_STAGE(PG8_SA(0, 1), a2 + hstep, voffA);
            PG8_WAIT_L(8); PG8_BAR; PG8_WAIT_L(0); PG8_MMA(0, 0, At, B0); PG8_BAR; PG8_SCHED;
            PG8_LDB(B1, 1, 1); PG8_STAGE(PG8_SB(1, 0), b3, voffB);
            PG8_BAR; PG8_WAIT_L(0); PG8_MMA(0, 1, At, B1); PG8_BAR;
            PG8_LDA(At, 1, 1); PG8_STAGE(PG8_SA(1, 0), a3, voffA);
            PG8_BAR; PG8_WAIT_L(0); PG8_MMA(1, 0, At, B0); PG8_BAR; PG8_SCHED;
            PG8_STAGE(PG8_SB(1, 1), b3 + hstep, voffB);
            PG8_WAIT_V(6); PG8_BAR; PG8_MMA(1, 1, At, B1); PG8_BAR;
            }
        }
        if constexpr (ALIGN_EPI) { if (wr == 0) PG8_BAR; }
        if constexpr (!Epi::AFTER_DRAIN) { E(acc, cur, wr, wc, fr, fq); S.done(cur); }
        if (!has_next) break;
#pragma unroll
        for (int a = 0; a < 2; ++a)
#pragma unroll
            for (int b = 0; b < 2; ++b)
#pragma unroll
                for (int m = 0; m < 4; ++m)
#pragma unroll
                    for (int n = 0; n < 2; ++n) acc[a][b][m][n] = (f32x4){0.f, 0.f, 0.f, 0.f};
        cur = nxt; cA = nA; cB = nB; ++ui;
        if constexpr (ALIGN_EPI) { if (wr == 1) PG8_BAR; }
    }
    PG8_WAIT_V(0);
    if constexpr (!ALIGN_EPI) { if (wr == 0) PG8_BAR; }
    PG8_BAR;
    if constexpr (Epi::AFTER_DRAIN) { E.fused(acc, cur, wr, wc, fr, fq, lds, wid, lane); S.done(cur); }
#undef PG8_SA
#undef PG8_SB
#undef PG8_STAGE
#undef PG8_LDA
#undef PG8_LDB
#undef PG8_MMA
#undef PG8_WAIT_V
#undef PG8_WAIT_L
#undef PG8_BAR
#undef PG8_SCHED
}
}
namespace pg8 {
struct EpiSwiGLU {
    static constexpr bool PERM = true, AFTER_DRAIN = false;
    bf16_t* O; int ldc;
    __device__ __forceinline__ void operator()(const f32x4 (&acc)[2][2][4][2], const Unit& u, int wr, int wc, int fr, int fq) const {
        const int row0 = u.pm * BM + wr * 64 + fr; const int col0 = u.pn * HALF + wc * 32 + 8 * fq;
#pragma unroll
        for (int ai = 0; ai < 2; ++ai)
#pragma unroll
            for (int m = 0; m < 4; ++m) { bf16_t* rowp = O + (size_t)(row0 + ai * HALF + m * 16) * ldc + col0;
                float v[8];
#pragma unroll
                for (int n = 0; n < 2; ++n)
#pragma unroll
                    for (int i = 0; i < 4; ++i) { const float g = acc[ai][0][m][n][i], up = acc[ai][1][m][n][i];
                        const float sg = g * __builtin_amdgcn_rcpf(1.0f + __builtin_amdgcn_exp2f(-1.4426950408889634f * g)); v[4 * n + i] = sg * up; }
                u32x4 w; w.x = cvt_pk_bf16(v[0], v[1]); w.y = cvt_pk_bf16(v[2], v[3]); w.z = cvt_pk_bf16(v[4], v[5]); w.w = cvt_pk_bf16(v[6], v[7]);
                *(u32x4*)rowp = w; }
    }
};
struct EpiF32 {
    static constexpr bool PERM = true, AFTER_DRAIN = false;
    float* O; int ldc;
    __device__ __forceinline__ void operator()(const f32x4 (&acc)[2][2][4][2], const Unit& u, int wr, int wc, int fr, int fq) const {
        const int row0 = u.pm * BM + wr * 64 + fr; const int col0 = u.pn * BM + wc * 32 + 8 * fq;
#pragma unroll
        for (int ai = 0; ai < 2; ++ai)
#pragma unroll
            for (int m = 0; m < 4; ++m) { float* rowp = O + (size_t)(row0 + ai * HALF + m * 16) * ldc + col0;
#pragma unroll
                for (int bj = 0; bj < 2; ++bj) { *(f32x4*)(rowp + bj * HALF) = acc[ai][bj][m][0]; *(f32x4*)(rowp + bj * HALF + 4) = acc[ai][bj][m][1]; } }
    }
};
struct EpiGlu {
    static constexpr bool PERM = true, AFTER_DRAIN = false;
    bf16_t* O; int ldc; const bf16_t* ys; int ldy; const float* bias;
    __device__ __forceinline__ void operator()(const f32x4 (&acc)[2][2][4][2], const Unit& u, int wr, int wc, int fr, int fq) const {
        const int row0 = u.pm * BM + wr * 64 + fr; const int col0 = u.pn * BM + wc * 32 + 8 * fq;
#pragma unroll
        for (int ai = 0; ai < 2; ++ai)
#pragma unroll
            for (int m = 0; m < 4; ++m) { const int row = row0 + ai * HALF + m * 16;
#pragma unroll
                for (int bj = 0; bj < 2; ++bj) { const int col = col0 + bj * HALF;
                    const u32x4 yp = *(const u32x4*)(ys + (size_t)row * ldy + col);
                    const f32x4 b0 = *(const f32x4*)(bias + col), b1 = *(const f32x4*)(bias + col + 4);
                    const float yv[8] = {__uint_as_float(yp.x << 16), __uint_as_float(yp.x & 0xffff0000u), __uint_as_float(yp.y << 16), __uint_as_float(yp.y & 0xffff0000u),
                                         __uint_as_float(yp.z << 16), __uint_as_float(yp.z & 0xffff0000u), __uint_as_float(yp.w << 16), __uint_as_float(yp.w & 0xffff0000u)};
                    float v[8];
#pragma unroll
                    for (int i = 0; i < 4; ++i) { const float z0 = acc[ai][bj][m][0][i] + b0[i], z1 = acc[ai][bj][m][1][i] + b1[i];
                        v[i] = yv[i] * __builtin_amdgcn_rcpf(1.0f + __builtin_amdgcn_exp2f(-1.4426950408889634f * z0));
                        v[4 + i] = yv[4 + i] * __builtin_amdgcn_rcpf(1.0f + __builtin_amdgcn_exp2f(-1.4426950408889634f * z1)); }
                    u32x4 w; w.x = cvt_pk_bf16(v[0], v[1]); w.y = cvt_pk_bf16(v[2], v[3]); w.z = cvt_pk_bf16(v[4], v[5]); w.w = cvt_pk_bf16(v[6], v[7]);
                    *(u32x4*)(O + (size_t)row * ldc + col) = w; } }
    }
};
struct EpiBf16Plain {
    static constexpr bool PERM = true, AFTER_DRAIN = false;
    bf16_t* O; int ldc;
    __device__ __forceinline__ void operator()(const f32x4 (&acc)[2][2][4][2], const Unit& u, int wr, int wc, int fr, int fq) const {
        const int row0 = u.pm * BM + wr * 64 + fr; const int col0 = u.pn * BM + wc * 32 + 8 * fq;
#pragma unroll
        for (int ai = 0; ai < 2; ++ai)
#pragma unroll
            for (int m = 0; m < 4; ++m) { bf16_t* rowp = O + (size_t)(row0 + ai * HALF + m * 16) * ldc + col0;
#pragma unroll
                for (int bj = 0; bj < 2; ++bj) { const f32x4 v0 = acc[ai][bj][m][0], v1 = acc[ai][bj][m][1];
                    u32x4 w; w.x = cvt_pk_bf16(v0[0], v0[1]); w.y = cvt_pk_bf16(v0[2], v0[3]); w.z = cvt_pk_bf16(v1[0], v1[1]); w.w = cvt_pk_bf16(v1[2], v1[3]);
                    *(u32x4*)(rowp + bj * HALF) = w; } }
    }
};
struct GatedUnit {
    Unit un; unsigned* cnt; unsigned want;
    __device__ __forceinline__ bool next(int i, Unit& u) const { u = un; return i == 0; }
    __device__ __forceinline__ void a_ready(const Unit&) const {
        if (threadIdx.x == 0) { unsigned sp = 0;
            while (__hip_atomic_load(cnt, __ATOMIC_RELAXED, __HIP_MEMORY_SCOPE_AGENT) < want) { __builtin_amdgcn_s_sleep(2); if (++sp > (1u << 22)) break; }
            __builtin_amdgcn_fence(__ATOMIC_ACQUIRE, "agent"); asm volatile("s_waitcnt vmcnt(0)" ::: "memory"); }
        __syncthreads();
    }
    __device__ __forceinline__ void done(const Unit&) const {}
};
}
#include <hip/hip_cooperative_groups.h>
namespace cg = cooperative_groups;
#define LAS __attribute__((address_space(3)))
typedef unsigned short bf16;
typedef float f32x4 __attribute__((ext_vector_type(4)));
typedef float f32x16 __attribute__((ext_vector_type(16)));
typedef short bf16x8 __attribute__((ext_vector_type(8)));
typedef short s16x4 __attribute__((ext_vector_type(4)));
typedef unsigned u32x4 __attribute__((ext_vector_type(4)));
typedef unsigned u32x2 __attribute__((ext_vector_type(2)));
typedef float f32x2_t __attribute__((ext_vector_type(2)));
typedef __bf16 bf16x2_t __attribute__((ext_vector_type(2)));

constexpr int NB = 4, SEQ = 2048, DM = 2048, M = NB * SEQ, FF = 5632, INC = 5120, NLAYER = 2;
constexpr int C_SBQ = 0, C_SBK = 768, C_SBV = 1536, C_U = 2304, C_DQ = 2816, C_DK = 3584, C_DV = 4352;
constexpr int MIX_SB = 0, MIX_SSM = 768, MIX_DIFF = 1280;
constexpr float EPS = 1e-6f;
constexpr float LOG2E = 1.4426950408889634f;
constexpr int NTHREADS = 512, NWAVES = 8;
constexpr int LDS_BYTES = 148480;

constexpr size_t SZ_WGU = (size_t)2 * FF * DM * 2, SZ_WD = (size_t)DM * FF * 2, SZ_WIN = (size_t)INC * DM * 2, SZ_WOUT = (size_t)DM * DM * 2, SZ_WGLU = (size_t)512 * 512 * 2;
constexpr size_t LW_GU1 = 0, LW_D1 = LW_GU1 + SZ_WGU, LW_IN = LW_D1 + SZ_WD, LW_OUT = LW_IN + SZ_WIN, LW_GLU = LW_OUT + SZ_WOUT, LW_GU2 = LW_GLU + SZ_WGLU, LW_D2 = LW_GU2 + SZ_WGU, LW_SIZE = LW_D2 + SZ_WD;
constexpr size_t WS_W = 1u << 20;
constexpr size_t WS_XN = WS_W + NLAYER * LW_SIZE;
constexpr size_t WS_BIG = WS_XN + (size_t)M * DM * 2;
constexpr size_t WS_Y = WS_BIG + (size_t)M * FF * 2;
constexpr size_t WS_MIX = WS_Y + (size_t)M * DM * 4;
constexpr size_t WS_YS = WS_MIX + (size_t)M * DM * 2;
constexpr size_t WS_YSB = WS_YS + (size_t)M * 512 * 4;
constexpr size_t WS_END = WS_YSB + (size_t)M * 512 * 2;

struct Args { const float* in[31]; float* out; unsigned char* ws; };
typedef __attribute__((address_space(4))) const Args* KArgs;
__device__ __forceinline__ KArgs kargs_ptr() { KArgs ap = (KArgs)__builtin_amdgcn_kernarg_segment_ptr(); asm volatile("" : "+s"(ap)); return ap; }
#define IN(k) (kargs_ptr()->in[(k)])

__device__ const unsigned char T5B[128] = {0, 1, 2, 3, 4, 5, 6, 7, 8, 9, 10, 11, 12, 13, 14, 15, 16, 16, 16, 17, 17, 18, 18, 18, 19, 19, 19, 20, 20, 20, 20, 21, 21, 21, 21, 22, 22, 22, 22, 22, 23, 23, 23, 23, 23, 23, 24, 24, 24, 24, 24, 24, 25, 25, 25, 25, 25, 25, 25, 26, 26, 26, 26, 26, 26, 26, 26, 27, 27, 27, 27, 27, 27, 27, 27, 27, 27, 28, 28, 28, 28, 28, 28, 28, 28, 28, 28, 29, 29, 29, 29, 29, 29, 29, 29, 29, 29, 29, 29, 30, 30, 30, 30, 30, 30, 30, 30, 30, 30, 30, 30, 30, 30, 31, 31, 31, 31, 31, 31, 31, 31, 31, 31, 31, 31, 31, 31, 31};

#define LDS_WAIT() asm volatile("s_waitcnt lgkmcnt(0)" ::: "memory")
#define WAVE_SYNC() do { asm volatile("s_waitcnt lgkmcnt(0)" ::: "memory"); __builtin_amdgcn_wave_barrier(); } while (0)
#define MFMA32(a, b, c) __builtin_amdgcn_mfma_f32_32x32x16_bf16((a), (b), (c), 0, 0, 0)
__device__ __forceinline__ unsigned f2bf(float f) { unsigned u = __float_as_uint(f); return (u + 0x7fffu + ((u >> 16) & 1u)) >> 16; }
__device__ __forceinline__ unsigned pk2(float lo, float hi) { return f2bf(lo) | (f2bf(hi) << 16); }
__device__ __forceinline__ unsigned cvtpk(float lo, float hi) { f32x2_t v = {lo, hi}; bf16x2_t b = __builtin_convertvector(v, bf16x2_t); return __builtin_bit_cast(unsigned, b); }
__device__ __forceinline__ float bf2f(unsigned short b) { return __uint_as_float(((unsigned)b) << 16); }
__device__ __forceinline__ float wave_sum(float v) {
#pragma unroll
    for (int o = 1; o < 64; o <<= 1) v += __shfl_xor(v, o);
    return v;
}
__device__ __forceinline__ int crow(int i, int h) { return (i & 3) + 8 * (i >> 2) + 4 * h; }

#define XB_TMO      128
#define XB_XCNT(j)  (256  + 64 * (j))
#define XB_XSUB(j)  (1280 + 64 * (j))
#define XB_XGEN(j)  (2304 + 64 * (j))
#define XB_TOP      3328
#define XB_TOPGEN   3392
#define XCD_BAR_WORDS 3456
#define XB_SPIN_CAP (1u << 18)

__device__ __forceinline__ unsigned xb_ld(unsigned* p)              { return __hip_atomic_load(p, __ATOMIC_RELAXED, __HIP_MEMORY_SCOPE_AGENT); }
__device__ __forceinline__ unsigned xb_add(unsigned* p, unsigned v) { return __hip_atomic_fetch_add(p, v, __ATOMIC_RELAXED, __HIP_MEMORY_SCOPE_AGENT); }
__device__ __forceinline__ unsigned xb_xcc_id() { return (unsigned)__builtin_amdgcn_s_getreg((3 << 11) | 20) & 0xFu; }
#define XB_SPIN(cond, bar) do { unsigned _sp = 0; while (cond) { __builtin_amdgcn_s_sleep(1); \
    if ((++_sp & 255u) == 0u) { if (xb_ld(&(bar)[XB_TMO])) break; if (_sp > XB_SPIN_CAP) { atomicAdd(&(bar)[XB_TMO], 1u); break; } } } } while (0)

struct XcdBarrier {
    unsigned* bar; unsigned x;
    volatile LAS unsigned* st;
};

__device__ __forceinline__ XcdBarrier xcd_barrier_post(unsigned* bar, volatile LAS unsigned* st) {
    XcdBarrier b; b.bar = bar; b.x = xb_xcc_id(); b.st = st;
    if (threadIdx.x == 0) (void)xb_add(&bar[XB_XCNT(b.x)], 1u);
    return b;
}
__device__ __forceinline__ void xcd_barrier_complete(unsigned* bar, unsigned x, unsigned& nloc, unsigned& nx) {
    const unsigned G = gridDim.x * gridDim.y * gridDim.z;
    unsigned sum, cnt, mine, sp = 0u;
    for (;;) {
        sum = 0u; cnt = 0u; mine = 0u;
#pragma unroll
        for (unsigned j = 0; j < 16; ++j) { const unsigned c = xb_ld(&bar[XB_XCNT(j)]); sum += c; cnt += (c > 0u) ? 1u : 0u; mine = (j == x) ? c : mine; }
        if (sum == G) break;
        __builtin_amdgcn_s_sleep(1);
        if ((++sp & 255u) == 0u) { if (xb_ld(&bar[XB_TMO])) break; if (sp > XB_SPIN_CAP) { atomicAdd(&bar[XB_TMO], 1u); break; } }
    }
    nloc = mine > 0u ? mine : 1u; nx = cnt > 0u ? cnt : 1u;
}

__device__ __forceinline__ void xcd_barrier(const XcdBarrier& b) {
    asm volatile("s_waitcnt vmcnt(0)" ::: "memory");
    __syncthreads();
    if (threadIdx.x == 0) {
        unsigned* bar = b.bar;
        __builtin_amdgcn_s_waitcnt(0);
        unsigned nloc = b.st[0], nx = b.st[1];
        if (nloc == 0u) { xcd_barrier_complete(bar, b.x, nloc, nx); b.st[0] = nloc; b.st[1] = nx; }
        const unsigned old = xb_add(&bar[XB_XSUB(b.x)], 1u);
        const unsigned gen = old / nloc;
        if (old + 1u == (gen + 1u) * nloc) {
            __builtin_amdgcn_fence(__ATOMIC_RELEASE, "agent");
            asm volatile("s_waitcnt vmcnt(0)" ::: "memory");
            const unsigned og = xb_add(&bar[XB_TOP], 1u);
            const unsigned tg = og / nx;
            if (og + 1u == (tg + 1u) * nx) xb_add(&bar[XB_TOPGEN], 1u);
            else XB_SPIN(xb_ld(&bar[XB_TOPGEN]) == tg, bar);
            __builtin_amdgcn_fence(__ATOMIC_ACQUIRE, "agent");
            xb_add(&bar[XB_XGEN(b.x)], 1u);
            asm volatile("s_waitcnt vmcnt(0)" ::: "memory");
        } else {
            XB_SPIN(xb_ld(&bar[XB_XGEN(b.x)]) == gen, bar);
            __builtin_amdgcn_fence(__ATOMIC_ACQUIRE, "agent");
            asm volatile("s_waitcnt vmcnt(0)" ::: "memory");
        }
    }
    __syncthreads();
}

__device__ __forceinline__ void transpose_item(const float* __restrict__ W, int K, int N, bf16* WT, int mode, LAS float* scr, int item, int lane) {
    const int nblk = N / 32, kb = item / nblk, nb = item % nblk, k0 = 64 * kb, n0 = 32 * nb;
#pragma unroll 8
    for (int i = 0; i < 32; ++i) { const int kk = 2 * i + (lane >> 5); scr[kk * 33 + (lane & 31)] = __builtin_nontemporal_load(&W[(size_t)(k0 + kk) * N + n0 + (lane & 31)]); }
    LDS_WAIT();
    const int rb = mode == 0 ? n0 : ((n0 >> 7) * 256 + (n0 & 127) + (mode == 2 ? 128 : 0));
    const int c = lane & 7;
#pragma unroll
    for (int j = 0; j < 4; ++j) { const int n = (lane >> 3) + 8 * j; const LAS float* s = scr + (8 * c) * 33 + n;
        u32x4 o; o.x = pk2(s[0 * 33], s[1 * 33]); o.y = pk2(s[2 * 33], s[3 * 33]); o.z = pk2(s[4 * 33], s[5 * 33]); o.w = pk2(s[6 * 33], s[7 * 33]);
        *(u32x4*)(WT + (size_t)(rb + n) * K + k0 + 8 * c) = o; }
    LDS_WAIT();
}

__device__ __forceinline__ void row_pass(const bf16* Y, const float* Hin, float* Hout, bf16* XN, const float* gpost, float wres, const float* gpre, int gw, int ngw, int lane) {
    for (int m = gw; m < M; m += ngw) {
        f32x4 hv[8];
        const f32x4* hr = (const f32x4*)(Hin + (size_t)m * DM) + 2 * lane;
#pragma unroll
        for (int j = 0; j < 4; ++j) { hv[2 * j] = hr[128 * j]; hv[2 * j + 1] = hr[128 * j + 1]; }
        if (Y) {
            f32x4 yv[8]; const u32x4* yr = (const u32x4*)(Y + (size_t)m * DM) + lane; float ss = 0.f;
#pragma unroll
            for (int j = 0; j < 4; ++j) { const u32x4 p = yr[64 * j];
                yv[2 * j] = (f32x4){__uint_as_float(p.x << 16), __uint_as_float(p.x & 0xffff0000u), __uint_as_float(p.y << 16), __uint_as_float(p.y & 0xffff0000u)};
                yv[2 * j + 1] = (f32x4){__uint_as_float(p.z << 16), __uint_as_float(p.z & 0xffff0000u), __uint_as_float(p.w << 16), __uint_as_float(p.w & 0xffff0000u)}; }
#pragma unroll
            for (int j = 0; j < 8; ++j) ss += (yv[j].x * yv[j].x + yv[j].y * yv[j].y) + (yv[j].z * yv[j].z + yv[j].w * yv[j].w);
            ss = wave_sum(ss);
            const float rstd = wres / sqrtf(ss * (1.0f / DM) + EPS);
#pragma unroll
            for (int j = 0; j < 4; ++j) { const f32x4 g0 = ((const f32x4*)gpost)[2 * lane + 128 * j], g1 = ((const f32x4*)gpost)[2 * lane + 128 * j + 1];
                hv[2 * j] = hv[2 * j] + yv[2 * j] * g0 * rstd; hv[2 * j + 1] = hv[2 * j + 1] + yv[2 * j + 1] * g1 * rstd; }
        }
        if (Hout) { f32x4* ho = (f32x4*)(Hout + (size_t)m * DM) + 2 * lane;
#pragma unroll
            for (int j = 0; j < 4; ++j) { ho[128 * j] = hv[2 * j]; ho[128 * j + 1] = hv[2 * j + 1]; } }
        if (gpre) {
            float s2 = 0.f;
#pragma unroll
            for (int j = 0; j < 8; ++j) s2 += (hv[j].x * hv[j].x + hv[j].y * hv[j].y) + (hv[j].z * hv[j].z + hv[j].w * hv[j].w);
            s2 = wave_sum(s2);
            const float r2 = 1.0f / sqrtf(s2 * (1.0f / DM) + EPS);
            u32x4* xo = (u32x4*)(XN + (size_t)m * DM) + lane;
#pragma unroll
            for (int j = 0; j < 4; ++j) { const f32x4 g0 = ((const f32x4*)gpre)[2 * lane + 128 * j], g1 = ((const f32x4*)gpre)[2 * lane + 128 * j + 1];
                const f32x4 v0 = hv[2 * j] * g0 * r2, v1 = hv[2 * j + 1] * g1 * r2; u32x4 o; o.x = pk2(v0.x, v0.y); o.y = pk2(v0.z, v0.w); o.z = pk2(v1.x, v1.y); o.w = pk2(v1.z, v1.w); xo[64 * j] = o; }
        }
    }
}

constexpr int KP = 272, VP = 320;
constexpr int KBYTES = 64 * KP, VBYTES = 64 * VP;
constexpr int A_K = 0, A_V = 2 * KBYTES, A_BIAS = A_V + 2 * VBYTES, A_FLAG = A_BIAS + 1024, A_Q = A_FLAG + 1024, A_END = A_Q + 8 * 32 * KP;

__device__ __forceinline__ void tile_prefetch(u32x4 (&rg)[2], const bf16* g, int tid) {
#pragma unroll
    for (int i = 0; i < 2; ++i) { const int chunk = tid + 512 * i, row = chunk >> 4, ch = chunk & 15; rg[i] = *(const u32x4*)(g + (size_t)row * INC + ch * 8); }
}
__device__ __forceinline__ void tile_store(LAS char* dst, int pitch, const u32x4 (&rg)[2], int tid) {
#pragma unroll
    for (int i = 0; i < 2; ++i) { const int chunk = tid + 512 * i, row = chunk >> 4, ch = chunk & 15; *(LAS u32x4*)(dst + row * pitch + ch * 16) = rg[i]; }
}
__device__ __forceinline__ void pv_half(f32x16 (&o)[4], const LAS char* Vb, int kh, bf16x8 P0, bf16x8 P1, int lane) {
    const int h = lane >> 5, i16 = lane & 15, qq = i16 >> 2, p = i16 & 3, blk = (lane >> 4) & 1;
    const LAS char* vb = Vb + (32 * kh + 4 * h + qq) * VP + (16 * blk + 4 * p) * 2;
#pragma unroll
    for (int s2 = 0; s2 < 2; ++s2)
#pragma unroll
        for (int db = 0; db < 4; ++db) {
            const s16x4 lo = __builtin_bit_cast(s16x4, __builtin_amdgcn_ds_read_tr16_b64_v4i16((LAS s16x4*)(vb + (16 * s2) * VP + db * 64)));
            const s16x4 hi = __builtin_bit_cast(s16x4, __builtin_amdgcn_ds_read_tr16_b64_v4i16((LAS s16x4*)(vb + (16 * s2 + 8) * VP + db * 64)));
            const bf16x8 vf = __builtin_shufflevector(lo, hi, 0, 1, 2, 3, 4, 5, 6, 7);
            o[db] = MFMA32(vf, s2 == 0 ? P0 : P1, o[db]);
        }
}

__device__ __forceinline__ void sb_unit(LAS char* lds, const bf16* PROJ, bf16* MIX, int b, int hd, int qb) {
    int tid_o = threadIdx.x; asm volatile("" : "+v"(tid_o)); const int tid = tid_o, lane = tid & 63, r = lane & 31, h = lane >> 5, w = __builtin_amdgcn_readfirstlane(tid >> 6);
    const int q0 = qb * 256, qw = q0 + 32 * w, q = qw + r;
    const size_t rowb = (size_t)b * SEQ;
    const float SCALE = 0.08838834764831845f;
    bf16x8 qf[8];
    { const bf16* Qg = PROJ + (rowb + q) * INC + C_SBQ + hd * 128 + 8 * h;
#pragma unroll
      for (int s = 0; s < 8; ++s) qf[s] = *(const bf16x8*)(Qg + 16 * s); }
    const bf16* Kg = PROJ + rowb * INC + C_SBK + hd * 128; const bf16* Vg = PROJ + rowb * INC + C_SBV + hd * 128;
    f32x16 o[4];
#pragma unroll
    for (int d = 0; d < 4; ++d)
#pragma unroll
        for (int i = 0; i < 16; ++i) o[d][i] = 0.f;
    float R = 0.f; bool wdone = false;
    const int kt_hi = (q0 + 255) >> 6;
    volatile LAS int* flags = (volatile LAS int*)(lds + A_FLAG);
    u32x4 kr[2], vr[2];
    tile_prefetch(kr, Kg + (size_t)(kt_hi * 64) * INC, tid); tile_prefetch(vr, Vg + (size_t)(kt_hi * 64) * INC, tid);
    int it = 0;
    for (int kt = kt_hi; kt >= 0; --kt, ++it) {
        const int buf = it & 1;
        LAS char* Kb = lds + A_K + buf * KBYTES; LAS char* Vb = lds + A_V + buf * VBYTES;
        tile_store(Kb, KP, kr, tid); tile_store(Vb, VP, vr, tid);
        __syncthreads();
        if (it > 0) { int alld = 1;
#pragma unroll
            for (int ww = 0; ww < 8; ++ww) alld &= flags[((it - 1) & 1) * 8 + ww];
            if (alld) break; }
        if (kt > 0) { tile_prefetch(kr, Kg + (size_t)((kt - 1) * 64) * INC, tid); tile_prefetch(vr, Vg + (size_t)((kt - 1) * 64) * INC, tid); }
        const int k0 = kt * 64;
        if (k0 < qw + 31 && !wdone) {
#pragma unroll
            for (int kh = 1; kh >= 0; --kh) {
                f32x16 c;
#pragma unroll
                for (int i = 0; i < 16; ++i) c[i] = 0.f;
                const LAS char* kp = Kb + (32 * kh + r) * KP + 16 * h;
#pragma unroll
                for (int s = 0; s < 8; ++s) { const bf16x8 kf = *(const LAS bf16x8*)(kp + 32 * s); c = MFMA32(kf, qf[s], c); }
                const int keyb = k0 + 32 * kh + 4 * h;
                float lk[16], lb[16], gs[4], og[4];
#pragma unroll
                for (int i = 0; i < 16; ++i) { const int key = keyb + (i & 3) + 8 * (i >> 2); const float z = c[i] * SCALE;
                    const float e = __expf(-fabsf(z)); const float ls = fminf(z, 0.f) - __logf(1.0f + e);
                    lb[i] = ls; lk[i] = (key < q) ? (ls - z) : 0.f; }
#pragma unroll
                for (int g = 0; g < 4; ++g) { gs[g] = (lk[4 * g] + lk[4 * g + 1]) + (lk[4 * g + 2] + lk[4 * g + 3]); og[g] = __shfl_xor(gs[g], 32); }
                const float sg = (gs[0] + gs[1]) + (gs[2] + gs[3]), so = (og[0] + og[1]) + (og[2] + og[3]);
                float after[4];
                after[3] = (h ? 0.f : og[3]);
                after[2] = gs[3] + og[3] + (h ? 0.f : og[2]);
                after[1] = gs[3] + gs[2] + og[3] + og[2] + (h ? 0.f : og[1]);
                after[0] = gs[3] + gs[2] + gs[1] + og[3] + og[2] + og[1] + (h ? 0.f : og[0]);
                float wv[16];
#pragma unroll
                for (int g = 0; g < 4; ++g) { const float base = R + after[g];
                    const float s3 = 0.f, s2 = lk[4 * g + 3], s1 = s2 + lk[4 * g + 2], s0 = s1 + lk[4 * g + 1];
                    const float bt[4] = {s0, s1, s2, s3};
#pragma unroll
                    for (int j = 0; j < 4; ++j) { const int i = 4 * g + j; const int key = keyb + j + 8 * g;
                        wv[i] = (key < q) ? __expf(lb[i] + base + bt[j]) : 0.f; } }
                R += sg + so;
                u32x4 p0, p1;
                p0.x = cvtpk(wv[0], wv[1]); p0.y = cvtpk(wv[2], wv[3]); p0.z = cvtpk(wv[4], wv[5]); p0.w = cvtpk(wv[6], wv[7]);
                p1.x = cvtpk(wv[8], wv[9]); p1.y = cvtpk(wv[10], wv[11]); p1.z = cvtpk(wv[12], wv[13]); p1.w = cvtpk(wv[14], wv[15]);
                pv_half(o, Vb, kh, __builtin_bit_cast(bf16x8, p0), __builtin_bit_cast(bf16x8, p1), lane);
            }
            wdone = __all(R < -110.f);
        }
        if (lane == 0) flags[(it & 1) * 8 + w] = wdone ? 1 : 0;
    }
    bf16* Og = MIX + (rowb + q) * DM + MIX_SB + hd * 128 + 4 * h;
#pragma unroll
    for (int db = 0; db < 4; ++db)
#pragma unroll
        for (int g = 0; g < 4; ++g) { u32x2 ov; ov.x = cvtpk(o[db][4 * g], o[db][4 * g + 1]); ov.y = cvtpk(o[db][4 * g + 2], o[db][4 * g + 3]); *(u32x2*)(Og + 32 * db + 8 * g) = ov; }
    __syncthreads();
}

__device__ __forceinline__ f32x16 diff_qk(const LAS char* kp, const LAS char* qp) {
    f32x16 c;
#pragma unroll
    for (int i = 0; i < 16; ++i) c[i] = 0.f;
#pragma unroll
    for (int s = 0; s < 4; ++s) { const bf16x8 kf = *(const LAS bf16x8*)(kp + 32 * s); const bf16x8 qf = *(const LAS bf16x8*)(qp + 32 * s); c = MFMA32(kf, qf, c); }
    return c;
}
__device__ __forceinline__ void diff_sm(f32x16& c, bool far, float bfar, const LAS float* bt, int q, int keyb, float& m, float& l, f32x16 (&o)[4], bf16x8& P0, bf16x8& P1) {
    const float SC2 = 0.125f * LOG2E;
    if (far) {
#pragma unroll
        for (int i = 0; i < 16; ++i) c[i] = c[i] * SC2 + bfar;
    } else {
#pragma unroll
        for (int i = 0; i < 16; ++i) { const int key = keyb + (i & 3) + 8 * (i >> 2); const int n = q - key; const int ni = n < 0 ? 0 : (n > 128 ? 128 : n);
            c[i] = (n < 0) ? -INFINITY : (c[i] * SC2 + bt[ni]); }
    }
    float mx = fmaxf(fmaxf(c[0], c[1]), fmaxf(c[2], c[3]));
#pragma unroll
    for (int i = 4; i < 16; i += 4) mx = fmaxf(mx, fmaxf(fmaxf(c[i], c[i + 1]), fmaxf(c[i + 2], c[i + 3])));
    mx = fmaxf(mx, __shfl_xor(mx, 32));
    const float mnew = fmaxf(m, mx);
    if (__any(mx > m + 8.0f)) {
        const float sc = __builtin_amdgcn_exp2f(m - mnew); l *= sc;
#pragma unroll
        for (int d = 0; d < 4; ++d)
#pragma unroll
            for (int i = 0; i < 16; ++i) o[d][i] *= sc;
        m = mnew;
    }
    float a = 0.f;
#pragma unroll
    for (int i = 0; i < 16; ++i) { c[i] = __builtin_amdgcn_exp2f(c[i] - m); a += c[i]; }
    l += a;
    u32x4 p0, p1;
    p0.x = cvtpk(c[0], c[1]); p0.y = cvtpk(c[2], c[3]); p0.z = cvtpk(c[4], c[5]); p0.w = cvtpk(c[6], c[7]);
    p1.x = cvtpk(c[8], c[9]); p1.y = cvtpk(c[10], c[11]); p1.z = cvtpk(c[12], c[13]); p1.w = cvtpk(c[14], c[15]);
    P0 = __builtin_bit_cast(bf16x8, p0); P1 = __builtin_bit_cast(bf16x8, p1);
}
__device__ __forceinline__ void diff_unit(LAS char* lds, const bf16* PROJ, bf16* MIX, const float* relb, float lam, float outscale, const float* subg, int b, int hd, int qb) {
    int tid_o = threadIdx.x; asm volatile("" : "+v"(tid_o)); const int tid = tid_o, lane = tid & 63, r = lane & 31, h = lane >> 5, w = __builtin_amdgcn_readfirstlane(tid >> 6);
    const int rg = w & 3, kh = w >> 2;
    const int q0 = qb * 128, qw = q0 + 32 * rg, q = qw + r;
    const size_t rowb = (size_t)b * SEQ;
    LAS float* bt = (LAS float*)(lds + A_BIAS);
    if (tid < 129) { const int bucket = tid < 128 ? (int)T5B[tid] : 31; bt[tid] = relb[bucket * 6 + hd] * LOG2E; }
    LAS char* qp = lds + A_Q + w * (32 * KP) + r * KP + 16 * h;
    { const bf16* Qg = PROJ + (rowb + q) * INC + C_DQ + hd * 128 + 8 * h;
#pragma unroll
      for (int s = 0; s < 8; ++s) *(LAS u32x4*)(qp + 32 * s) = *(const u32x4*)(Qg + 16 * s); }
    const bf16* Kg = PROJ + rowb * INC + C_DK + hd * 128; const bf16* Vg = PROJ + rowb * INC + C_DV + hd * 128;
    float m1 = -1e30f, m2 = -1e30f, l1 = 0.f, l2 = 0.f;
    f32x16 o1[4], o2[4];
#pragma unroll
    for (int d = 0; d < 4; ++d)
#pragma unroll
        for (int i = 0; i < 16; ++i) { o1[d][i] = 0.f; o2[d][i] = 0.f; }
    const int nt = ((q0 + 127) >> 6) + 1;
    u32x4 kr[2], vr[2];
    tile_prefetch(kr, Kg, tid); tile_prefetch(vr, Vg, tid);
#pragma unroll 1
    for (int kt = 0; kt < nt; ++kt) {
        const int buf = kt & 1;
        LAS char* Kb = lds + A_K + buf * KBYTES; LAS char* Vb = lds + A_V + buf * VBYTES;
        tile_store(Kb, KP, kr, tid); tile_store(Vb, VP, vr, tid);
        __syncthreads();
        if (kt + 1 < nt) { tile_prefetch(kr, Kg + (size_t)((kt + 1) * 64) * INC, tid); tile_prefetch(vr, Vg + (size_t)((kt + 1) * 64) * INC, tid); }
        const int k0 = kt * 64;
        if (k0 + 32 * kh <= qw + 31) {
            const bool far = (qw - (k0 + 63)) >= 128; const float bfar = bt[128];
            const LAS char* kp = Kb + (32 * kh + r) * KP + 16 * h;
            const int keyb = k0 + 32 * kh + 4 * h;
            bf16x8 Pa, Pb, Pc, Pd;
            f32x16 c1 = diff_qk(kp, qp), c2 = diff_qk(kp + 128, qp + 128);
            diff_sm(c1, far, bfar, bt, q, keyb, m1, l1, o1, Pa, Pb);
            pv_half(o1, Vb, kh, Pa, Pb, lane);
            diff_sm(c2, far, bfar, bt, q, keyb, m2, l2, o2, Pc, Pd);
            pv_half(o2, Vb, kh, Pc, Pd, lane);
            __builtin_amdgcn_sched_barrier(0);
        }
    }
    l1 += __shfl_xor(l1, 32); l2 += __shfl_xor(l2, 32);
    __syncthreads();
    LAS float* EX = (LAS float*)(lds + rg * 16384) + lane;
    LAS float* ST = (LAS float*)(lds + 65536 + rg * 1024) + lane;
    if (kh == 1) { ST[0] = m1; ST[64] = l1; ST[128] = m2; ST[192] = l2;
#pragma unroll
        for (int d = 0; d < 4; ++d)
#pragma unroll
            for (int i = 0; i < 16; ++i) EX[(16 * d + i) * 64] = o1[d][i]; }
    __syncthreads();
    float f2a = 1.f, f2b = 0.f;
    if (kh == 0) {
        const float mb1 = ST[0], lb1 = ST[64], mb2 = ST[128], lb2 = ST[192];
        const float mn1 = fmaxf(m1, mb1), fa = __builtin_amdgcn_exp2f(m1 - mn1), fb = __builtin_amdgcn_exp2f(mb1 - mn1);
        l1 = l1 * fa + lb1 * fb;
#pragma unroll
        for (int d = 0; d < 4; ++d)
#pragma unroll
            for (int i = 0; i < 16; ++i) o1[d][i] = o1[d][i] * fa + EX[(16 * d + i) * 64] * fb;
        const float mn2 = fmaxf(m2, mb2); f2a = __builtin_amdgcn_exp2f(m2 - mn2); f2b = __builtin_amdgcn_exp2f(mb2 - mn2);
        l2 = l2 * f2a + lb2 * f2b;
    }
    __syncthreads();
    if (kh == 1) {
#pragma unroll
        for (int d = 0; d < 4; ++d)
#pragma unroll
            for (int i = 0; i < 16; ++i) EX[(16 * d + i) * 64] = o2[d][i]; }
    __syncthreads();
    if (kh == 0) {
        const float inv1 = 1.0f / l1, inv2 = lam / l2;
        float ss = 0.f;
#pragma unroll
        for (int db = 0; db < 4; ++db)
#pragma unroll
            for (int i = 0; i < 16; ++i) { const float v2 = o2[db][i] * f2a + EX[(16 * db + i) * 64] * f2b; const float v = o1[db][i] * inv1 - v2 * inv2; o1[db][i] = v; ss += v * v; }
        ss += __shfl_xor(ss, 32);
        const float rs = outscale / sqrtf(ss * (1.0f / 128.0f) + EPS);
        bf16* Og = MIX + (rowb + q) * DM + MIX_DIFF + hd * 128 + 4 * h;
#pragma unroll
        for (int db = 0; db < 4; ++db)
#pragma unroll
            for (int g = 0; g < 4; ++g) { const f32x4 gg = *(const f32x4*)(subg + 32 * db + 8 * g + 4 * h);
                u32x2 ov; ov.x = cvtpk(o1[db][4 * g] * rs * gg.x, o1[db][4 * g + 1] * rs * gg.y); ov.y = cvtpk(o1[db][4 * g + 2] * rs * gg.z, o1[db][4 * g + 3] * rs * gg.w); *(u32x2*)(Og + 32 * db + 8 * g) = ov; }
    }
    __syncthreads();
}

constexpr int S_E = 0, S_XT = 16384, S_XTB = 32 * KP;
__device__ __forceinline__ float gelu_tanh(float y) {
    const float a = 0.7978845608028654f * (y + 0.044715f * y * y * y);
    const float t = 1.0f - 2.0f / (__expf(2.0f * a) + 1.0f);
    return 0.5f * y * (1.0f + t);
}
#define SSM_BU(uf_) \
    f32x16 a_re, b_re, a_im, b_im; \
    { f32x16 z; _Pragma("unroll") for (int i = 0; i < 16; ++i) z[i] = 0.f; \
      a_re = MFMA32(uf_, bfrag[0], z); b_re = MFMA32(uf_, bfrag[1], z); a_im = MFMA32(uf_, bfrag[2], z); b_im = MFMA32(uf_, bfrag[3], z); \
      _Pragma("unroll") for (int i = 0; i < 16; ++i) { \
          auto s1 = __builtin_amdgcn_permlane32_swap(__float_as_uint(a_re[i]), __float_as_uint(b_re[i]), false, false); a_re[i] = __uint_as_float(s1[0]); b_re[i] = __uint_as_float(s1[1]); \
          auto s2 = __builtin_amdgcn_permlane32_swap(__float_as_uint(a_im[i]), __float_as_uint(b_im[i]), false, false); a_im[i] = __uint_as_float(s2[0]); b_im[i] = __uint_as_float(s2[1]); } }
#define SSM_ADV(bur_, bui_) do { const float nxr = lr * xr - li * xi + (bur_), nxi = lr * xi + li * xr + (bui_); xr = nxr; xi = nxi; } while (0)
__device__ __forceinline__ void ssm_unit(LAS char* lds, int l, const bf16* PROJ, bf16* YSB, int b, int g, unsigned* done_cnt) {
    int tid_o = threadIdx.x; asm volatile("" : "+v"(tid_o)); const int tid = tid_o, lane = tid & 63, r = lane & 31, h = lane >> 5, w = __builtin_amdgcn_readfirstlane(tid >> 6);
    const int lg = l * 32 + g;
    const size_t rowb = (size_t)b * SEQ;
    LAS float* E = (LAS float*)(lds + S_E);
    LAS char* XT = lds + S_XT + w * S_XTB;
    const int trow = 16 * ((r >> 2) & 1) + (r & 3) + 4 * (r >> 3);
    const float ar = IN(8)[lg * 64 + lane], ai = IN(9)[lg * 64 + lane], dt = expf(IN(10)[lg]);
    const float mag = expf(ar * dt); const float lr = mag * cosf(ai * dt), li = mag * sinf(ai * dt);
    const float den = ar * ar + ai * ai;
    const float fr = ((lr - 1.0f) * ar + li * ai) / den, fi = (li * ar - (lr - 1.0f) * ai) / den;
    bf16x8 bfrag[4];
    { float bbr[16], bbi[16], pbr[16], pbi[16];
      const f32x4* br4 = (const f32x4*)(IN(11) + ((size_t)lg * 64 + lane) * 16); const f32x4* bi4 = (const f32x4*)(IN(12) + ((size_t)lg * 64 + lane) * 16);
#pragma unroll
      for (int j = 0; j < 4; ++j) { const f32x4 br = br4[j], bi = bi4[j];
#pragma unroll
          for (int e = 0; e < 4; ++e) { bbr[4 * j + e] = fr * br[e] - fi * bi[e]; bbi[4 * j + e] = fr * bi[e] + fi * br[e]; } }
#pragma unroll
      for (int c = 0; c < 16; ++c) { pbr[c] = __shfl_xor(bbr[c], 32); pbi[c] = __shfl_xor(bbi[c], 32); }
#pragma unroll
      for (int nb = 0; nb < 4; ++nb) { const bool own = ((nb & 1) == h); float v[8];
#pragma unroll
          for (int j = 0; j < 8; ++j) { const float o_ = (nb < 2) ? (h ? bbr[8 + j] : bbr[j]) : (h ? bbi[8 + j] : bbi[j]); const float p_ = (nb < 2) ? (h ? pbr[8 + j] : pbr[j]) : (h ? pbi[8 + j] : pbi[j]); v[j] = own ? o_ : p_; }
          u32x4 pk; pk.x = cvtpk(v[0], v[1]); pk.y = cvtpk(v[2], v[3]); pk.z = cvtpk(v[4], v[5]); pk.w = cvtpk(v[6], v[7]); bfrag[nb] = __builtin_bit_cast(bf16x8, pk); } }
    bf16x8 cmf[9];
#pragma unroll
    for (int s = 0; s < 8; ++s) { u32x4 pk = {0u, 0u, 0u, 0u};
        if (r < 16) { const float* src = (s < 4 ? IN(13) : IN(14)) + ((size_t)lg * 16 + r) * 64 + 16 * (s & 3) + 8 * h; const float sg = s < 4 ? 1.0f : -1.0f;
            const f32x4 a = *(const f32x4*)src * sg, c = *(const f32x4*)(src + 4) * sg;
            pk.x = cvtpk(a.x, a.y); pk.y = cvtpk(a.z, a.w); pk.z = cvtpk(c.x, c.y); pk.w = cvtpk(c.z, c.w); }
        cmf[s] = __builtin_bit_cast(bf16x8, pk); }
    { const float dsk = IN(15)[lg * 16 + (r & 15)]; float v[8];
#pragma unroll
      for (int j = 0; j < 8; ++j) v[j] = (r < 16 && (8 * h + j) == r) ? dsk : 0.f;
      u32x4 pk; pk.x = cvtpk(v[0], v[1]); pk.y = cvtpk(v[2], v[3]); pk.z = cvtpk(v[4], v[5]); pk.w = cvtpk(v[6], v[7]); cmf[8] = __builtin_bit_cast(bf16x8, pk); }
    float l64r = lr, l64i = li;
#pragma unroll
    for (int s = 0; s < 6; ++s) { const float nr = l64r * l64r - l64i * l64i, ni = 2.0f * l64r * l64i; l64r = nr; l64i = ni; }
#define SSM_UADDR(bi_) (PROJ + (rowb + 64 * (w + 8 * ((bi_) >> 1)) + 32 * ((bi_) & 1) + trow) * INC + C_U + g * 16 + 8 * h)
    {
        bf16x8 ufc = *(const bf16x8*)SSM_UADDR(0);
        float xr = 0.f, xi = 0.f;
#pragma unroll 1
        for (int bi = 0; bi < 8; ++bi) {
            const bf16x8 ufn = *(const bf16x8*)SSM_UADDR(bi < 7 ? bi + 1 : 7);
            SSM_BU(ufc)
#pragma unroll
            for (int i = 0; i < 16; ++i) SSM_ADV(a_re[i], a_im[i]);
#pragma unroll
            for (int i = 0; i < 16; ++i) SSM_ADV(b_re[i], b_im[i]);
            if (bi & 1) { const int k = w + 8 * (bi >> 1); E[k * 128 + lane] = xr; E[k * 128 + 64 + lane] = xi; xr = 0.f; xi = 0.f; }
            ufc = ufn;
        }
    }
    __syncthreads();
    LAS char* xw = XT + 2 * lane;
    const LAS char* xrd = XT + r * KP + 16 * h;
    {
        float cr = 0.f, ci = 0.f;
#pragma unroll 1
        for (int k = 0; k < w; ++k) { const float er = E[k * 128 + lane], ei = E[k * 128 + 64 + lane]; const float nr = l64r * cr - l64i * ci + er, ni = l64r * ci + l64i * cr + ei; cr = nr; ci = ni; }
        bf16x8 ufc = *(const bf16x8*)SSM_UADDR(0);
        float xr = cr, xi = ci;
#pragma unroll 1
        for (int bi = 0; bi < 8; ++bi) {
            const bf16x8 ufn = *(const bf16x8*)SSM_UADDR(bi < 7 ? bi + 1 : 7);
            const size_t row0 = rowb + 64 * (w + 8 * (bi >> 1)) + 32 * (bi & 1);
            { SSM_BU(ufc)
#pragma unroll
              for (int i = 0; i < 16; ++i) { SSM_ADV(a_re[i], a_im[i]); const unsigned pk = cvtpk(xr, xi); const int rho = 8 * (i >> 2) + (i & 3);
                  *(LAS unsigned short*)(xw + rho * KP) = (unsigned short)pk; *(LAS unsigned short*)(xw + rho * KP + 128) = (unsigned short)(pk >> 16); }
#pragma unroll
              for (int i = 0; i < 16; ++i) { SSM_ADV(b_re[i], b_im[i]); const unsigned pk = cvtpk(xr, xi); const int rho = 8 * (i >> 2) + 4 + (i & 3);
                  *(LAS unsigned short*)(xw + rho * KP) = (unsigned short)pk; *(LAS unsigned short*)(xw + rho * KP + 128) = (unsigned short)(pk >> 16); } }
            WAVE_SYNC();
            f32x16 y;
#pragma unroll
            for (int i = 0; i < 16; ++i) y[i] = 0.f;
            y = MFMA32(cmf[8], ufc, y);
#pragma unroll
            for (int s = 0; s < 8; ++s) { const bf16x8 xa = *(const LAS bf16x8*)(xrd + 32 * s); y = MFMA32(cmf[s], xa, y); }
            {
                bf16* yo = YSB + (row0 + trow) * 512 + g * 16 + 4 * h;
                u32x2 w0, w1;
                w0.x = pk2(gelu_tanh(y[0]), gelu_tanh(y[1])); w0.y = pk2(gelu_tanh(y[2]), gelu_tanh(y[3]));
                w1.x = pk2(gelu_tanh(y[4]), gelu_tanh(y[5])); w1.y = pk2(gelu_tanh(y[6]), gelu_tanh(y[7]));
                *(u32x2*)yo = w0; *(u32x2*)(yo + 8) = w1;
            }
            WAVE_SYNC();
            if ((bi & 1) && bi < 7) {
                const int k0c = w + 8 * (bi >> 1);
#pragma unroll 1
                for (int k = k0c; k < k0c + 8; ++k) { const float er = E[k * 128 + lane], ei = E[k * 128 + 64 + lane]; const float nr = l64r * cr - l64i * ci + er, ni = l64r * ci + l64i * cr + ei; cr = nr; ci = ni; }
                xr = cr; xi = ci;
            }
            ufc = ufn;
        }
    }
    asm volatile("s_waitcnt vmcnt(0)" ::: "memory");
    __syncthreads();
    if (tid == 0) { __builtin_amdgcn_fence(__ATOMIC_RELEASE, "agent"); asm volatile("s_waitcnt vmcnt(0)" ::: "memory"); __hip_atomic_fetch_add(done_cnt, 1u, __ATOMIC_RELAXED, __HIP_MEMORY_SCOPE_AGENT); }
}
#undef SSM_UADDR
#undef SSM_BU
#undef SSM_ADV
constexpr int I_G = (DM / 64) * (FF / 32), I_D = (FF / 64) * (DM / 32), I_IN = (DM / 64) * (INC / 32), I_OUT = (DM / 64) * (DM / 32), I_GLU = (512 / 64) * (512 / 32);
constexpr int CV_PER_LAYER = 4 * I_G + 2 * I_D + I_IN + I_OUT + I_GLU, CV_TOTAL = NLAYER * CV_PER_LAYER;
static_assert(CV_TOTAL % 8 == 0 && (2 * I_G) % 8 == 0, "batches of 8");
__device__ __forceinline__ void convert_item(int it, unsigned char* wsb, LAS float* scr, int lane) {
    const int l = it / CV_PER_LAYER; int r = it % CV_PER_LAYER;
    unsigned char* lw0 = wsb + WS_W + (size_t)l * LW_SIZE;
    if (r < I_G) { transpose_item(IN(2) + (size_t)l * DM * FF, DM, FF, (bf16*)(lw0 + LW_GU1), 1, scr, r, lane); return; } r -= I_G;
    if (r < I_G) { transpose_item(IN(3) + (size_t)l * DM * FF, DM, FF, (bf16*)(lw0 + LW_GU1), 2, scr, r, lane); return; } r -= I_G;
    if (r < I_D) { transpose_item(IN(4) + (size_t)l * FF * DM, FF, DM, (bf16*)(lw0 + LW_D1), 0, scr, r, lane); return; } r -= I_D;
    if (r < I_IN) { transpose_item(IN(7) + (size_t)l * DM * INC, DM, INC, (bf16*)(lw0 + LW_IN), 0, scr, r, lane); return; } r -= I_IN;
    if (r < I_OUT) { transpose_item(IN(24) + (size_t)l * DM * DM, DM, DM, (bf16*)(lw0 + LW_OUT), 0, scr, r, lane); return; } r -= I_OUT;
    if (r < I_GLU) { transpose_item(IN(16) + (size_t)l * 512 * 512, 512, 512, (bf16*)(lw0 + LW_GLU), 0, scr, r, lane); return; } r -= I_GLU;
    if (r < I_G) { transpose_item(IN(27) + (size_t)l * DM * FF, DM, FF, (bf16*)(lw0 + LW_GU2), 1, scr, r, lane); return; } r -= I_G;
    if (r < I_G) { transpose_item(IN(28) + (size_t)l * DM * FF, DM, FF, (bf16*)(lw0 + LW_GU2), 2, scr, r, lane); return; } r -= I_G;
    transpose_item(IN(29) + (size_t)l * FF * DM, FF, DM, (bf16*)(lw0 + LW_D2), 0, scr, r, lane);
}
__device__ __forceinline__ void convert_static(int start, int end, int b0, int nb, unsigned char* wsb, LAS unsigned char* lds) {
    const int ib = (int)blockIdx.x - b0; if (ib < 0 || ib >= nb) return;
    int tid_o = threadIdx.x; asm volatile("" : "+v"(tid_o)); const int lane = tid_o & 63, wave = __builtin_amdgcn_readfirstlane(tid_o >> 6);
    LAS float* scr = (LAS float*)(lds + wave * 16384);
#pragma unroll 1
    for (int it = start + ib * NWAVES + wave; it < end; it += nb * NWAVES) convert_item(it, wsb, scr, lane);
}
__device__ __forceinline__ void convert_batch64(int c0, unsigned char* wsb, LAS unsigned char* lds) {
    int tid_o = threadIdx.x; asm volatile("" : "+v"(tid_o)); const int lane = tid_o & 63, wave = __builtin_amdgcn_readfirstlane(tid_o >> 6);
    LAS float* scr = (LAS float*)(lds + wave * 16384);
#pragma unroll 1
    for (int j = 0; j < 8; ++j) convert_item(c0 + 8 * wave + j, wsb, scr, lane);
}
#ifndef CV_UPFRONT
#define CV_UPFRONT 1
#endif
#if CV_UPFRONT
constexpr int CV_P0_END = CV_TOTAL, CV_A_END = CV_TOTAL, CV_B_END = CV_TOTAL, CV_M_END = CV_TOTAL, CV_MB = 0;
#else
constexpr int CV_P0_END = 2 * I_G;
constexpr int CV_A_END = 4 * I_G + I_D + I_IN + I_OUT + I_GLU - 2 * I_G + 2048;
constexpr int CV_B_END = CV_PER_LAYER;
constexpr int CV_M_END = CV_PER_LAYER + 2 * I_G + I_D + I_IN + I_OUT + I_GLU;
constexpr int CV_MB = (CV_M_END - CV_B_END) / 64;
#endif
static_assert((CV_M_END - CV_B_END) % 64 == 0, "mixer-phase conversion batches");
#ifndef PHASE_MASK
#define PHASE_MASK 0xFFFF
#endif
#define PH(k) if constexpr (((PHASE_MASK) >> (k)) & 1)
#ifndef MK_SYNC
#define MK_SYNC() do { XcdBarrier xb_; xb_.bar = (unsigned*)ws + 1024; xb_.x = xb_xcc_id(); xb_.st = (volatile LAS unsigned*)(lds + LDS_BYTES - 32); xcd_barrier(xb_); } while (0)
#endif
#ifndef CV_P0_LIM
#define CV_P0_LIM (2 * I_G)
#endif
#ifndef CV_LIM_GU1
#define CV_LIM_GU1 32000
#endif
#ifndef CV_LIM_WIN
#define CV_LIM_WIN 52000
#endif
#ifndef CV_LIM_MIX
#define CV_LIM_MIX 64000
#endif
__global__ void __launch_bounds__(NTHREADS, 2) fwd_megakernel(Args args) {
    extern __shared__ __attribute__((aligned(16))) unsigned char lds_raw[];
    cg::grid_group grid = cg::this_grid();
    LAS unsigned char* lds = (LAS unsigned char*)lds_raw;
    const int G = gridDim.x, bid = blockIdx.x, ngw = G * NWAVES;
    if (threadIdx.x < 2) ((volatile LAS unsigned*)(lds + LDS_BYTES - 32))[threadIdx.x] = 0u;
    __syncthreads();
    (void)xcd_barrier_post((unsigned*)(kargs_ptr()->ws) + 1024, (volatile LAS unsigned*)(lds + LDS_BYTES - 32));
#define LANE_SETUP() int tid_o = threadIdx.x; asm volatile("" : "+v"(tid_o)); const int lane = tid_o & 63, wave = __builtin_amdgcn_readfirstlane(tid_o >> 6), gw = bid * NWAVES + wave; (void)gw; (void)lane
#define ws (kargs_ptr()->ws)
#define XN ((bf16*)(ws + WS_XN))
#define BIG ((bf16*)(ws + WS_BIG))
#define Y ((bf16*)(ws + WS_Y))
#define MIX ((bf16*)(ws + WS_MIX))
#define YS ((float*)(ws + WS_YS))
#define YSB ((bf16*)(ws + WS_YSB))
#define H (kargs_ptr()->out)

    { convert_static(0, CV_P0_END, 0, G, ws, lds);
      PH(0) { LANE_SETUP();
        row_pass(nullptr, IN(0), nullptr, XN, nullptr, 0.f, IN(1), gw, ngw, lane); }
    }
    if (__builtin_expect(kargs_ptr()->out == nullptr, 0)) grid.sync();
    MK_SYNC();

#pragma unroll 1
    for (int l = 0; l < NLAYER; ++l) {
#define lw (ws + WS_W + (size_t)l * LW_SIZE)
#pragma unroll 1
        for (int f = 0; f < 2; ++f) {
            PH(1) { pg8::Gemm g{XN, (const bf16*)(lw + (f ? LW_GU2 : LW_GU1)), M, 2 * FF, DM}; pg8::StaticOrder S; S.init(M, 2 * FF, G, bid);
              pg8::EpiSwiGLU E{BIG, FF};
              pg8::gemm_phase<pg8::EpiSwiGLU, pg8::StaticOrder, true, true>(lds, g, S, E); }
            MK_SYNC();
            PH(2) { pg8::Gemm g{BIG, (const bf16*)(lw + (f ? LW_D2 : LW_D1)), M, DM, FF}; pg8::StaticOrder S; S.init(M, DM, G, bid);
              pg8::EpiBf16Plain E{Y, DM};
              pg8::gemm_phase<pg8::EpiBf16Plain, pg8::StaticOrder, true, true>(lds, g, S, E); }
            MK_SYNC();
            PH(3) { LANE_SETUP(); const float* gpost = (f ? IN(30) : IN(5)) + (size_t)l * DM;
              const float* gpre = f == 0 ? IN(6) + (size_t)l * DM : (l + 1 < NLAYER ? IN(1) + (size_t)(l + 1) * DM : nullptr);
              row_pass(Y, (l == 0 && f == 0) ? IN(0) : (const float*)H, H, XN, gpost, 0.5f, gpre, gw, ngw, lane); }
            if (f == 1) break;
            MK_SYNC();
            PH(4) { pg8::Gemm g{XN, (const bf16*)(lw + LW_IN), M, INC, DM}; pg8::StaticOrder S; S.init(M, INC, G, bid);
              pg8::EpiBf16Plain E{BIG, INC};
              pg8::gemm_phase<pg8::EpiBf16Plain, pg8::StaticOrder, true, true>(lds, g, S, E); }
            MK_SYNC();
#ifndef MIX_REPS
#define MIX_REPS 1
#endif
            {
                LANE_SETUP();
                const float lambda_init = 0.8f - 0.6f * expf(-0.3f * (float)l);
                const float d1 = wave_sum(IN(18)[l * 64 + lane] * IN(19)[l * 64 + lane]);
                const float d2 = wave_sum(IN(20)[l * 64 + lane] * IN(21)[l * 64 + lane]);
                const float lam = expf(d1) - expf(d2) + lambda_init;
                volatile LAS int* slot = (volatile LAS int*)(lds + LDS_BYTES - 64);
                volatile LAS int* peekv = (volatile LAS int*)(lds + LDS_BYTES - 128);
                const int myx = (int)(xb_xcc_id() & 7u);
#pragma unroll 1
                for (int stage = 0; stage < 3; ++stage) {
                    const int limit = stage == 0 ? 64 : (stage == 1 ? 24 : 64);
                    const int cbase = stage == 0 ? 64 * (l * 8) : (stage == 1 ? 4608 + 64 * (l * 8) : 5632 + 64 * l);
#pragma unroll 1
                    for (int pass = 0; ; ++pass) {
                        int x = 0;
                        if (stage == 2) { if (pass) break; }
                        else if (pass == 0) x = myx;
                        else {
                            if (tid_o < 8) peekv[tid_o] = (int)__hip_atomic_load((unsigned*)ws + cbase + 64 * tid_o, __ATOMIC_RELAXED, __HIP_MEMORY_SCOPE_AGENT);
                            __syncthreads();
                            x = -1;
#pragma unroll
                            for (int j = 7; j >= 0; --j) { const int xx = (myx + j) & 7; if (peekv[xx] < limit) x = xx; }
                            __syncthreads();
                            if (x < 0) break;
                        }
                        unsigned* ctr = (unsigned*)ws + cbase + 64 * x;
                        if (tid_o == 0) *slot = (int)atomicAdd(ctr, 1u);
                        __syncthreads();
                        int item = *slot;
                        __syncthreads();
                        while (item < limit) {
                            if (stage == 0) {
                                if (item < 24 || item >= 40) { PH(5) { const int di = item < 24 ? item : item - 16; const int qb = 15 - (di / 3), bh = 8 * (di % 3) + x;
                                    diff_unit((LAS char*)lds, BIG, MIX, IN(23), lam, 1.0f - lambda_init, IN(22) + (size_t)l * 128, bh / 6, bh % 6, qb); } }
                                else { PH(6) { const int u = 8 * (item - 24) + x; ssm_unit((LAS char*)lds, l, BIG, YSB, u / 32, u % 32, (unsigned*)ws + 6144 + 64 * (l * 4 + u / 32)); } }
                            } else if (stage == 1) { PH(7) { const int qb = 7 - (item / 3), bh = 8 * (item % 3) + x; sb_unit((LAS char*)lds, BIG, MIX, bh / 6, bh % 6, qb); } }
                            else { PH(8) {
                                pg8::Gemm g{YSB, (const bf16*)(lw + LW_GLU), M, 512, 512};
                                pg8::GatedUnit S1{pg8::Unit{item >> 1, item & 1}, (unsigned*)ws + 6144 + 64 * (l * 4 + (item >> 4)), 32u};
                                pg8::EpiGlu E{MIX + MIX_SSM, DM, YSB, 512, IN(17) + (size_t)l * 512};
                                pg8::gemm_phase<pg8::EpiGlu, pg8::GatedUnit, true, true>(lds, g, S1, E);
                                __syncthreads(); } }
                            if (tid_o == 0) *slot = (int)atomicAdd(ctr, 1u);
                            __syncthreads();
                            item = *slot;
                            __syncthreads();
                        }
                    }
                }
            }
            MK_SYNC();
            PH(9) { pg8::Gemm g{MIX, (const bf16*)(lw + LW_OUT), M, DM, DM}; pg8::StaticOrder S; S.init(M, DM, G, bid);
              pg8::EpiBf16Plain E{Y, DM};
              pg8::gemm_phase<pg8::EpiBf16Plain, pg8::StaticOrder, true, true>(lds, g, S, E); }
            MK_SYNC();
            PH(3) { LANE_SETUP(); row_pass(Y, H, H, XN, IN(25) + (size_t)l * DM, 1.0f, IN(26) + (size_t)l * DM, gw, ngw, lane); }
            MK_SYNC();
        }
        if (l + 1 < NLAYER) MK_SYNC();
    }
}

#undef ws
#undef XN
#undef BIG
#undef Y
#undef MIX
#undef YS
#undef YSB
#undef H
#undef lw
extern "C" void kernel_launch(void* const* d_in, const int* in_sizes, int n_in, void* d_out, int out_size, void* d_ws, size_t ws_size, hipStream_t stream) {
    static int grid = 0;
    if (grid == 0) {
        if (n_in != 31 || out_size != M * DM || ws_size < WS_END) { fprintf(stderr, "kernel_launch: unexpected shapes (n_in %d, out %d, ws %zu < %zu)\n", n_in, out_size, ws_size, (size_t)WS_END); grid = -1; return; }
        int dev = 0, cus = 0, per_cu = 0;
        hipGetDevice(&dev); hipDeviceGetAttribute(&cus, hipDeviceAttributeMultiprocessorCount, dev);
        if (hipFuncSetAttribute((const void*)fwd_megakernel, hipFuncAttributeMaxDynamicSharedMemorySize, LDS_BYTES) != hipSuccess) { fprintf(stderr, "kernel_launch: hipFuncSetAttribute failed\n"); grid = -1; return; }
        hipOccupancyMaxActiveBlocksPerMultiprocessor(&per_cu, (const void*)fwd_megakernel, NTHREADS, LDS_BYTES);
        if (per_cu < 1) { fprintf(stderr, "kernel_launch: occupancy query says %d blocks per CU\n", per_cu); per_cu = 1; }
        (void)hipGetLastError();
        grid = cus * 1;
    }
    if (grid < 0) return;
    if (hipMemsetAsync(d_ws, 0, 65536, stream) != hipSuccess) { fprintf(stderr, "kernel_launch: memset failed\n"); return; }
    Args a{};
    for (int i = 0; i < 31; ++i) a.in[i] = (const float*)d_in[i];
    a.out = (float*)d_out; a.ws = (unsigned char*)d_ws;
    void* kargs[] = {&a};
    hipError_t e = hipLaunchCooperativeKernel((const void*)fwd_megakernel, dim3(grid), dim3(NTHREADS), kargs, LDS_BYTES, stream);
    if (e != hipSuccess) fprintf(stderr, "kernel_launch: cooperative launch failed: %s (grid %d)\n", hipGetErrorString(e), grid);
}
```

```cpp
#include <hip/hip_runtime.h>
#include <cstdio>
#include <cstdint>
namespace pg8 {
#define PG8_LAS __attribute__((address_space(3)))
typedef unsigned short bf16_t;
typedef short bf16x8 __attribute__((ext_vector_type(8)));
typedef float f32x4 __attribute__((ext_vector_type(4)));
typedef unsigned u32x4 __attribute__((ext_vector_type(4)));
constexpr int BM = 256, BK = 64, HALF = 128, HTB = HALF * BK * 2  , STAGE_BYTES = 8 * HTB, NXCD = 8, WGM = 8;

__host__ __device__ __forceinline__ int lds_byte(int r, int c) { const int st = (r >> 4) * 2 + (c >> 5), rr = r & 15, cc = c & 31, ob = rr * 64 + cc * 2; return st * 1024 + (ob ^ (((ob >> 9) & 1) << 5)); }
__host__ __device__ __forceinline__ void stage_rc(int b, int& R, int& C) { const int st = b / 1024, sb = b % 1024, swz = sb ^ (((sb >> 9) & 1) << 5); R = (st >> 1) * 16 + swz / 64; C = (st & 1) * 32 + (swz % 64) / 2; }
__host__ __device__ __forceinline__ int perm32(int rho) { const int n = rho >> 4, i = rho & 15; return 8 * (i >> 2) + 4 * n + (i & 3); }

struct Unit { int pm, pn; };
struct Gemm { const bf16_t* A; const bf16_t* Bt; int M, N, K; };

struct StaticOrder {
    int nM, nN, nwg, G, c;
    __host__ __device__ void init(int M, int N, int G_, int c_) { nM = M / BM; nN = N / BM; nwg = nM * nN; G = G_; c = c_; }
    __host__ __device__ bool next(int i, Unit& u) const {
        const long L = (long)i * G + c; if (L >= nwg) return false;
        int wgid = (int)L; { const int q = nwg / NXCD, r = nwg % NXCD, xcd = wgid % NXCD, off = wgid / NXCD; wgid = (xcd < r ? xcd * (q + 1) : r * (q + 1) + (xcd - r) * q) + off; }
        const int nig = WGM * nN, gid = wgid / nig, fm = gid * WGM, gsz = (nM - fm) < WGM ? (nM - fm) : WGM;
        u.pm = fm + ((wgid % nig) % gsz); u.pn = (wgid % nig) / gsz; return true;
    }
    __device__ __forceinline__ void a_ready(const Unit&) const {}
    __device__ __forceinline__ void done(const Unit&) const {}
};

__device__ __forceinline__ unsigned cvt_pk_bf16(float lo, float hi) { unsigned r; asm volatile("v_cvt_pk_bf16_f32 %0, %1, %2" : "=v"(r) : "v"(lo), "v"(hi)); return r; }
typedef float f32x2 __attribute__((ext_vector_type(2)));
__device__ __forceinline__ f32x2 gelu_pk(f32x2 v) {
    const f32x2 av = __builtin_elementwise_abs(v), d = av * 0.2316418882f + 1.0f;
    f32x2 t; t.x = __builtin_amdgcn_rcpf(d.x); t.y = __builtin_amdgcn_rcpf(d.y);
    f32x2 q = t * 0.5307027145f + (-0.7265760135f); q = q * t + 0.7107068705f; q = q * t + (-0.142248368f); q = q * t + 0.127414796f; q = q * t;
    const f32x2 s = (v * v) * (-0.72134752044f);
    f32x2 e; e.x = __builtin_amdgcn_exp2f(s.x); e.y = __builtin_amdgcn_exp2f(s.y);
    const f32x2 m = v * (q * e), r = v - m;
    f32x2 o; o.x = v.x < 0.f ? m.x : r.x; o.y = v.y < 0.f ? m.y : r.y; return o;
}

template <int ACT  > struct EpiBf16 {
    static constexpr bool PERM = true, AFTER_DRAIN = false; static_assert(ACT == 0 || ACT == 1, "EpiBf16: ACT is 0 (none) or 1 (gelu_pk)");
    bf16_t* O; int ldc; const float* bias; int split_cols; size_t split_stride; float scale0;
    __device__ __forceinline__ void operator()(const f32x4 (&acc)[2][2][4][2], const Unit& u, int wr, int wc, int fr, int fq) const {
        const int row0 = u.pm * BM + wr * 64 + fr; int colt = u.pn * BM; bf16_t* base = O;
        float sc = 1.f; if (split_cols) { const int t = colt / split_cols; base += (size_t)t * split_stride; colt -= t * split_cols; if (t == 0) sc = scale0; }
        const int col0 = colt + wc * 32 + 8 * fq, bcol0 = u.pn * BM + wc * 32 + 8 * fq;
        f32x4 bv[2][2];
#pragma unroll
        for (int bj = 0; bj < 2; ++bj)
#pragma unroll
            for (int n = 0; n < 2; ++n) bv[bj][n] = bias ? *(const f32x4*)(bias + bcol0 + bj * HALF + 4 * n) : (f32x4){0.f, 0.f, 0.f, 0.f};
#pragma unroll
        for (int ai = 0; ai < 2; ++ai)
#pragma unroll
            for (int m = 0; m < 4; ++m) { bf16_t* rowp = base + (size_t)(row0 + ai * HALF + m * 16) * ldc + col0;
#pragma unroll
                for (int bj = 0; bj < 2; ++bj) { f32x4 v0 = acc[ai][bj][m][0] + bv[bj][0], v1 = acc[ai][bj][m][1] + bv[bj][1];
                    if (ACT == 1) { f32x2 a = gelu_pk((f32x2){v0[0], v0[1]}), b = gelu_pk((f32x2){v0[2], v0[3]}), c = gelu_pk((f32x2){v1[0], v1[1]}), d = gelu_pk((f32x2){v1[2], v1[3]});
                        v0 = (f32x4){a.x, a.y, b.x, b.y}; v1 = (f32x4){c.x, c.y, d.x, d.y}; }
                    v0 = v0 * sc; v1 = v1 * sc; u32x4 w; w.x = cvt_pk_bf16(v0[0], v0[1]); w.y = cvt_pk_bf16(v0[2], v0[3]); w.z = cvt_pk_bf16(v1[0], v1[1]); w.w = cvt_pk_bf16(v1[2], v1[3]);
                    *(u32x4*)(rowp + bj * HALF) = w; } }
    }
};

template <class Epi, class Sched, bool ALIGN_EPI = false, bool SP2 = false>
__device__ __forceinline__ void gemm_phase(PG8_LAS unsigned char* lds, const Gemm g, const Sched& S, const Epi& E) {
    int tid_o = threadIdx.x; asm volatile("" : "+v"(tid_o));
    const int tid = tid_o, wid = __builtin_amdgcn_readfirstlane(tid >> 6), lane = tid & 63, wr = wid >> 2, wc = wid & 3, fr = lane & 15, fq = lane >> 4;
    const int K = g.K, nt = K / BK;
    unsigned voffA[2], voffB[2];
#pragma unroll
    for (int i = 0; i < 2; ++i) { int R, C; stage_rc(tid * 16 + i * 8192, R, C); const int Rb = Epi::PERM ? ((R & ~31) + perm32(R & 31)) : R;
        voffA[i] = (unsigned)(R * K + C) * 2u; voffB[i] = (unsigned)(Rb * K + C) * 2u; }
    const size_t kstep = (size_t)(BK * 2);
    const size_t hstep = (size_t)HALF * K * 2;
    const size_t tstep = 2 * hstep;
    const unsigned ldsw = (unsigned)wid * 1024u;
    const int aoff = lds_byte(wr * 64 + fr, fq * 8), boff = lds_byte(wc * 32 + fr, fq * 8);
#define PG8_SA(b, h) (((b) * 2 + (h)) * HTB)
#define PG8_SB(b, h) ((4 + (b) * 2 + (h)) * HTB)
#define PG8_STAGE(bufoff, gbase, voff) do { _Pragma("unroll") for (int _i = 0; _i < 2; ++_i) \
        __builtin_amdgcn_global_load_lds((const unsigned*)((const char*)(gbase) + (voff)[_i]), (PG8_LAS unsigned*)(lds + (bufoff) + ldsw + _i * 8192), 16, 0, 0); } while (0)
#define PG8_LDA(dst, b, h) do { _Pragma("unroll") for (int m = 0; m < 4; ++m) _Pragma("unroll") for (int k = 0; k < 2; ++k) dst[m][k] = *(const PG8_LAS bf16x8*)(lds + PG8_SA(b, h) + aoff + m * 2048 + k * 1024); } while (0)
#define PG8_LDB(dst, b, h) do { _Pragma("unroll") for (int n = 0; n < 2; ++n) _Pragma("unroll") for (int k = 0; k < 2; ++k) dst[n][k] = *(const PG8_LAS bf16x8*)(lds + PG8_SB(b, h) + boff + n * 2048 + k * 1024); } while (0)
#define PG8_MMA(ai, bj, At, Bt) do { __builtin_amdgcn_s_setprio(1); _Pragma("unroll") for (int m = 0; m < 4; ++m) _Pragma("unroll") for (int n = 0; n < 2; ++n) _Pragma("unroll") for (int k = 0; k < 2; ++k) \
        acc[ai][bj][m][n] = __builtin_amdgcn_mfma_f32_16x16x32_bf16(Bt[n][k], At[m][k], acc[ai][bj][m][n], 0, 0, 0); __builtin_amdgcn_s_setprio(0); } while (0)
#define PG8_WAIT_V(n) asm volatile("s_waitcnt vmcnt(" #n ")" ::: "memory")
#define PG8_WAIT_L(n) asm volatile("s_waitcnt lgkmcnt(" #n ")" ::: "memory")
#define PG8_BAR __builtin_amdgcn_s_barrier()
#define PG8_SCHED __builtin_amdgcn_sched_barrier(0)
    Unit cur, nxt; int ui = 0;
    if (!S.next(0, cur)) return;
    f32x4 acc[2][2][4][2];
#pragma unroll
    for (int a = 0; a < 2; ++a)
#pragma unroll
        for (int b = 0; b < 2; ++b)
#pragma unroll
            for (int m = 0; m < 4; ++m)
#pragma unroll
                for (int n = 0; n < 2; ++n) acc[a][b][m][n] = (f32x4){0.f, 0.f, 0.f, 0.f};
    bf16x8 At[4][2], B0[2][2], B1[2][2];
    const char* cA = (const char*)g.A + (size_t)cur.pm * tstep; const char* cB = (const char*)g.Bt + (size_t)cur.pn * tstep;
    S.a_ready(cur);
    if constexpr (SP2) {
        PG8_STAGE(PG8_SB(0, 0), cB, voffB); PG8_STAGE(PG8_SB(0, 1), cB + hstep, voffB); PG8_STAGE(PG8_SA(0, 0), cA, voffA); PG8_STAGE(PG8_SA(0, 1), cA + hstep, voffA);
        if (wr == 1) PG8_BAR;
        PG8_WAIT_V(2); PG8_BAR;
        PG8_STAGE(PG8_SB(1, 0), cB + kstep, voffB); PG8_STAGE(PG8_SA(1, 0), cA + kstep, voffA); PG8_STAGE(PG8_SB(1, 1), cB + hstep + kstep, voffB);
        PG8_WAIT_V(6); PG8_BAR;
    } else {
        PG8_STAGE(PG8_SB(0, 0), cB, voffB); PG8_STAGE(PG8_SA(0, 0), cA, voffA); PG8_STAGE(PG8_SB(0, 1), cB + hstep, voffB); PG8_STAGE(PG8_SA(0, 1), cA + hstep, voffA);
        if (wr == 1) PG8_BAR;
        PG8_WAIT_V(4); PG8_BAR;
        PG8_STAGE(PG8_SB(1, 0), cB + kstep, voffB); PG8_STAGE(PG8_SA(1, 0), cA + kstep, voffA); PG8_STAGE(PG8_SB(1, 1), cB + hstep + kstep, voffB);
        PG8_WAIT_V(6); PG8_BAR;
    }
    for (;;) {
        const bool has_next = S.next(ui + 1, nxt);
        const char* nA = has_next ? (const char*)g.A + (size_t)nxt.pm * tstep : cA; const char* nB = has_next ? (const char*)g.Bt + (size_t)nxt.pn * tstep : cB;
        for (int t = 0; t < nt; t += 2) {
            const bool last = (t == nt - 2);
            const char* a1 = cA + (size_t)(t + 1) * kstep;
            const char* a2 = last ? nA : cA + (size_t)(t + 2) * kstep; const char* b2 = last ? nB : cB + (size_t)(t + 2) * kstep;
            const char* a3 = a2 + kstep; const char* b3 = b2 + kstep;
            if (last && has_next) S.a_ready(nxt);
            if constexpr (SP2) {
            PG8_LDB(B0, 0, 0); PG8_LDB(B1, 0, 1); PG8_SCHED; PG8_LDA(At, 0, 0); PG8_STAGE(PG8_SA(1, 1), a1 + hstep, voffA);
            PG8_WAIT_V(8); PG8_WAIT_L(0); PG8_BAR; PG8_MMA(0, 0, At, B0); PG8_MMA(0, 1, At, B1); PG8_BAR; PG8_SCHED;
            PG8_LDA(At, 0, 1); PG8_STAGE(PG8_SB(0, 0), b2, voffB); PG8_STAGE(PG8_SB(0, 1), b2 + hstep, voffB); PG8_STAGE(PG8_SA(0, 0), a2, voffA);
            PG8_WAIT_V(8); PG8_WAIT_L(0); PG8_BAR; PG8_MMA(1, 0, At, B0); PG8_MMA(1, 1, At, B1); PG8_BAR; PG8_SCHED;
            PG8_LDB(B0, 1, 0); PG8_LDB(B1, 1, 1); PG8_SCHED; PG8_LDA(At, 1, 0); PG8_STAGE(PG8_SA(0, 1), a2 + hstep, voffA);
            PG8_WAIT_V(8); PG8_WAIT_L(0); PG8_BAR; PG8_MMA(0, 0, At, B0); PG8_MMA(0, 1, At, B1); PG8_BAR; PG8_SCHED;
            PG8_LDA(At, 1, 1); PG8_STAGE(PG8_SB(1, 0), b3, voffB); PG8_STAGE(PG8_SB(1, 1), b3 + hstep, voffB); PG8_STAGE(PG8_SA(1, 0), a3, voffA);
            PG8_WAIT_V(8); PG8_WAIT_L(0); PG8_BAR; PG8_MMA(1, 0, At, B0); PG8_MMA(1, 1, At, B1); PG8_BAR; PG8_SCHED;
            } else {
            PG8_LDB(B0, 0, 0); PG8_SCHED; PG8_LDA(At, 0, 0); PG8_STAGE(PG8_SA(1, 1), a1 + hstep, voffA);
            PG8_WAIT_L(8); PG8_BAR; PG8_WAIT_L(0); PG8_MMA(0, 0, At, B0); PG8_BAR; PG8_SCHED;
            PG8_LDB(B1, 0, 1); PG8_STAGE(PG8_SB(0, 0), b2, voffB);
            PG8_BAR; PG8_WAIT_L(0); PG8_MMA(0, 1, At, B1); PG8_BAR;
            PG8_LDA(At, 0, 1); PG8_STAGE(PG8_SA(0, 0), a2, voffA);
            PG8_BAR; PG8_WAIT_L(0); PG8_MMA(1, 0, At, B0); PG8_BAR; PG8_SCHED;
            PG8_STAGE(PG8_SB(0, 1), b2 + hstep, voffB);
            PG8_WAIT_V(6); PG8_BAR; PG8_MMA(1, 1, At, B1); PG8_BAR;
            PG8_LDB(B0, 1, 0); PG8_SCHED; PG8_LDA(At, 1, 0); PG8_STAGE(PG8_SA(0, 1), a2 + hstep, voffA);
            PG8_WAIT_L(8); PG8_BAR; PG8_WAIT_L(0); PG8_MMA(0, 0, At, B0); PG8_BAR; PG8_SCHED;
            PG8_LDB(B1, 1, 1); PG8_STAGE(PG8_SB(1, 0), b3, voffB);
            PG8_BAR; PG8_WAIT_L(0); PG8_MMA(0, 1, At, B1); PG8_BAR;
            PG8_LDA(At, 1, 1); PG8_STAGE(PG8_SA(1, 0), a3, voffA);
            PG8_BAR; PG8_WAIT_L(0); PG8_MMA(1, 0, At, B0); PG8_BAR; PG8_SCHED;
            PG8_STAGE(PG8_SB(1, 1), b3 + hstep, voffB);
            PG8_WAIT_V(6); PG8_BAR; PG8_MMA(1, 1, At, B1); PG8_BAR;
            }
        }
        if constexpr (ALIGN_EPI) { if (wr == 0) PG8_BAR; }
        if constexpr (!Epi::AFTER_DRAIN) { E(acc, cur, wr, wc, fr, fq); S.done(cur); }
        if (!has_next) break;
#pragma unroll
        for (int a = 0; a < 2; ++a)
#pragma unroll
            for (int b = 0; b < 2; ++b)
#pragma unroll
                for (int m = 0; m < 4; ++m)
#pragma unroll
                    for (int n = 0; n < 2; ++n) acc[a][b][m][n] = (f32x4){0.f, 0.f, 0.f, 0.f};
        cur = nxt; cA = nA; cB = nB; ++ui;
        if constexpr (ALIGN_EPI) { if (wr == 1) PG8_BAR; }
    }
    PG8_WAIT_V(0);
    if constexpr (!ALIGN_EPI) { if (wr == 0) PG8_BAR; }
    PG8_BAR;
    if constexpr (Epi::AFTER_DRAIN) { E.fused(acc, cur, wr, wc, fr, fq, lds, wid, lane); S.done(cur); }
#undef PG8_SA
#undef PG8_SB
#undef PG8_STAGE
#undef PG8_LDA
#undef PG8_LDB
#undef PG8_MMA
#undef PG8_WAIT_V
#undef PG8_WAIT_L
#undef PG8_BAR
#undef PG8_SCHED
}
}
namespace pg8 {
struct EpiSwiGLU {
    static constexpr bool PERM = true, AFTER_DRAIN = false;
    bf16_t* O; int ldc;
    __device__ __forceinline__ void operator()(const f32x4 (&acc)[2][2][4][2], const Unit& u, int wr, int wc, int fr, int fq) const {
        const int row0 = u.pm * BM + wr * 64 + fr; const int col0 = u.pn * HALF + wc * 32 + 8 * fq;
#pragma unroll
        for (int ai = 0; ai < 2; ++ai)
#pragma unroll
            for (int m = 0; m < 4; ++m) { bf16_t* rowp = O + (size_t)(row0 + ai * HALF + m * 16) * ldc + col0;
                float v[8];
#pragma unroll
                for (int n = 0; n < 2; ++n)
#pragma unroll
                    for (int i = 0; i < 4; ++i) { const float g = acc[ai][0][m][n][i], up = acc[ai][1][m][n][i];
                        const float sg = g * __builtin_amdgcn_rcpf(1.0f + __builtin_amdgcn_exp2f(-1.4426950408889634f * g)); v[4 * n + i] = sg * up; }
                u32x4 w; w.x = cvt_pk_bf16(v[0], v[1]); w.y = cvt_pk_bf16(v[2], v[3]); w.z = cvt_pk_bf16(v[4], v[5]); w.w = cvt_pk_bf16(v[6], v[7]);
                *(u32x4*)rowp = w; }
    }
};
struct EpiF32 {
    static constexpr bool PERM = true, AFTER_DRAIN = false;
    float* O; int ldc;
    __device__ __forceinline__ void operator()(const f32x4 (&acc)[2][2][4][2], const Unit& u, int wr, int wc, int fr, int fq) const {
        const int row0 = u.pm * BM + wr * 64 + fr; const int col0 = u.pn * BM + wc * 32 + 8 * fq;
#pragma unroll
        for (int ai = 0; ai < 2; ++ai)
#pragma unroll
            for (int m = 0; m < 4; ++m) { float* rowp = O + (size_t)(row0 + ai * HALF + m * 16) * ldc + col0;
#pragma unroll
                for (int bj = 0; bj < 2; ++bj) { *(f32x4*)(rowp + bj * HALF) = acc[ai][bj][m][0]; *(f32x4*)(rowp + bj * HALF + 4) = acc[ai][bj][m][1]; } }
    }
};
struct EpiGlu {
    static constexpr bool PERM = true, AFTER_DRAIN = false;
    bf16_t* O; int ldc; const bf16_t* ys; int ldy; const float* bias;
    __device__ __forceinline__ void operator()(const f32x4 (&acc)[2][2][4][2], const Unit& u, int wr, int wc, int fr, int fq) const {
        const int row0 = u.pm * BM + wr * 64 + fr; const int col0 = u.pn * BM + wc * 32 + 8 * fq;
#pragma unroll
        for (int ai = 0; ai < 2; ++ai)
#pragma unroll
            for (int m = 0; m < 4; ++m) { const int row = row0 + ai * HALF + m * 16;
#pragma unroll
                for (int bj = 0; bj < 2; ++bj) { const int col = col0 + bj * HALF;
                    const u32x4 yp = *(const u32x4*)(ys + (size_t)row * ldy + col);
                    const f32x4 b0 = *(const f32x4*)(bias + col), b1 = *(const f32x4*)(bias + col + 4);
                    const float yv[8] = {__uint_as_float(yp.x << 16), __uint_as_float(yp.x & 0xffff0000u), __uint_as_float(yp.y << 16), __uint_as_float(yp.y & 0xffff0000u),
                                         __uint_as_float(yp.z << 16), __uint_as_float(yp.z & 0xffff0000u), __uint_as_float(yp.w << 16), __uint_as_float(yp.w & 0xffff0000u)};
                    float v[8];
#pragma unroll
                    for (int i = 0; i < 4; ++i) { const float z0 = acc[ai][bj][m][0][i] + b0[i], z1 = acc[ai][bj][m][1][i] + b1[i];
                        v[i] = yv[i] * __builtin_amdgcn_rcpf(1.0f + __builtin_amdgcn_exp2f(-1.4426950408889634f * z0));
                        v[4 + i] = yv[4 + i] * __builtin_amdgcn_rcpf(1.0f + __builtin_amdgcn_exp2f(-1.4426950408889634f * z1)); }
                    u32x4 w; w.x = cvt_pk_bf16(v[0], v[1]); w.y = cvt_pk_bf16(v[2], v[3]); w.z = cvt_pk_bf16(v[4], v[5]); w.w = cvt_pk_bf16(v[6], v[7]);
                    *(u32x4*)(O + (size_t)row * ldc + col) = w; } }
    }
};
struct EpiBf16Plain {
    static constexpr bool PERM = true, AFTER_DRAIN = false;
    bf16_t* O; int ldc;
    __device__ __forceinline__ void operator()(const f32x4 (&acc)[2][2][4][2], const Unit& u, int wr, int wc, int fr, int fq) const {
        const int row0 = u.pm * BM + wr * 64 + fr; const int col0 = u.pn * BM + wc * 32 + 8 * fq;
#pragma unroll
        for (int ai = 0; ai < 2; ++ai)
#pragma unroll
            for (int m = 0; m < 4; ++m) { bf16_t* rowp = O + (size_t)(row0 + ai * HALF + m * 16) * ldc + col0;
#pragma unroll
                for (int bj = 0; bj < 2; ++bj) { const f32x4 v0 = acc[ai][bj][m][0], v1 = acc[ai][bj][m][1];
                    u32x4 w; w.x = cvt_pk_bf16(v0[0], v0[1]); w.y = cvt_pk_bf16(v0[2], v0[3]); w.z = cvt_pk_bf16(v1[0], v1[1]); w.w = cvt_pk_bf16(v1[2], v1[3]);
                    *(u32x4*)(rowp + bj * HALF) = w; } }
    }
};
struct GatedUnit {
    Unit un; unsigned* cnt; unsigned want;
    __device__ __forceinline__ bool next(int i, Unit& u) const { u = un; return i == 0; }
    __device__ __forceinline__ void a_ready(const Unit&) const {
        if (threadIdx.x == 0) { unsigned sp = 0;
            while (__hip_atomic_load(cnt, __ATOMIC_RELAXED, __HIP_MEMORY_SCOPE_AGENT) < want) { __builtin_amdgcn_s_sleep(2); if (++sp > (1u << 22)) break; }
            __builtin_amdgcn_fence(__ATOMIC_ACQUIRE, "agent"); asm volatile("s_waitcnt vmcnt(0)" ::: "memory"); }
        __syncthreads();
    }
    __device__ __forceinline__ void done(const Unit&) const {}
};
}
#include <hip/hip_cooperative_groups.h>
namespace cg = cooperative_groups;
#define LAS __attribute__((address_space(3)))
typedef unsigned short bf16;
typedef float f32x4 __attribute__((ext_vector_type(4)));
typedef float f32x16 __attribute__((ext_vector_type(16)));
typedef short bf16x8 __attribute__((ext_vector_type(8)));
typedef short s16x4 __attribute__((ext_vector_type(4)));
typedef unsigned u32x4 __attribute__((ext_vector_type(4)));
typedef unsigned u32x2 __attribute__((ext_vector_type(2)));
typedef float f32x2_t __attribute__((ext_vector_type(2)));
typedef __bf16 bf16x2_t __attribute__((ext_vector_type(2)));

constexpr int NB = 4, SEQ = 2048, DM = 2048, M = NB * SEQ, FF = 5632, INC = 5120, NLAYER = 2;
constexpr int C_SBQ = 0, C_SBK = 768, C_SBV = 1536, C_U = 2304, C_DQ = 2816, C_DK = 3584, C_DV = 4352;
constexpr int MIX_SB = 0, MIX_SSM = 768, MIX_DIFF = 1280;
constexpr float EPS = 1e-6f;
constexpr float LOG2E = 1.4426950408889634f;
constexpr int NTHREADS = 512, NWAVES = 8;
constexpr int LDS_BYTES = 148480;

constexpr size_t SZ_WGU = (size_t)2 * FF * DM * 2, SZ_WD = (size_t)DM * FF * 2, SZ_WIN = (size_t)INC * DM * 2, SZ_WOUT = (size_t)DM * DM * 2, SZ_WGLU = (size_t)512 * 512 * 2;
constexpr size_t LW_GU1 = 0, LW_D1 = LW_GU1 + SZ_WGU, LW_IN = LW_D1 + SZ_WD, LW_OUT = LW_IN + SZ_WIN, LW_GLU = LW_OUT + SZ_WOUT, LW_GU2 = LW_GLU + SZ_WGLU, LW_D2 = LW_GU2 + SZ_WGU, LW_SIZE = LW_D2 + SZ_WD;
constexpr size_t WS_W = 1u << 20;
constexpr size_t WS_XN = WS_W + NLAYER * LW_SIZE;
constexpr size_t WS_BIG = WS_XN + (size_t)M * DM * 2;
constexpr size_t WS_Y = WS_BIG + (size_t)M * FF * 2;
constexpr size_t WS_MIX = WS_Y + (size_t)M * DM * 4;
constexpr size_t WS_YS = WS_MIX + (size_t)M * DM * 2;
constexpr size_t WS_YSB = WS_YS + (size_t)M * 512 * 4;
constexpr size_t WS_END = WS_YSB + (size_t)M * 512 * 2;

struct Args { const float* in[31]; float* out; unsigned char* ws; };
typedef __attribute__((address_space(4))) const Args* KArgs;
__device__ __forceinline__ KArgs kargs_ptr() { KArgs ap = (KArgs)__builtin_amdgcn_kernarg_segment_ptr(); asm volatile("" : "+s"(ap)); return ap; }
#define IN(k) (kargs_ptr()->in[(k)])

__device__ const unsigned char T5B[128] = {0, 1, 2, 3, 4, 5, 6, 7, 8, 9, 10, 11, 12, 13, 14, 15, 16, 16, 16, 17, 17, 18, 18, 18, 19, 19, 19, 20, 20, 20, 20, 21, 21, 21, 21, 22, 22, 22, 22, 22, 23, 23, 23, 23, 23, 23, 24, 24, 24, 24, 24, 24, 25, 25, 25, 25, 25, 25, 25, 26, 26, 26, 26, 26, 26, 26, 26, 27, 27, 27, 27, 27, 27, 27, 27, 27, 27, 28, 28, 28, 28, 28, 28, 28, 28, 28, 28, 29, 29, 29, 29, 29, 29, 29, 29, 29, 29, 29, 29, 30, 30, 30, 30, 30, 30, 30, 30, 30, 30, 30, 30, 30, 30, 31, 31, 31, 31, 31, 31, 31, 31, 31, 31, 31, 31, 31, 31, 31};

#define LDS_WAIT() asm volatile("s_waitcnt lgkmcnt(0)" ::: "memory")
#define WAVE_SYNC() do { asm volatile("s_waitcnt lgkmcnt(0)" ::: "memory"); __builtin_amdgcn_wave_barrier(); } while (0)
#define MFMA32(a, b, c) __builtin_amdgcn_mfma_f32_32x32x16_bf16((a), (b), (c), 0, 0, 0)
__device__ __forceinline__ unsigned f2bf(float f) { unsigned u = __float_as_uint(f); return (u + 0x7fffu + ((u >> 16) & 1u)) >> 16; }
__device__ __forceinline__ unsigned pk2(float lo, float hi) { return f2bf(lo) | (f2bf(hi) << 16); }
__device__ __forceinline__ unsigned cvtpk(float lo, float hi) { f32x2_t v = {lo, hi}; bf16x2_t b = __builtin_convertvector(v, bf16x2_t); return __builtin_bit_cast(unsigned, b); }
__device__ __forceinline__ float bf2f(unsigned short b) { return __uint_as_float(((unsigned)b) << 16); }
__device__ __forceinline__ float wave_sum(float v) {
#pragma unroll
    for (int o = 1; o < 64; o <<= 1) v += __shfl_xor(v, o);
    return v;
}
__device__ __forceinline__ int crow(int i, int h) { return (i & 3) + 8 * (i >> 2) + 4 * h; }

#define XB_TMO      128
#define XB_XCNT(j)  (256  + 64 * (j))
#define XB_XSUB(j)  (1280 + 64 * (j))
#define XB_XGEN(j)  (2304 + 64 * (j))
#define XB_TOP      3328
#define XB_TOPGEN   3392
#define XCD_BAR_WORDS 3456
#define XB_SPIN_CAP (1u << 18)

__device__ __forceinline__ unsigned xb_ld(unsigned* p)              { return __hip_atomic_load(p, __ATOMIC_RELAXED, __HIP_MEMORY_SCOPE_AGENT); }
__device__ __forceinline__ unsigned xb_add(unsigned* p, unsigned v) { return __hip_atomic_fetch_add(p, v, __ATOMIC_RELAXED, __HIP_MEMORY_SCOPE_AGENT); }
__device__ __forceinline__ unsigned xb_xcc_id() { return (unsigned)__builtin_amdgcn_s_getreg((3 << 11) | 20) & 0xFu; }
#define XB_SPIN(cond, bar) do { unsigned _sp = 0; while (cond) { __builtin_amdgcn_s_sleep(1); \
    if ((++_sp & 255u) == 0u) { if (xb_ld(&(bar)[XB_TMO])) break; if (_sp > XB_SPIN_CAP) { atomicAdd(&(bar)[XB_TMO], 1u); break; } } } } while (0)

struct XcdBarrier {
    unsigned* bar; unsigned x;
    volatile LAS unsigned* st;
};

__device__ __forceinline__ XcdBarrier xcd_barrier_post(unsigned* bar, volatile LAS unsigned* st) {
    XcdBarrier b; b.bar = bar; b.x = xb_xcc_id(); b.st = st;
    if (threadIdx.x == 0) (void)xb_add(&bar[XB_XCNT(b.x)], 1u);
    return b;
}
__device__ __forceinline__ void xcd_barrier_complete(unsigned* bar, unsigned x, unsigned& nloc, unsigned& nx) {
    const unsigned G = gridDim.x * gridDim.y * gridDim.z;
    unsigned sum, cnt, mine, sp = 0u;
    for (;;) {
        sum = 0u; cnt = 0u; mine = 0u;
#pragma unroll
        for (unsigned j = 0; j < 16; ++j) { const unsigned c = xb_ld(&bar[XB_XCNT(j)]); sum += c; cnt += (c > 0u) ? 1u : 0u; mine = (j == x) ? c : mine; }
        if (sum == G) break;
        __builtin_amdgcn_s_sleep(1);
        if ((++sp & 255u) == 0u) { if (xb_ld(&bar[XB_TMO])) break; if (sp > XB_SPIN_CAP) { atomicAdd(&bar[XB_TMO], 1u); break; } }
    }
    nloc = mine > 0u ? mine : 1u; nx = cnt > 0u ? cnt : 1u;
}

__device__ __forceinline__ void xcd_barrier(const XcdBarrier& b) {
    asm volatile("s_waitcnt vmcnt(0)" ::: "memory");
    __syncthreads();
    if (threadIdx.x == 0) {
        unsigned* bar = b.bar;
        __builtin_amdgcn_s_waitcnt(0);
        unsigned nloc = b.st[0], nx = b.st[1];
        if (nloc == 0u) { xcd_barrier_complete(bar, b.x, nloc, nx); b.st[0] = nloc; b.st[1] = nx; }
        const unsigned old = xb_add(&bar[XB_XSUB(b.x)], 1u);
        const unsigned gen = old / nloc;
        if (old + 1u == (gen + 1u) * nloc) {
            __builtin_amdgcn_fence(__ATOMIC_RELEASE, "agent");
            asm volatile("s_waitcnt vmcnt(0)" ::: "memory");
            const unsigned og = xb_add(&bar[XB_TOP], 1u);
            const unsigned tg = og / nx;
            if (og + 1u == (tg + 1u) * nx) xb_add(&bar[XB_TOPGEN], 1u);
            else XB_SPIN(xb_ld(&bar[XB_TOPGEN]) == tg, bar);
            __builtin_amdgcn_fence(__ATOMIC_ACQUIRE, "agent");
            xb_add(&bar[XB_XGEN(b.x)], 1u);
            asm volatile("s_waitcnt vmcnt(0)" ::: "memory");
        } else {
            XB_SPIN(xb_ld(&bar[XB_XGEN(b.x)]) == gen, bar);
            __builtin_amdgcn_fence(__ATOMIC_ACQUIRE, "agent");
            asm volatile("s_waitcnt vmcnt(0)" ::: "memory");
        }
    }
    __syncthreads();
}

__device__ __forceinline__ void transpose_item(const float* __restrict__ W, int K, int N, bf16* WT, int mode, LAS float* scr, int item, int lane) {
    const int nblk = N / 32, kb = item / nblk, nb = item % nblk, k0 = 64 * kb, n0 = 32 * nb;
#pragma unroll 8
    for (int i = 0; i < 32; ++i) { const int kk = 2 * i + (lane >> 5); scr[kk * 33 + (lane & 31)] = __builtin_nontemporal_load(&W[(size_t)(k0 + kk) * N + n0 + (lane & 31)]); }
    LDS_WAIT();
    const int rb = mode == 0 ? n0 : ((n0 >> 7) * 256 + (n0 & 127) + (mode == 2 ? 128 : 0));
    const int c = lane & 7;
#pragma unroll
    for (int j = 0; j < 4; ++j) { const int n = (lane >> 3) + 8 * j; const LAS float* s = scr + (8 * c) * 33 + n;
        u32x4 o; o.x = pk2(s[0 * 33], s[1 * 33]); o.y = pk2(s[2 * 33], s[3 * 33]); o.z = pk2(s[4 * 33], s[5 * 33]); o.w = pk2(s[6 * 33], s[7 * 33]);
        *(u32x4*)(WT + (size_t)(rb + n) * K + k0 + 8 * c) = o; }
    LDS_WAIT();
}

__device__ __forceinline__ void row_pass(const bf16* Y, const float* Hin, float* Hout, bf16* XN, const float* gpost, float wres, const float* gpre, int gw, int ngw, int lane) {
    for (int m = gw; m < M; m += ngw) {
        f32x4 hv[8];
        const f32x4* hr = (const f32x4*)(Hin + (size_t)m * DM) + 2 * lane;
#pragma unroll
        for (int j = 0; j < 4; ++j) { hv[2 * j] = hr[128 * j]; hv[2 * j + 1] = hr[128 * j + 1]; }
        if (Y) {
            f32x4 yv[8]; const u32x4* yr = (const u32x4*)(Y + (size_t)m * DM) + lane; float ss = 0.f;
#pragma unroll
            for (int j = 0; j < 4; ++j) { const u32x4 p = yr[64 * j];
                yv[2 * j] = (f32x4){__uint_as_float(p.x << 16), __uint_as_float(p.x & 0xffff0000u), __uint_as_float(p.y << 16), __uint_as_float(p.y & 0xffff0000u)};
                yv[2 * j + 1] = (f32x4){__uint_as_float(p.z << 16), __uint_as_float(p.z & 0xffff0000u), __uint_as_float(p.w << 16), __uint_as_float(p.w & 0xffff0000u)}; }
#pragma unroll
            for (int j = 0; j < 8; ++j) ss += (yv[j].x * yv[j].x + yv[j].y * yv[j].y) + (yv[j].z * yv[j].z + yv[j].w * yv[j].w);
            ss = wave_sum(ss);
            const float rstd = wres / sqrtf(ss * (1.0f / DM) + EPS);
#pragma unroll
            for (int j = 0; j < 4; ++j) { const f32x4 g0 = ((const f32x4*)gpost)[2 * lane + 128 * j], g1 = ((const f32x4*)gpost)[2 * lane + 128 * j + 1];
                hv[2 * j] = hv[2 * j] + yv[2 * j] * g0 * rstd; hv[2 * j + 1] = hv[2 * j + 1] + yv[2 * j + 1] * g1 * rstd; }
        }
        if (Hout) { f32x4* ho = (f32x4*)(Hout + (size_t)m * DM) + 2 * lane;
#pragma unroll
            for (int j = 0; j < 4; ++j) { ho[128 * j] = hv[2 * j]; ho[128 * j + 1] = hv[2 * j + 1]; } }
        if (gpre) {
            float s2 = 0.f;
#pragma unroll
            for (int j = 0; j < 8; ++j) s2 += (hv[j].x * hv[j].x + hv[j].y * hv[j].y) + (hv[j].z * hv[j].z + hv[j].w * hv[j].w);
            s2 = wave_sum(s2);
            const float r2 = 1.0f / sqrtf(s2 * (1.0f / DM) + EPS);
            u32x4* xo = (u32x4*)(XN + (size_t)m * DM) + lane;
#pragma unroll
            for (int j = 0; j < 4; ++j) { const f32x4 g0 = ((const f32x4*)gpre)[2 * lane + 128 * j], g1 = ((const f32x4*)gpre)[2 * lane + 128 * j + 1];
                const f32x4 v0 = hv[2 * j] * g0 * r2, v1 = hv[2 * j + 1] * g1 * r2; u32x4 o; o.x = pk2(v0.x, v0.y); o.y = pk2(v0.z, v0.w); o.z = pk2(v1.x, v1.y); o.w = pk2(v1.z, v1.w); xo[64 * j] = o; }
        }
    }
}

constexpr int KP = 272, VP = 320;
constexpr int KBYTES = 64 * KP, VBYTES = 64 * VP;
constexpr int A_K = 0, A_V = 2 * KBYTES, A_BIAS = A_V + 2 * VBYTES, A_FLAG = A_BIAS + 1024, A_Q = A_FLAG + 1024, A_END = A_Q + 8 * 32 * KP;

__device__ __forceinline__ void tile_prefetch(u32x4 (&rg)[2], const bf16* g, int tid) {
#pragma unroll
    for (int i = 0; i < 2; ++i) { const int chunk = tid + 512 * i, row = chunk >> 4, ch = chunk & 15; rg[i] = *(const u32x4*)(g + (size_t)row * INC + ch * 8); }
}
__device__ __forceinline__ void tile_store(LAS char* dst, int pitch, const u32x4 (&rg)[2], int tid) {
#pragma unroll
    for (int i = 0; i < 2; ++i) { const int chunk = tid + 512 * i, row = chunk >> 4, ch = chunk & 15; *(LAS u32x4*)(dst + row * pitch + ch * 16) = rg[i]; }
}
__device__ __forceinline__ void pv_half(f32x16 (&o)[4], const LAS char* Vb, int kh, bf16x8 P0, bf16x8 P1, int lane) {
    const int h = lane >> 5, i16 = lane & 15, qq = i16 >> 2, p = i16 & 3, blk = (lane >> 4) & 1;
    const LAS char* vb = Vb + (32 * kh + 4 * h + qq) * VP + (16 * blk + 4 * p) * 2;
#pragma unroll
    for (int s2 = 0; s2 < 2; ++s2)
#pragma unroll
        for (int db = 0; db < 4; ++db) {
            const s16x4 lo = __builtin_bit_cast(s16x4, __builtin_amdgcn_ds_read_tr16_b64_v4i16((LAS s16x4*)(vb + (16 * s2) * VP + db * 64)));
            const s16x4 hi = __builtin_bit_cast(s16x4, __builtin_amdgcn_ds_read_tr16_b64_v4i16((LAS s16x4*)(vb + (16 * s2 + 8) * VP + db * 64)));
            const bf16x8 vf = __builtin_shufflevector(lo, hi, 0, 1, 2, 3, 4, 5, 6, 7);
            o[db] = MFMA32(vf, s2 == 0 ? P0 : P1, o[db]);
        }
}

#ifndef SB_DONE
#define SB_DONE (-50.0f)
#endif
__device__ __forceinline__ void sb_unit(LAS char* lds, const bf16* PROJ, bf16* MIX, int b, int hd, int qb) {
    int tid_o = threadIdx.x; asm volatile("" : "+v"(tid_o)); const int tid = tid_o, lane = tid & 63, r = lane & 31, h = lane >> 5, w = __builtin_amdgcn_readfirstlane(tid >> 6);
    const int q0 = qb * 256, qw = q0 + 32 * w, q = qw + r;
    const size_t rowb = (size_t)b * SEQ;
    const float SCALE = 0.08838834764831845f;
    bf16x8 qf[8];
    { const bf16* Qg = PROJ + (rowb + q) * INC + C_SBQ + hd * 128 + 8 * h;
#pragma unroll
      for (int s = 0; s < 8; ++s) qf[s] = *(const bf16x8*)(Qg + 16 * s); }
    const bf16* Kg = PROJ + rowb * INC + C_SBK + hd * 128; const bf16* Vg = PROJ + rowb * INC + C_SBV + hd * 128;
    f32x16 o[4];
#pragma unroll
    for (int d = 0; d < 4; ++d)
#pragma unroll
        for (int i = 0; i < 16; ++i) o[d][i] = 0.f;
    float R = 0.f; bool wdone = false;
    const int kt_hi = (q0 + 255) >> 6;
    volatile LAS int* flags = (volatile LAS int*)(lds + A_FLAG);
    u32x4 kr[2], vr[2];
    tile_prefetch(kr, Kg + (size_t)(kt_hi * 64) * INC, tid); tile_prefetch(vr, Vg + (size_t)(kt_hi * 64) * INC, tid);
    int it = 0;
    for (int kt = kt_hi; kt >= 0; --kt, ++it) {
        const int buf = it & 1;
        LAS char* Kb = lds + A_K + buf * KBYTES; LAS char* Vb = lds + A_V + buf * VBYTES;
        tile_store(Kb, KP, kr, tid); tile_store(Vb, VP, vr, tid);
        __syncthreads();
        if (it > 0) { int alld = 1;
#pragma unroll
            for (int ww = 0; ww < 8; ++ww) alld &= flags[((it - 1) & 1) * 8 + ww];
            if (alld) break; }
        if (kt > 0) { tile_prefetch(kr, Kg + (size_t)((kt - 1) * 64) * INC, tid); tile_prefetch(vr, Vg + (size_t)((kt - 1) * 64) * INC, tid); }
        const int k0 = kt * 64;
        if (k0 < qw + 31 && !wdone) {
#pragma unroll
            for (int kh = 1; kh >= 0; --kh) {
                f32x16 c;
#pragma unroll
                for (int i = 0; i < 16; ++i) c[i] = 0.f;
                const LAS char* kp = Kb + (32 * kh + r) * KP + 16 * h;
#pragma unroll
                for (int s = 0; s < 8; ++s) { const bf16x8 kf = *(const LAS bf16x8*)(kp + 32 * s); c = MFMA32(kf, qf[s], c); }
                const int keyb = k0 + 32 * kh + 4 * h;
                float lk[16], lb[16], gs[4], og[4];
#pragma unroll
                for (int i = 0; i < 16; ++i) { const int key = keyb + (i & 3) + 8 * (i >> 2); const float z = c[i] * SCALE;
                    const float e = __expf(-fabsf(z)); const float ls = fminf(z, 0.f) - __logf(1.0f + e);
                    lb[i] = ls; lk[i] = (key < q) ? (ls - z) : 0.f; }
#pragma unroll
                for (int g = 0; g < 4; ++g) { gs[g] = (lk[4 * g] + lk[4 * g + 1]) + (lk[4 * g + 2] + lk[4 * g + 3]); og[g] = __shfl_xor(gs[g], 32); }
                const float sg = (gs[0] + gs[1]) + (gs[2] + gs[3]), so = (og[0] + og[1]) + (og[2] + og[3]);
                float after[4];
                after[3] = (h ? 0.f : og[3]);
                after[2] = gs[3] + og[3] + (h ? 0.f : og[2]);
                after[1] = gs[3] + gs[2] + og[3] + og[2] + (h ? 0.f : og[1]);
                after[0] = gs[3] + gs[2] + gs[1] + og[3] + og[2] + og[1] + (h ? 0.f : og[0]);
                float wv[16];
#pragma unroll
                for (int g = 0; g < 4; ++g) { const float base = R + after[g];
                    const float s3 = 0.f, s2 = lk[4 * g + 3], s1 = s2 + lk[4 * g + 2], s0 = s1 + lk[4 * g + 1];
                    const float bt[4] = {s0, s1, s2, s3};
#pragma unroll
                    for (int j = 0; j < 4; ++j) { const int i = 4 * g + j; const int key = keyb + j + 8 * g;
                        wv[i] = (key < q) ? __expf(lb[i] + base + bt[j]) : 0.f; } }
                R += sg + so;
                u32x4 p0, p1;
                p0.x = cvtpk(wv[0], wv[1]); p0.y = cvtpk(wv[2], wv[3]); p0.z = cvtpk(wv[4], wv[5]); p0.w = cvtpk(wv[6], wv[7]);
                p1.x = cvtpk(wv[8], wv[9]); p1.y = cvtpk(wv[10], wv[11]); p1.z = cvtpk(wv[12], wv[13]); p1.w = cvtpk(wv[14], wv[15]);
                pv_half(o, Vb, kh, __builtin_bit_cast(bf16x8, p0), __builtin_bit_cast(bf16x8, p1), lane);
            }
            wdone = __all(R < SB_DONE);
        }
        if (lane == 0) flags[(it & 1) * 8 + w] = wdone ? 1 : 0;
    }
    bf16* Og = MIX + (rowb + q) * DM + MIX_SB + hd * 128 + 4 * h;
#pragma unroll
    for (int db = 0; db < 4; ++db)
#pragma unroll
        for (int g = 0; g < 4; ++g) { u32x2 ov; ov.x = cvtpk(o[db][4 * g], o[db][4 * g + 1]); ov.y = cvtpk(o[db][4 * g + 2], o[db][4 * g + 3]); *(u32x2*)(Og + 32 * db + 8 * g) = ov; }
    __syncthreads();
}

__device__ __forceinline__ f32x16 diff_qk(const LAS char* kp, const LAS char* qp) {
    f32x16 c;
#pragma unroll
    for (int i = 0; i < 16; ++i) c[i] = 0.f;
#pragma unroll
    for (int s = 0; s < 4; ++s) { const bf16x8 kf = *(const LAS bf16x8*)(kp + 32 * s); const bf16x8 qf = *(const LAS bf16x8*)(qp + 32 * s); c = MFMA32(kf, qf, c); }
    return c;
}
__device__ __forceinline__ void diff_sm(f32x16& c, bool far, float bfar, const LAS float* bt, int q, int keyb, float& m, float& l, f32x16 (&o)[4], bf16x8& P0, bf16x8& P1) {
    const float SC2 = 0.125f * LOG2E;
    if (far) {
#pragma unroll
        for (int i = 0; i < 16; ++i) c[i] = c[i] * SC2 + bfar;
    } else {
#pragma unroll
        for (int i = 0; i < 16; ++i) { const int key = keyb + (i & 3) + 8 * (i >> 2); const int n = q - key; const int ni = n < 0 ? 0 : (n > 128 ? 128 : n);
            c[i] = (n < 0) ? -INFINITY : (c[i] * SC2 + bt[ni]); }
    }
    float mx = fmaxf(fmaxf(c[0], c[1]), fmaxf(c[2], c[3]));
#pragma unroll
    for (int i = 4; i < 16; i += 4) mx = fmaxf(mx, fmaxf(fmaxf(c[i], c[i + 1]), fmaxf(c[i + 2], c[i + 3])));
    mx = fmaxf(mx, __shfl_xor(mx, 32));
    const float mnew = fmaxf(m, mx);
    if (__any(mx > m + 8.0f)) {
        const float sc = __builtin_amdgcn_exp2f(m - mnew); l *= sc;
#pragma unroll
        for (int d = 0; d < 4; ++d)
#pragma unroll
            for (int i = 0; i < 16; ++i) o[d][i] *= sc;
        m = mnew;
    }
    float a = 0.f;
#pragma unroll
    for (int i = 0; i < 16; ++i) { c[i] = __builtin_amdgcn_exp2f(c[i] - m); a += c[i]; }
    l += a;
    u32x4 p0, p1;
    p0.x = cvtpk(c[0], c[1]); p0.y = cvtpk(c[2], c[3]); p0.z = cvtpk(c[4], c[5]); p0.w = cvtpk(c[6], c[7]);
    p1.x = cvtpk(c[8], c[9]); p1.y = cvtpk(c[10], c[11]); p1.z = cvtpk(c[12], c[13]); p1.w = cvtpk(c[14], c[15]);
    P0 = __builtin_bit_cast(bf16x8, p0); P1 = __builtin_bit_cast(bf16x8, p1);
}
__device__ __forceinline__ void diff_unit(LAS char* lds, const bf16* PROJ, bf16* MIX, const float* relb, float lam, float outscale, const float* subg, int b, int hd, int qb) {
    int tid_o = threadIdx.x; asm volatile("" : "+v"(tid_o)); const int tid = tid_o, lane = tid & 63, r = lane & 31, h = lane >> 5, w = __builtin_amdgcn_readfirstlane(tid >> 6);
    const int rg = w & 3, kh = w >> 2;
    const int q0 = qb * 128, qw = q0 + 32 * rg, q = qw + r;
    const size_t rowb = (size_t)b * SEQ;
    LAS float* bt = (LAS float*)(lds + A_BIAS);
    if (tid < 129) { const int bucket = tid < 128 ? (int)T5B[tid] : 31; bt[tid] = relb[bucket * 6 + hd] * LOG2E; }
    LAS char* qp = lds + A_Q + w * (32 * KP) + r * KP + 16 * h;
    { const bf16* Qg = PROJ + (rowb + q) * INC + C_DQ + hd * 128 + 8 * h;
#pragma unroll
      for (int s = 0; s < 8; ++s) *(LAS u32x4*)(qp + 32 * s) = *(const u32x4*)(Qg + 16 * s); }
    const bf16* Kg = PROJ + rowb * INC + C_DK + hd * 128; const bf16* Vg = PROJ + rowb * INC + C_DV + hd * 128;
    float m1 = -1e30f, m2 = -1e30f, l1 = 0.f, l2 = 0.f;
    f32x16 o1[4], o2[4];
#pragma unroll
    for (int d = 0; d < 4; ++d)
#pragma unroll
        for (int i = 0; i < 16; ++i) { o1[d][i] = 0.f; o2[d][i] = 0.f; }
    const int nt = ((q0 + 127) >> 6) + 1;
    u32x4 kr[2], vr[2];
    tile_prefetch(kr, Kg, tid); tile_prefetch(vr, Vg, tid);
#pragma unroll 1
    for (int kt = 0; kt < nt; ++kt) {
        const int buf = kt & 1;
        LAS char* Kb = lds + A_K + buf * KBYTES; LAS char* Vb = lds + A_V + buf * VBYTES;
        tile_store(Kb, KP, kr, tid); tile_store(Vb, VP, vr, tid);
        __syncthreads();
        if (kt + 1 < nt) { tile_prefetch(kr, Kg + (size_t)((kt + 1) * 64) * INC, tid); tile_prefetch(vr, Vg + (size_t)((kt + 1) * 64) * INC, tid); }
        const int k0 = kt * 64;
        if (k0 + 32 * kh <= qw + 31) {
            const bool far = (qw - (k0 + 63)) >= 128; const float bfar = bt[128];
            const LAS char* kp = Kb + (32 * kh + r) * KP + 16 * h;
            const int keyb = k0 + 32 * kh + 4 * h;
            bf16x8 Pa, Pb, Pc, Pd;
            f32x16 c1 = diff_qk(kp, qp), c2 = diff_qk(kp + 128, qp + 128);
            diff_sm(c1, far, bfar, bt, q, keyb, m1, l1, o1, Pa, Pb);
            pv_half(o1, Vb, kh, Pa, Pb, lane);
            diff_sm(c2, far, bfar, bt, q, keyb, m2, l2, o2, Pc, Pd);
            pv_half(o2, Vb, kh, Pc, Pd, lane);
            __builtin_amdgcn_sched_barrier(0);
        }
    }
    l1 += __shfl_xor(l1, 32); l2 += __shfl_xor(l2, 32);
    __syncthreads();
    LAS float* EX = (LAS float*)(lds + rg * 16384) + lane;
    LAS float* ST = (LAS float*)(lds + 65536 + rg * 1024) + lane;
    if (kh == 1) { ST[0] = m1; ST[64] = l1; ST[128] = m2; ST[192] = l2;
#pragma unroll
        for (int d = 0; d < 4; ++d)
#pragma unroll
            for (int i = 0; i < 16; ++i) EX[(16 * d + i) * 64] = o1[d][i]; }
    __syncthreads();
    float f2a = 1.f, f2b = 0.f;
    if (kh == 0) {
        const float mb1 = ST[0], lb1 = ST[64], mb2 = ST[128], lb2 = ST[192];
        const float mn1 = fmaxf(m1, mb1), fa = __builtin_amdgcn_exp2f(m1 - mn1), fb = __builtin_amdgcn_exp2f(mb1 - mn1);
        l1 = l1 * fa + lb1 * fb;
#pragma unroll
        for (int d = 0; d < 4; ++d)
#pragma unroll
            for (int i = 0; i < 16; ++i) o1[d][i] = o1[d][i] * fa + EX[(16 * d + i) * 64] * fb;
        const float mn2 = fmaxf(m2, mb2); f2a = __builtin_amdgcn_exp2f(m2 - mn2); f2b = __builtin_amdgcn_exp2f(mb2 - mn2);
        l2 = l2 * f2a + lb2 * f2b;
    }
    __syncthreads();
    if (kh == 1) {
#pragma unroll
        for (int d = 0; d < 4; ++d)
#pragma unroll
            for (int i = 0; i < 16; ++i) EX[(16 * d + i) * 64] = o2[d][i]; }
    __syncthreads();
    if (kh == 0) {
        const float inv1 = 1.0f / l1, inv2 = lam / l2;
        float ss = 0.f;
#pragma unroll
        for (int db = 0; db < 4; ++db)
#pragma unroll
            for (int i = 0; i < 16; ++i) { const float v2 = o2[db][i] * f2a + EX[(16 * db + i) * 64] * f2b; const float v = o1[db][i] * inv1 - v2 * inv2; o1[db][i] = v; ss += v * v; }
        ss += __shfl_xor(ss, 32);
        const float rs = outscale / sqrtf(ss * (1.0f / 128.0f) + EPS);
        bf16* Og = MIX + (rowb + q) * DM + MIX_DIFF + hd * 128 + 4 * h;
#pragma unroll
        for (int db = 0; db < 4; ++db)
#pragma unroll
            for (int g = 0; g < 4; ++g) { const f32x4 gg = *(const f32x4*)(subg + 32 * db + 8 * g + 4 * h);
                u32x2 ov; ov.x = cvtpk(o1[db][4 * g] * rs * gg.x, o1[db][4 * g + 1] * rs * gg.y); ov.y = cvtpk(o1[db][4 * g + 2] * rs * gg.z, o1[db][4 * g + 3] * rs * gg.w); *(u32x2*)(Og + 32 * db + 8 * g) = ov; }
    }
    __syncthreads();
}

constexpr int S_E = 0, S_XT = 16384, S_XTB = 32 * KP;
__device__ __forceinline__ float gelu_tanh(float y) {
    const float a = 0.7978845608028654f * (y + 0.044715f * y * y * y);
    const float t = 1.0f - 2.0f / (__expf(2.0f * a) + 1.0f);
    return 0.5f * y * (1.0f + t);
}
#define SSM_BU(uf_) \
    f32x16 a_re, b_re, a_im, b_im; \
    { f32x16 z; _Pragma("unroll") for (int i = 0; i < 16; ++i) z[i] = 0.f; \
      a_re = MFMA32(uf_, bfrag[0], z); b_re = MFMA32(uf_, bfrag[1], z); a_im = MFMA32(uf_, bfrag[2], z); b_im = MFMA32(uf_, bfrag[3], z); \
      _Pragma("unroll") for (int i = 0; i < 16; ++i) { \
          auto s1 = __builtin_amdgcn_permlane32_swap(__float_as_uint(a_re[i]), __float_as_uint(b_re[i]), false, false); a_re[i] = __uint_as_float(s1[0]); b_re[i] = __uint_as_float(s1[1]); \
          auto s2 = __builtin_amdgcn_permlane32_swap(__float_as_uint(a_im[i]), __float_as_uint(b_im[i]), false, false); a_im[i] = __uint_as_float(s2[0]); b_im[i] = __uint_as_float(s2[1]); } }
#define SSM_ADV(bur_, bui_) do { const float nxr = lr * xr - li * xi + (bur_), nxi = lr * xi + li * xr + (bui_); xr = nxr; xi = nxi; } while (0)
__device__ __forceinline__ void ssm_unit(LAS char* lds, int l, const bf16* PROJ, bf16* YSB, int b, int g, unsigned* done_cnt) {
    int tid_o = threadIdx.x; asm volatile("" : "+v"(tid_o)); const int tid = tid_o, lane = tid & 63, r = lane & 31, h = lane >> 5, w = __builtin_amdgcn_readfirstlane(tid >> 6);
    const int lg = l * 32 + g;
    const size_t rowb = (size_t)b * SEQ;
    LAS float* E = (LAS float*)(lds + S_E);
    LAS char* XT = lds + S_XT + w * S_XTB;
    const int trow = 16 * ((r >> 2) & 1) + (r & 3) + 4 * (r >> 3);
    const float ar = IN(8)[lg * 64 + lane], ai = IN(9)[lg * 64 + lane], dt = expf(IN(10)[lg]);
    const float mag = expf(ar * dt); const float lr = mag * cosf(ai * dt), li = mag * sinf(ai * dt);
    const float den = ar * ar + ai * ai;
    const float fr = ((lr - 1.0f) * ar + li * ai) / den, fi = (li * ar - (lr - 1.0f) * ai) / den;
    bf16x8 bfrag[4];
    { float bbr[16], bbi[16], pbr[16], pbi[16];
      const f32x4* br4 = (const f32x4*)(IN(11) + ((size_t)lg * 64 + lane) * 16); const f32x4* bi4 = (const f32x4*)(IN(12) + ((size_t)lg * 64 + lane) * 16);
#pragma unroll
      for (int j = 0; j < 4; ++j) { const f32x4 br = br4[j], bi = bi4[j];
#pragma unroll
          for (int e = 0; e < 4; ++e) { bbr[4 * j + e] = fr * br[e] - fi * bi[e]; bbi[4 * j + e] = fr * bi[e] + fi * br[e]; } }
#pragma unroll
      for (int c = 0; c < 16; ++c) { pbr[c] = __shfl_xor(bbr[c], 32); pbi[c] = __shfl_xor(bbi[c], 32); }
#pragma unroll
      for (int nb = 0; nb < 4; ++nb) { const bool own = ((nb & 1) == h); float v[8];
#pragma unroll
          for (int j = 0; j < 8; ++j) { const float o_ = (nb < 2) ? (h ? bbr[8 + j] : bbr[j]) : (h ? bbi[8 + j] : bbi[j]); const float p_ = (nb < 2) ? (h ? pbr[8 + j] : pbr[j]) : (h ? pbi[8 + j] : pbi[j]); v[j] = own ? o_ : p_; }
          u32x4 pk; pk.x = cvtpk(v[0], v[1]); pk.y = cvtpk(v[2], v[3]); pk.z = cvtpk(v[4], v[5]); pk.w = cvtpk(v[6], v[7]); bfrag[nb] = __builtin_bit_cast(bf16x8, pk); } }
    bf16x8 cmf[9];
#pragma unroll
    for (int s = 0; s < 8; ++s) { u32x4 pk = {0u, 0u, 0u, 0u};
        if (r < 16) { const float* src = (s < 4 ? IN(13) : IN(14)) + ((size_t)lg * 16 + r) * 64 + 16 * (s & 3) + 8 * h; const float sg = s < 4 ? 1.0f : -1.0f;
            const f32x4 a = *(const f32x4*)src * sg, c = *(const f32x4*)(src + 4) * sg;
            pk.x = cvtpk(a.x, a.y); pk.y = cvtpk(a.z, a.w); pk.z = cvtpk(c.x, c.y); pk.w = cvtpk(c.z, c.w); }
        cmf[s] = __builtin_bit_cast(bf16x8, pk); }
    { const float dsk = IN(15)[lg * 16 + (r & 15)]; float v[8];
#pragma unroll
      for (int j = 0; j < 8; ++j) v[j] = (r < 16 && (8 * h + j) == r) ? dsk : 0.f;
      u32x4 pk; pk.x = cvtpk(v[0], v[1]); pk.y = cvtpk(v[2], v[3]); pk.z = cvtpk(v[4], v[5]); pk.w = cvtpk(v[6], v[7]); cmf[8] = __builtin_bit_cast(bf16x8, pk); }
    float l64r = lr, l64i = li;
#pragma unroll
    for (int s = 0; s < 6; ++s) { const float nr = l64r * l64r - l64i * l64i, ni = 2.0f * l64r * l64i; l64r = nr; l64i = ni; }
#define SSM_UADDR(bi_) (PROJ + (rowb + 64 * (w + 8 * ((bi_) >> 1)) + 32 * ((bi_) & 1) + trow) * INC + C_U + g * 16 + 8 * h)
    {
        bf16x8 ufc = *(const bf16x8*)SSM_UADDR(0);
        float xr = 0.f, xi = 0.f;
#pragma unroll 1
        for (int bi = 0; bi < 8; ++bi) {
            const bf16x8 ufn = *(const bf16x8*)SSM_UADDR(bi < 7 ? bi + 1 : 7);
            SSM_BU(ufc)
#pragma unroll
            for (int i = 0; i < 16; ++i) SSM_ADV(a_re[i], a_im[i]);
#pragma unroll
            for (int i = 0; i < 16; ++i) SSM_ADV(b_re[i], b_im[i]);
            if (bi & 1) { const int k = w + 8 * (bi >> 1); E[k * 128 + lane] = xr; E[k * 128 + 64 + lane] = xi; xr = 0.f; xi = 0.f; }
            ufc = ufn;
        }
    }
    __syncthreads();
    LAS char* xw = XT + 2 * lane;
    const LAS char* xrd = XT + r * KP + 16 * h;
    {
        float cr = 0.f, ci = 0.f;
#pragma unroll 1
        for (int k = 0; k < w; ++k) { const float er = E[k * 128 + lane], ei = E[k * 128 + 64 + lane]; const float nr = l64r * cr - l64i * ci + er, ni = l64r * ci + l64i * cr + ei; cr = nr; ci = ni; }
        bf16x8 ufc = *(const bf16x8*)SSM_UADDR(0);
        float xr = cr, xi = ci;
#pragma unroll 1
        for (int bi = 0; bi < 8; ++bi) {
            const bf16x8 ufn = *(const bf16x8*)SSM_UADDR(bi < 7 ? bi + 1 : 7);
            const size_t row0 = rowb + 64 * (w + 8 * (bi >> 1)) + 32 * (bi & 1);
            { SSM_BU(ufc)
#pragma unroll
              for (int i = 0; i < 16; ++i) { SSM_ADV(a_re[i], a_im[i]); const unsigned pk = cvtpk(xr, xi); const int rho = 8 * (i >> 2) + (i & 3);
                  *(LAS unsigned short*)(xw + rho * KP) = (unsigned short)pk; *(LAS unsigned short*)(xw + rho * KP + 128) = (unsigned short)(pk >> 16); }
#pragma unroll
              for (int i = 0; i < 16; ++i) { SSM_ADV(b_re[i], b_im[i]); const unsigned pk = cvtpk(xr, xi); const int rho = 8 * (i >> 2) + 4 + (i & 3);
                  *(LAS unsigned short*)(xw + rho * KP) = (unsigned short)pk; *(LAS unsigned short*)(xw + rho * KP + 128) = (unsigned short)(pk >> 16); } }
            WAVE_SYNC();
            f32x16 y;
#pragma unroll
            for (int i = 0; i < 16; ++i) y[i] = 0.f;
            y = MFMA32(cmf[8], ufc, y);
#pragma unroll
            for (int s = 0; s < 8; ++s) { const bf16x8 xa = *(const LAS bf16x8*)(xrd + 32 * s); y = MFMA32(cmf[s], xa, y); }
            {
                bf16* yo = YSB + (row0 + trow) * 512 + g * 16 + 4 * h;
                u32x2 w0, w1;
                w0.x = pk2(gelu_tanh(y[0]), gelu_tanh(y[1])); w0.y = pk2(gelu_tanh(y[2]), gelu_tanh(y[3]));
                w1.x = pk2(gelu_tanh(y[4]), gelu_tanh(y[5])); w1.y = pk2(gelu_tanh(y[6]), gelu_tanh(y[7]));
                *(u32x2*)yo = w0; *(u32x2*)(yo + 8) = w1;
            }
            WAVE_SYNC();
            if ((bi & 1) && bi < 7) {
                const int k0c = w + 8 * (bi >> 1);
#pragma unroll 1
                for (int k = k0c; k < k0c + 8; ++k) { const float er = E[k * 128 + lane], ei = E[k * 128 + 64 + lane]; const float nr = l64r * cr - l64i * ci + er, ni = l64r * ci + l64i * cr + ei; cr = nr; ci = ni; }
                xr = cr; xi = ci;
            }
            ufc = ufn;
        }
    }
    asm volatile("s_waitcnt vmcnt(0)" ::: "memory");
    __syncthreads();
    if (tid == 0) { __builtin_amdgcn_fence(__ATOMIC_RELEASE, "agent"); asm volatile("s_waitcnt vmcnt(0)" ::: "memory"); __hip_atomic_fetch_add(done_cnt, 1u, __ATOMIC_RELAXED, __HIP_MEMORY_SCOPE_AGENT); }
}
#undef SSM_UADDR
#undef SSM_BU
#undef SSM_ADV
constexpr int I_G = (DM / 64) * (FF / 32), I_D = (FF / 64) * (DM / 32), I_IN = (DM / 64) * (INC / 32), I_OUT = (DM / 64) * (DM / 32), I_GLU = (512 / 64) * (512 / 32);
constexpr int CV_PER_LAYER = 4 * I_G + 2 * I_D + I_IN + I_OUT + I_GLU, CV_TOTAL = NLAYER * CV_PER_LAYER;
static_assert(CV_TOTAL % 8 == 0 && (2 * I_G) % 8 == 0, "batches of 8");
__device__ __forceinline__ void convert_item(int it, unsigned char* wsb, LAS float* scr, int lane) {
    const int l = it / CV_PER_LAYER; int r = it % CV_PER_LAYER;
    unsigned char* lw0 = wsb + WS_W + (size_t)l * LW_SIZE;
    if (r < I_G) { transpose_item(IN(2) + (size_t)l * DM * FF, DM, FF, (bf16*)(lw0 + LW_GU1), 1, scr, r, lane); return; } r -= I_G;
    if (r < I_G) { transpose_item(IN(3) + (size_t)l * DM * FF, DM, FF, (bf16*)(lw0 + LW_GU1), 2, scr, r, lane); return; } r -= I_G;
    if (r < I_D) { transpose_item(IN(4) + (size_t)l * FF * DM, FF, DM, (bf16*)(lw0 + LW_D1), 0, scr, r, lane); return; } r -= I_D;
    if (r < I_IN) { transpose_item(IN(7) + (size_t)l * DM * INC, DM, INC, (bf16*)(lw0 + LW_IN), 0, scr, r, lane); return; } r -= I_IN;
    if (r < I_OUT) { transpose_item(IN(24) + (size_t)l * DM * DM, DM, DM, (bf16*)(lw0 + LW_OUT), 0, scr, r, lane); return; } r -= I_OUT;
    if (r < I_GLU) { transpose_item(IN(16) + (size_t)l * 512 * 512, 512, 512, (bf16*)(lw0 + LW_GLU), 0, scr, r, lane); return; } r -= I_GLU;
    if (r < I_G) { transpose_item(IN(27) + (size_t)l * DM * FF, DM, FF, (bf16*)(lw0 + LW_GU2), 1, scr, r, lane); return; } r -= I_G;
    if (r < I_G) { transpose_item(IN(28) + (size_t)l * DM * FF, DM, FF, (bf16*)(lw0 + LW_GU2), 2, scr, r, lane); return; } r -= I_G;
    transpose_item(IN(29) + (size_t)l * FF * DM, FF, DM, (bf16*)(lw0 + LW_D2), 0, scr, r, lane);
}
__device__ __forceinline__ void convert_static(int start, int end, int b0, int nb, unsigned char* wsb, LAS unsigned char* lds) {
    const int ib = (int)blockIdx.x - b0; if (ib < 0 || ib >= nb) return;
    int tid_o = threadIdx.x; asm volatile("" : "+v"(tid_o)); const int lane = tid_o & 63, wave = __builtin_amdgcn_readfirstlane(tid_o >> 6);
    LAS float* scr = (LAS float*)(lds + wave * 16384);
#pragma unroll 1
    for (int it = start + ib * NWAVES + wave; it < end; it += nb * NWAVES) convert_item(it, wsb, scr, lane);
}
__device__ __forceinline__ void convert_batch64(int c0, unsigned char* wsb, LAS unsigned char* lds) {
    int tid_o = threadIdx.x; asm volatile("" : "+v"(tid_o)); const int lane = tid_o & 63, wave = __builtin_amdgcn_readfirstlane(tid_o >> 6);
    LAS float* scr = (LAS float*)(lds + wave * 16384);
#pragma unroll 1
    for (int j = 0; j < 8; ++j) convert_item(c0 + 8 * wave + j, wsb, scr, lane);
}
#ifndef CV_UPFRONT
#define CV_UPFRONT 1
#endif
#if CV_UPFRONT
constexpr int CV_P0_END = CV_TOTAL, CV_A_END = CV_TOTAL, CV_B_END = CV_TOTAL, CV_M_END = CV_TOTAL, CV_MB = 0;
#else
constexpr int CV_P0_END = 2 * I_G;
constexpr int CV_A_END = 4 * I_G + I_D + I_IN + I_OUT + I_GLU - 2 * I_G + 2048;
constexpr int CV_B_END = CV_PER_LAYER;
constexpr int CV_M_END = CV_PER_LAYER + 2 * I_G + I_D + I_IN + I_OUT + I_GLU;
constexpr int CV_MB = (CV_M_END - CV_B_END) / 64;
#endif
static_assert((CV_M_END - CV_B_END) % 64 == 0, "mixer-phase conversion batches");
#ifndef PHASE_MASK
#define PHASE_MASK 0xFFFF
#endif
#define PH(k) if constexpr (((PHASE_MASK) >> (k)) & 1)
#ifndef MK_SYNC
#define MK_SYNC() do { XcdBarrier xb_; xb_.bar = (unsigned*)ws + 1024; xb_.x = xb_xcc_id(); xb_.st = (volatile LAS unsigned*)(lds + LDS_BYTES - 32); xcd_barrier(xb_); } while (0)
#endif
#ifndef CV_P0_LIM
#define CV_P0_LIM (2 * I_G)
#endif
#ifndef CV_LIM_GU1
#define CV_LIM_GU1 32000
#endif
#ifndef CV_LIM_WIN
#define CV_LIM_WIN 52000
#endif
#ifndef CV_LIM_MIX
#define CV_LIM_MIX 64000
#endif
__global__ void __launch_bounds__(NTHREADS, 2) fwd_megakernel(Args args) {
    extern __shared__ __attribute__((aligned(16))) unsigned char lds_raw[];
    cg::grid_group grid = cg::this_grid();
    LAS unsigned char* lds = (LAS unsigned char*)lds_raw;
    const int G = gridDim.x, bid = blockIdx.x, ngw = G * NWAVES;
    if (threadIdx.x < 2) ((volatile LAS unsigned*)(lds + LDS_BYTES - 32))[threadIdx.x] = 0u;
    __syncthreads();
    (void)xcd_barrier_post((unsigned*)(kargs_ptr()->ws) + 1024, (volatile LAS unsigned*)(lds + LDS_BYTES - 32));
#define LANE_SETUP() int tid_o = threadIdx.x; asm volatile("" : "+v"(tid_o)); const int lane = tid_o & 63, wave = __builtin_amdgcn_readfirstlane(tid_o >> 6), gw = bid * NWAVES + wave; (void)gw; (void)lane
#define ws (kargs_ptr()->ws)
#define XN ((bf16*)(ws + WS_XN))
#define BIG ((bf16*)(ws + WS_BIG))
#define Y ((bf16*)(ws + WS_Y))
#define MIX ((bf16*)(ws + WS_MIX))
#define YS ((float*)(ws + WS_YS))
#define YSB ((bf16*)(ws + WS_YSB))
#define H (kargs_ptr()->out)

    { convert_static(0, CV_P0_END, 0, G, ws, lds);
      PH(0) { LANE_SETUP();
        row_pass(nullptr, IN(0), nullptr, XN, nullptr, 0.f, IN(1), gw, ngw, lane); }
    }
    if (__builtin_expect(kargs_ptr()->out == nullptr, 0)) grid.sync();
    MK_SYNC();

#pragma unroll 1
    for (int l = 0; l < NLAYER; ++l) {
#define lw (ws + WS_W + (size_t)l * LW_SIZE)
#pragma unroll 1
        for (int f = 0; f < 2; ++f) {
            PH(1) { pg8::Gemm g{XN, (const bf16*)(lw + (f ? LW_GU2 : LW_GU1)), M, 2 * FF, DM}; pg8::StaticOrder S; S.init(M, 2 * FF, G, bid);
              pg8::EpiSwiGLU E{BIG, FF};
              pg8::gemm_phase<pg8::EpiSwiGLU, pg8::StaticOrder, true, true>(lds, g, S, E); }
            MK_SYNC();
            PH(2) { pg8::Gemm g{BIG, (const bf16*)(lw + (f ? LW_D2 : LW_D1)), M, DM, FF}; pg8::StaticOrder S; S.init(M, DM, G, bid);
              pg8::EpiBf16Plain E{Y, DM};
              pg8::gemm_phase<pg8::EpiBf16Plain, pg8::StaticOrder, true, true>(lds, g, S, E); }
            MK_SYNC();
            PH(3) { LANE_SETUP(); const float* gpost = (f ? IN(30) : IN(5)) + (size_t)l * DM;
              const float* gpre = f == 0 ? IN(6) + (size_t)l * DM : (l + 1 < NLAYER ? IN(1) + (size_t)(l + 1) * DM : nullptr);
              row_pass(Y, (l == 0 && f == 0) ? IN(0) : (const float*)H, H, XN, gpost, 0.5f, gpre, gw, ngw, lane); }
            if (f == 1) break;
            MK_SYNC();
            PH(4) { pg8::Gemm g{XN, (const bf16*)(lw + LW_IN), M, INC, DM}; pg8::StaticOrder S; S.init(M, INC, G, bid);
              pg8::EpiBf16Plain E{BIG, INC};
              pg8::gemm_phase<pg8::EpiBf16Plain, pg8::StaticOrder, true, true>(lds, g, S, E); }
            MK_SYNC();
#ifndef MIX_REPS
#define MIX_REPS 1
#endif
            {
                LANE_SETUP();
                const float lambda_init = 0.8f - 0.6f * expf(-0.3f * (float)l);
                const float d1 = wave_sum(IN(18)[l * 64 + lane] * IN(19)[l * 64 + lane]);
                const float d2 = wave_sum(IN(20)[l * 64 + lane] * IN(21)[l * 64 + lane]);
                const float lam = expf(d1) - expf(d2) + lambda_init;
                volatile LAS int* slot = (volatile LAS int*)(lds + LDS_BYTES - 64);
                volatile LAS int* peekv = (volatile LAS int*)(lds + LDS_BYTES - 128);
                const int myx = (int)(xb_xcc_id() & 7u);
#pragma unroll 1
                for (int stage = 0; stage < 3; ++stage) {
                    const int limit = stage == 0 ? 64 : (stage == 1 ? 24 : 64);
                    const int cbase = stage == 0 ? 64 * (l * 8) : (stage == 1 ? 4608 + 64 * (l * 8) : 5632 + 64 * l);
#pragma unroll 1
                    for (int pass = 0; ; ++pass) {
                        int x = 0;
                        if (stage == 2) { if (pass) break; }
                        else if (pass == 0) x = myx;
                        else {
                            if (tid_o < 8) peekv[tid_o] = (int)__hip_atomic_load((unsigned*)ws + cbase + 64 * tid_o, __ATOMIC_RELAXED, __HIP_MEMORY_SCOPE_AGENT);
                            __syncthreads();
                            x = -1;
#pragma unroll
                            for (int j = 7; j >= 0; --j) { const int xx = (myx + j) & 7; if (peekv[xx] < limit) x = xx; }
                            __syncthreads();
                            if (x < 0) break;
                        }
                        unsigned* ctr = (unsigned*)ws + cbase + 64 * x;
                        if (tid_o == 0) *slot = (int)atomicAdd(ctr, 1u);
                        __syncthreads();
                        int item = *slot;
                        __syncthreads();
                        while (item < limit) {
                            if (stage == 0) {
                                if (item < 24 || item >= 40) { PH(5) { const int di = item < 24 ? item : item - 16; const int qb = 15 - (di / 3), bh = 8 * (di % 3) + x;
                                    diff_unit((LAS char*)lds, BIG, MIX, IN(23), lam, 1.0f - lambda_init, IN(22) + (size_t)l * 128, bh / 6, bh % 6, qb); } }
                                else { PH(6) { const int u = 8 * (item - 24) + x; ssm_unit((LAS char*)lds, l, BIG, YSB, u / 32, u % 32, (unsigned*)ws + 6144 + 64 * (l * 4 + u / 32)); } }
                            } else if (stage == 1) { PH(7) { const int qb = 7 - (item / 3), bh = 8 * (item % 3) + x; sb_unit((LAS char*)lds, BIG, MIX, bh / 6, bh % 6, qb); } }
                            else { PH(8) {
                                pg8::Gemm g{YSB, (const bf16*)(lw + LW_GLU), M, 512, 512};
                                pg8::GatedUnit S1{pg8::Unit{item >> 1, item & 1}, (unsigned*)ws + 6144 + 64 * (l * 4 + (item >> 4)), 32u};
                                pg8::EpiGlu E{MIX + MIX_SSM, DM, YSB, 512, IN(17) + (size_t)l * 512};
                                pg8::gemm_phase<pg8::EpiGlu, pg8::GatedUnit, true, true>(lds, g, S1, E);
                                __syncthreads(); } }
                            if (tid_o == 0) *slot = (int)atomicAdd(ctr, 1u);
                            __syncthreads();
                            item = *slot;
                            __syncthreads();
                        }
                    }
                }
            }
            MK_SYNC();
            PH(9) { pg8::Gemm g{MIX, (const bf16*)(lw + LW_OUT), M, DM, DM}; pg8::StaticOrder S; S.init(M, DM, G, bid);
              pg8::EpiBf16Plain E{Y, DM};
              pg8::gemm_phase<pg8::EpiBf16Plain, pg8::StaticOrder, true, true>(lds, g, S, E); }
            MK_SYNC();
            PH(3) { LANE_SETUP(); row_pass(Y, H, H, XN, IN(25) + (size_t)l * DM, 1.0f, IN(26) + (size_t)l * DM, gw, ngw, lane); }
            MK_SYNC();
        }
        if (l + 1 < NLAYER) MK_SYNC();
    }
}

#undef ws
#undef XN
#undef BIG
#undef Y
#undef MIX
#undef YS
#undef YSB
#undef H
#undef lw
extern "C" void kernel_launch(void* const* d_in, const int* in_sizes, int n_in, void* d_out, int out_size, void* d_ws, size_t ws_size, hipStream_t stream) {
    static int grid = 0;
    if (grid == 0) {
        if (n_in != 31 || out_size != M * DM || ws_size < WS_END) { fprintf(stderr, "kernel_launch: unexpected shapes (n_in %d, out %d, ws %zu < %zu)\n", n_in, out_size, ws_size, (size_t)WS_END); grid = -1; return; }
        int dev = 0, cus = 0, per_cu = 0;
        hipGetDevice(&dev); hipDeviceGetAttribute(&cus, hipDeviceAttributeMultiprocessorCount, dev);
        if (hipFuncSetAttribute((const void*)fwd_megakernel, hipFuncAttributeMaxDynamicSharedMemorySize, LDS_BYTES) != hipSuccess) { fprintf(stderr, "kernel_launch: hipFuncSetAttribute failed\n"); grid = -1; return; }
        hipOccupancyMaxActiveBlocksPerMultiprocessor(&per_cu, (const void*)fwd_megakernel, NTHREADS, LDS_BYTES);
        if (per_cu < 1) { fprintf(stderr, "kernel_launch: occupancy query says %d blocks per CU\n", per_cu); per_cu = 1; }
        (void)hipGetLastError();
        grid = cus * 1;
    }
    if (grid < 0) return;
    if (hipMemsetAsync(d_ws, 0, 65536, stream) != hipSuccess) { fprintf(stderr, "kernel_launch: memset failed\n"); return; }
    Args a{};
    for (int i = 0; i < 31; ++i) a.in[i] = (const float*)d_in[i];
    a.out = (float*)d_out; a.ws = (unsigned char*)d_ws;
    void* kargs[] = {&a};
    hipError_t e = hipLaunchCooperativeKernel((const void*)fwd_megakernel, dim3(grid), dim3(NTHREADS), kargs, LDS_BYTES, stream);
    if (e != hipSuccess) fprintf(stderr, "kernel_launch: cooperative launch failed: %s (grid %d)\n", hipGetErrorString(e), grid);
}
```

```cpp
#include <hip/hip_runtime.h>
#include <cstdio>
#include <cstdint>
namespace pg8 {
#define PG8_LAS __attribute__((address_space(3)))
typedef unsigned short bf16_t;
typedef short bf16x8 __attribute__((ext_vector_type(8)));
typedef float f32x4 __attribute__((ext_vector_type(4)));
typedef unsigned u32x4 __attribute__((ext_vector_type(4)));
constexpr int BM = 256, BK = 64, HALF = 128, HTB = HALF * BK * 2  , STAGE_BYTES = 8 * HTB, NXCD = 8, WGM = 8;

__host__ __device__ __forceinline__ int lds_byte(int r, int c) { const int st = (r >> 4) * 2 + (c >> 5), rr = r & 15, cc = c & 31, ob = rr * 64 + cc * 2; return st * 1024 + (ob ^ (((ob >> 9) & 1) << 5)); }
__host__ __device__ __forceinline__ void stage_rc(int b, int& R, int& C) { const int st = b / 1024, sb = b % 1024, swz = sb ^ (((sb >> 9) & 1) << 5); R = (st >> 1) * 16 + swz / 64; C = (st & 1) * 32 + (swz % 64) / 2; }
__host__ __device__ __forceinline__ int perm32(int rho) { const int n = rho >> 4, i = rho & 15; return 8 * (i >> 2) + 4 * n + (i & 3); }

struct Unit { int pm, pn; };
struct Gemm { const bf16_t* A; const bf16_t* Bt; int M, N, K; };

struct StaticOrder {
    int nM, nN, nwg, G, c;
    __host__ __device__ void init(int M, int N, int G_, int c_) { nM = M / BM; nN = N / BM; nwg = nM * nN; G = G_; c = c_; }
    __host__ __device__ bool next(int i, Unit& u) const {
        const long L = (long)i * G + c; if (L >= nwg) return false;
        int wgid = (int)L; { const int q = nwg / NXCD, r = nwg % NXCD, xcd = wgid % NXCD, off = wgid / NXCD; wgid = (xcd < r ? xcd * (q + 1) : r * (q + 1) + (xcd - r) * q) + off; }
        const int nig = WGM * nN, gid = wgid / nig, fm = gid * WGM, gsz = (nM - fm) < WGM ? (nM - fm) : WGM;
        u.pm = fm + ((wgid % nig) % gsz); u.pn = (wgid % nig) / gsz; return true;
    }
    __device__ __forceinline__ void a_ready(const Unit&) const {}
    __device__ __forceinline__ void done(const Unit&) const {}
};

__device__ __forceinline__ unsigned cvt_pk_bf16(float lo, float hi) { unsigned r; asm volatile("v_cvt_pk_bf16_f32 %0, %1, %2" : "=v"(r) : "v"(lo), "v"(hi)); return r; }
typedef float f32x2 __attribute__((ext_vector_type(2)));
__device__ __forceinline__ f32x2 gelu_pk(f32x2 v) {
    const f32x2 av = __builtin_elementwise_abs(v), d = av * 0.2316418882f + 1.0f;
    f32x2 t; t.x = __builtin_amdgcn_rcpf(d.x); t.y = __builtin_amdgcn_rcpf(d.y);
    f32x2 q = t * 0.5307027145f + (-0.7265760135f); q = q * t + 0.7107068705f; q = q * t + (-0.142248368f); q = q * t + 0.127414796f; q = q * t;
    const f32x2 s = (v * v) * (-0.72134752044f);
    f32x2 e; e.x = __builtin_amdgcn_exp2f(s.x); e.y = __builtin_amdgcn_exp2f(s.y);
    const f32x2 m = v * (q * e), r = v - m;
    f32x2 o; o.x = v.x < 0.f ? m.x : r.x; o.y = v.y < 0.f ? m.y : r.y; return o;
}

template <int ACT  > struct EpiBf16 {
    static constexpr bool PERM = true, AFTER_DRAIN = false; static_assert(ACT == 0 || ACT == 1, "EpiBf16: ACT is 0 (none) or 1 (gelu_pk)");
    bf16_t* O; int ldc; const float* bias; int split_cols; size_t split_stride; float scale0;
    __device__ __forceinline__ void operator()(const f32x4 (&acc)[2][2][4][2], const Unit& u, int wr, int wc, int fr, int fq) const {
        const int row0 = u.pm * BM + wr * 64 + fr; int colt = u.pn * BM; bf16_t* base = O;
        float sc = 1.f; if (split_cols) { const int t = colt / split_cols; base += (size_t)t * split_stride; colt -= t * split_cols; if (t == 0) sc = scale0; }
        const int col0 = colt + wc * 32 + 8 * fq, bcol0 = u.pn * BM + wc * 32 + 8 * fq;
        f32x4 bv[2][2];
#pragma unroll
        for (int bj = 0; bj < 2; ++bj)
#pragma unroll
            for (int n = 0; n < 2; ++n) bv[bj][n] = bias ? *(const f32x4*)(bias + bcol0 + bj * HALF + 4 * n) : (f32x4){0.f, 0.f, 0.f, 0.f};
#pragma unroll
        for (int ai = 0; ai < 2; ++ai)
#pragma unroll
            for (int m = 0; m < 4; ++m) { bf16_t* rowp = base + (size_t)(row0 + ai * HALF + m * 16) * ldc + col0;
#pragma unroll
                for (int bj = 0; bj < 2; ++bj) { f32x4 v0 = acc[ai][bj][m][0] + bv[bj][0], v1 = acc[ai][bj][m][1] + bv[bj][1];
                    if (ACT == 1) { f32x2 a = gelu_pk((f32x2){v0[0], v0[1]}), b = gelu_pk((f32x2){v0[2], v0[3]}), c = gelu_pk((f32x2){v1[0], v1[1]}), d = gelu_pk((f32x2){v1[2], v1[3]});
                        v0 = (f32x4){a.x, a.y, b.x, b.y}; v1 = (f32x4){c.x, c.y, d.x, d.y}; }
                    v0 = v0 * sc; v1 = v1 * sc; u32x4 w; w.x = cvt_pk_bf16(v0[0], v0[1]); w.y = cvt_pk_bf16(v0[2], v0[3]); w.z = cvt_pk_bf16(v1[0], v1[1]); w.w = cvt_pk_bf16(v1[2], v1[3]);
                    *(u32x4*)(rowp + bj * HALF) = w; } }
    }
};

template <class Epi, class Sched, bool ALIGN_EPI = false, bool SP2 = false>
__device__ __forceinline__ void gemm_phase(PG8_LAS unsigned char* lds, const Gemm g, const Sched& S, const Epi& E) {
    int tid_o = threadIdx.x; asm volatile("" : "+v"(tid_o));
    const int tid = tid_o, wid = __builtin_amdgcn_readfirstlane(tid >> 6), lane = tid & 63, wr = wid >> 2, wc = wid & 3, fr = lane & 15, fq = lane >> 4;
    const int K = g.K, nt = K / BK;
    unsigned voffA[2], voffB[2];
#pragma unroll
    for (int i = 0; i < 2; ++i) { int R, C; stage_rc(tid * 16 + i * 8192, R, C); const int Rb = Epi::PERM ? ((R & ~31) + perm32(R & 31)) : R;
        voffA[i] = (unsigned)(R * K + C) * 2u; voffB[i] = (unsigned)(Rb * K + C) * 2u; }
    const size_t kstep = (size_t)(BK * 2);
    const size_t hstep = (size_t)HALF * K * 2;
    const size_t tstep = 2 * hstep;
    const unsigned ldsw = (unsigned)wid * 1024u;
    const int aoff = lds_byte(wr * 64 + fr, fq * 8), boff = lds_byte(wc * 32 + fr, fq * 8);
#define PG8_SA(b, h) (((b) * 2 + (h)) * HTB)
#define PG8_SB(b, h) ((4 + (b) * 2 + (h)) * HTB)
#define PG8_STAGE(bufoff, gbase, voff) do { _Pragma("unroll") for (int _i = 0; _i < 2; ++_i) \
        __builtin_amdgcn_global_load_lds((const unsigned*)((const char*)(gbase) + (voff)[_i]), (PG8_LAS unsigned*)(lds + (bufoff) + ldsw + _i * 8192), 16, 0, 0); } while (0)
#define PG8_LDA(dst, b, h) do { _Pragma("unroll") for (int m = 0; m < 4; ++m) _Pragma("unroll") for (int k = 0; k < 2; ++k) dst[m][k] = *(const PG8_LAS bf16x8*)(lds + PG8_SA(b, h) + aoff + m * 2048 + k * 1024); } while (0)
#define PG8_LDB(dst, b, h) do { _Pragma("unroll") for (int n = 0; n < 2; ++n) _Pragma("unroll") for (int k = 0; k < 2; ++k) dst[n][k] = *(const PG8_LAS bf16x8*)(lds + PG8_SB(b, h) + boff + n * 2048 + k * 1024); } while (0)
#define PG8_MMA(ai, bj, At, Bt) do { __builtin_amdgcn_s_setprio(1); _Pragma("unroll") for (int m = 0; m < 4; ++m) _Pragma("unroll") for (int n = 0; n < 2; ++n) _Pragma("unroll") for (int k = 0; k < 2; ++k) \
        acc[ai][bj][m][n] = __builtin_amdgcn_mfma_f32_16x16x32_bf16(Bt[n][k], At[m][k], acc[ai][bj][m][n], 0, 0, 0); __builtin_amdgcn_s_setprio(0); } while (0)
#define PG8_WAIT_V(n) asm volatile("s_waitcnt vmcnt(" #n ")" ::: "memory")
#define PG8_WAIT_L(n) asm volatile("s_waitcnt lgkmcnt(" #n ")" ::: "memory")
#define PG8_BAR __builtin_amdgcn_s_barrier()
#define PG8_SCHED __builtin_amdgcn_sched_barrier(0)
    Unit cur, nxt; int ui = 0;
    if (!S.next(0, cur)) return;
    f32x4 acc[2][2][4][2];
#pragma unroll
    for (int a = 0; a < 2; ++a)
#pragma unroll
        for (int b = 0; b < 2; ++b)
#pragma unroll
            for (int m = 0; m < 4; ++m)
#pragma unroll
                for (int n = 0; n < 2; ++n) acc[a][b][m][n] = (f32x4){0.f, 0.f, 0.f, 0.f};
    bf16x8 At[4][2], B0[2][2], B1[2][2];
    const char* cA = (const char*)g.A + (size_t)cur.pm * tstep; const char* cB = (const char*)g.Bt + (size_t)cur.pn * tstep;
    S.a_ready(cur);
    if constexpr (SP2) {
        PG8_STAGE(PG8_SB(0, 0), cB, voffB); PG8_STAGE(PG8_SB(0, 1), cB + hstep, voffB); PG8_STAGE(PG8_SA(0, 0), cA, voffA); PG8_STAGE(PG8_SA(0, 1), cA + hstep, voffA);
        if (wr == 1) PG8_BAR;
        PG8_WAIT_V(2); PG8_BAR;
        PG8_STAGE(PG8_SB(1, 0), cB + kstep, voffB); PG8_STAGE(PG8_SA(1, 0), cA + kstep, voffA); PG8_STAGE(PG8_SB(1, 1), cB + hstep + kstep, voffB);
        PG8_WAIT_V(6); PG8_BAR;
    } else {
        PG8_STAGE(PG8_SB(0, 0), cB, voffB); PG8_STAGE(PG8_SA(0, 0), cA, voffA); PG8_STAGE(PG8_SB(0, 1), cB + hstep, voffB); PG8_STAGE(PG8_SA(0, 1), cA + hstep, voffA);
        if (wr == 1) PG8_BAR;
        PG8_WAIT_V(4); PG8_BAR;
        PG8_STAGE(PG8_SB(1, 0), cB + kstep, voffB); PG8_STAGE(PG8_SA(1, 0), cA + kstep, voffA); PG8_STAGE(PG8_SB(1, 1), cB + hstep + kstep, voffB);
        PG8_WAIT_V(6); PG8_BAR;
    }
    for (;;) {
        const bool has_next = S.next(ui + 1, nxt);
        const char* nA = has_next ? (const char*)g.A + (size_t)nxt.pm * tstep : cA; const char* nB = has_next ? (const char*)g.Bt + (size_t)nxt.pn * tstep : cB;
        for (int t = 0; t < nt; t += 2) {
            const bool last = (t == nt - 2);
            const char* a1 = cA + (size_t)(t + 1) * kstep;
            const char* a2 = last ? nA : cA + (size_t)(t + 2) * kstep; const char* b2 = last ? nB : cB + (size_t)(t + 2) * kstep;
            const char* a3 = a2 + kstep; const char* b3 = b2 + kstep;
            if (last && has_next) S.a_ready(nxt);
            if constexpr (SP2) {
            PG8_LDB(B0, 0, 0); PG8_LDB(B1, 0, 1); PG8_SCHED; PG8_LDA(At, 0, 0); PG8_STAGE(PG8_SA(1, 1), a1 + hstep, voffA);
            PG8_WAIT_V(8); PG8_WAIT_L(0); PG8_BAR; PG8_MMA(0, 0, At, B0); PG8_MMA(0, 1, At, B1); PG8_BAR; PG8_SCHED;
            PG8_LDA(At, 0, 1); PG8_STAGE(PG8_SB(0, 0), b2, voffB); PG8_STAGE(PG8_SB(0, 1), b2 + hstep, voffB); PG8_STAGE(PG8_SA(0, 0), a2, voffA);
            PG8_WAIT_V(8); PG8_WAIT_L(0); PG8_BAR; PG8_MMA(1, 0, At, B0); PG8_MMA(1, 1, At, B1); PG8_BAR; PG8_SCHED;
            PG8_LDB(B0, 1, 0); PG8_LDB(B1, 1, 1); PG8_SCHED; PG8_LDA(At, 1, 0); PG8_STAGE(PG8_SA(0, 1), a2 + hstep, voffA);
            PG8_WAIT_V(8); PG8_WAIT_L(0); PG8_BAR; PG8_MMA(0, 0, At, B0); PG8_MMA(0, 1, At, B1); PG8_BAR; PG8_SCHED;
            PG8_LDA(At, 1, 1); PG8_STAGE(PG8_SB(1, 0), b3, voffB); PG8_STAGE(PG8_SB(1, 1), b3 + hstep, voffB); PG8_STAGE(PG8_SA(1, 0), a3, voffA);
            PG8_WAIT_V(8); PG8_WAIT_L(0); PG8_BAR; PG8_MMA(1, 0, At, B0); PG8_MMA(1, 1, At, B1); PG8_BAR; PG8_SCHED;
            } else {
            PG8_LDB(B0, 0, 0); PG8_SCHED; PG8_LDA(At, 0, 0); PG8_STAGE(PG8_SA(1, 1), a1 + hstep, voffA);
            PG8_WAIT_L(8); PG8_BAR; PG8_WAIT_L(0); PG8_MMA(0, 0, At, B0); PG8_BAR; PG8_SCHED;
            PG8_LDB(B1, 0, 1); PG8_STAGE(PG8_SB(0, 0), b2, voffB);
            PG8_BAR; PG8_WAIT_L(0); PG8_MMA(0, 1, At, B1); PG8_BAR;
            PG8_LDA(At, 0, 1); PG8_STAGE(PG8_SA(0, 0), a2, voffA);
            PG8_BAR; PG8_WAIT_L(0); PG8_MMA(1, 0, At, B0); PG8_BAR; PG8_SCHED;
            PG8_STAGE(PG8_SB(0, 1), b2 + hstep, voffB);
            PG8_WAIT_V(6); PG8_BAR; PG8_MMA(1, 1, At, B1); PG8_BAR;
            PG8_LDB(B0, 1, 0); PG8_SCHED; PG8_LDA(At, 1, 0); PG8_STAGE(PG8_SA(0, 1), a2 + hstep, voffA);
            PG8_WAIT_L(8); PG8_BAR; PG8_WAIT_L(0); PG8_MMA(0, 0, At, B0); PG8_BAR; PG8_SCHED;
            PG8_LDB(B1, 1, 1); PG8_STAGE(PG8_SB(1, 0), b3, voffB);
            PG8_BAR; PG8_WAIT_L(0); PG8_MMA(0, 1, At, B1); PG8_BAR;
            PG8_LDA(At, 1, 1); PG8_STAGE(PG8_SA(1, 0), a3, voffA);
            PG8_BAR; PG8_WAIT_L(0); PG8_MMA(1, 0, At, B0); PG8_BAR; PG8_SCHED;
            PG8_STAGE(PG8_SB(1, 1), b3 + hstep, voffB);
            PG8_WAIT_V(6); PG8_BAR; PG8_MMA(1, 1, At, B1); PG8_BAR;
            }
        }
        if constexpr (ALIGN_EPI) { if (wr == 0) PG8_BAR; }
        if constexpr (!Epi::AFTER_DRAIN) { E(acc, cur, wr, wc, fr, fq); S.done(cur); }
        if (!has_next) break;
#pragma unroll
        for (int a = 0; a < 2; ++a)
#pragma unroll
            for (int b = 0; b < 2; ++b)
#pragma unroll
                for (int m = 0; m < 4; ++m)
#pragma unroll
                    for (int n = 0; n < 2; ++n) acc[a][b][m][n] = (f32x4){0.f, 0.f, 0.f, 0.f};
        cur = nxt; cA = nA; cB = nB; ++ui;
        if constexpr (ALIGN_EPI) { if (wr == 1) PG8_BAR; }
    }
    PG8_WAIT_V(0);
    if constexpr (!ALIGN_EPI) { if (wr == 0) PG8_BAR; }
    PG8_BAR;
    if constexpr (Epi::AFTER_DRAIN) { E.fused(acc, cur, wr, wc, fr, fq, lds, wid, lane); S.done(cur); }
#undef PG8_SA
#undef PG8_SB
#undef PG8_STAGE
#undef PG8_LDA
#undef PG8_LDB
#undef PG8_MMA
#undef PG8_WAIT_V
#undef PG8_WAIT_L
#undef PG8_BAR
#undef PG8_SCHED
}
}
namespace pg8 {
struct EpiSwiGLU {
    static constexpr bool PERM = true, AFTER_DRAIN = false;
    bf16_t* O; int ldc;
    __device__ __forceinline__ void operator()(const f32x4 (&acc)[2][2][4][2], const Unit& u, int wr, int wc, int fr, int fq) const {
        const int row0 = u.pm * BM + wr * 64 + fr; const int col0 = u.pn * HALF + wc * 32 + 8 * fq;
#pragma unroll
        for (int ai = 0; ai < 2; ++ai)
#pragma unroll
            for (int m = 0; m < 4; ++m) { bf16_t* rowp = O + (size_t)(row0 + ai * HALF + m * 16) * ldc + col0;
                float v[8];
#pragma unroll
                for (int n = 0; n < 2; ++n)
#pragma unroll
                    for (int i = 0; i < 4; ++i) { const float g = acc[ai][0][m][n][i], up = acc[ai][1][m][n][i];
                        const float sg = g * __builtin_amdgcn_rcpf(1.0f + __builtin_amdgcn_exp2f(-1.4426950408889634f * g)); v[4 * n + i] = sg * up; }
                u32x4 w; w.x = cvt_pk_bf16(v[0], v[1]); w.y = cvt_pk_bf16(v[2], v[3]); w.z = cvt_pk_bf16(v[4], v[5]); w.w = cvt_pk_bf16(v[6], v[7]);
                *(u32x4*)rowp = w; }
    }
};
struct EpiF32 {
    static constexpr bool PERM = true, AFTER_DRAIN = false;
    float* O; int ldc;
    __device__ __forceinline__ void operator()(const f32x4 (&acc)[2][2][4][2], const Unit& u, int wr, int wc, int fr, int fq) const {
        const int row0 = u.pm * BM + wr * 64 + fr; const int col0 = u.pn * BM + wc * 32 + 8 * fq;
#pragma unroll
        for (int ai = 0; ai < 2; ++ai)
#pragma unroll
            for (int m = 0; m < 4; ++m) { float* rowp = O + (size_t)(row0 + ai * HALF + m * 16) * ldc + col0;
#pragma unroll
                for (int bj = 0; bj < 2; ++bj) { *(f32x4*)(rowp + bj * HALF) = acc[ai][bj][m][0]; *(f32x4*)(rowp + bj * HALF + 4) = acc[ai][bj][m][1]; } }
    }
};
struct EpiGlu {
    static constexpr bool PERM = true, AFTER_DRAIN = false;
    bf16_t* O; int ldc; const bf16_t* ys; int ldy; const float* bias;
    __device__ __forceinline__ void operator()(const f32x4 (&acc)[2][2][4][2], const Unit& u, int wr, int wc, int fr, int fq) const {
        const int row0 = u.pm * BM + wr * 64 + fr; const int col0 = u.pn * BM + wc * 32 + 8 * fq;
#pragma unroll
        for (int ai = 0; ai < 2; ++ai)
#pragma unroll
            for (int m = 0; m < 4; ++m) { const int row = row0 + ai * HALF + m * 16;
#pragma unroll
                for (int bj = 0; bj < 2; ++bj) { const int col = col0 + bj * HALF;
                    const u32x4 yp = *(const u32x4*)(ys + (size_t)row * ldy + col);
                    const f32x4 b0 = *(const f32x4*)(bias + col), b1 = *(const f32x4*)(bias + col + 4);
                    const float yv[8] = {__uint_as_float(yp.x << 16), __uint_as_float(yp.x & 0xffff0000u), __uint_as_float(yp.y << 16), __uint_as_float(yp.y & 0xffff0000u),
                                         __uint_as_float(yp.z << 16), __uint_as_float(yp.z & 0xffff0000u), __uint_as_float(yp.w << 16), __uint_as_float(yp.w & 0xffff0000u)};
                    float v[8];
#pragma unroll
                    for (int i = 0; i < 4; ++i) { const float z0 = acc[ai][bj][m][0][i] + b0[i], z1 = acc[ai][bj][m][1][i] + b1[i];
                        v[i] = yv[i] * __builtin_amdgcn_rcpf(1.0f + __builtin_amdgcn_exp2f(-1.4426950408889634f * z0));
                        v[4 + i] = yv[4 + i] * __builtin_amdgcn_rcpf(1.0f + __builtin_amdgcn_exp2f(-1.4426950408889634f * z1)); }
                    u32x4 w; w.x = cvt_pk_bf16(v[0], v[1]); w.y = cvt_pk_bf16(v[2], v[3]); w.z = cvt_pk_bf16(v[4], v[5]); w.w = cvt_pk_bf16(v[6], v[7]);
                    *(u32x4*)(O + (size_t)row * ldc + col) = w; } }
    }
};
struct EpiBf16Plain {
    static constexpr bool PERM = true, AFTER_DRAIN = false;
    bf16_t* O; int ldc;
    __device__ __forceinline__ void operator()(const f32x4 (&acc)[2][2][4][2], const Unit& u, int wr, int wc, int fr, int fq) const {
        const int row0 = u.pm * BM + wr * 64 + fr; const int col0 = u.pn * BM + wc * 32 + 8 * fq;
#pragma unroll
        for (int ai = 0; ai < 2; ++ai)
#pragma unroll
            for (int m = 0; m < 4; ++m) { bf16_t* rowp = O + (size_t)(row0 + ai * HALF + m * 16) * ldc + col0;
#pragma unroll
                for (int bj = 0; bj < 2; ++bj) { const f32x4 v0 = acc[ai][bj][m][0], v1 = acc[ai][bj][m][1];
                    u32x4 w; w.x = cvt_pk_bf16(v0[0], v0[1]); w.y = cvt_pk_bf16(v0[2], v0[3]); w.z = cvt_pk_bf16(v1[0], v1[1]); w.w = cvt_pk_bf16(v1[2], v1[3]);
                    *(u32x4*)(rowp + bj * HALF) = w; } }
    }
};
struct GatedUnit {
    Unit un; unsigned* cnt; unsigned want;
    __device__ __forceinline__ bool next(int i, Unit& u) const { u = un; return i == 0; }
    __device__ __forceinline__ void a_ready(const Unit&) const {
        if (threadIdx.x == 0) { unsigned sp = 0;
            while (__hip_atomic_load(cnt, __ATOMIC_RELAXED, __HIP_MEMORY_SCOPE_AGENT) < want) { __builtin_amdgcn_s_sleep(2); if (++sp > (1u << 22)) break; }
            __builtin_amdgcn_fence(__ATOMIC_ACQUIRE, "agent"); asm volatile("s_waitcnt vmcnt(0)" ::: "memory"); }
        __syncthreads();
    }
    __device__ __forceinline__ void done(const Unit&) const {}
};
}
#include <hip/hip_cooperative_groups.h>
namespace cg = cooperative_groups;
#define LAS __attribute__((address_space(3)))
typedef unsigned short bf16;
typedef float f32x4 __attribute__((ext_vector_type(4)));
typedef float f32x16 __attribute__((ext_vector_type(16)));
typedef short bf16x8 __attribute__((ext_vector_type(8)));
typedef short s16x4 __attribute__((ext_vector_type(4)));
typedef unsigned u32x4 __attribute__((ext_vector_type(4)));
typedef unsigned u32x2 __attribute__((ext_vector_type(2)));
typedef float f32x2_t __attribute__((ext_vector_type(2)));
typedef __bf16 bf16x2_t __attribute__((ext_vector_type(2)));

constexpr int NB = 4, SEQ = 2048, DM = 2048, M = NB * SEQ, FF = 5632, INC = 5120, NLAYER = 2;
constexpr int C_SBQ = 0, C_SBK = 768, C_SBV = 1536, C_U = 2304, C_DQ = 2816, C_DK = 3584, C_DV = 4352;
constexpr int MIX_SB = 0, MIX_SSM = 768, MIX_DIFF = 1280;
constexpr float EPS = 1e-6f;
constexpr float LOG2E = 1.4426950408889634f;
constexpr int NTHREADS = 512, NWAVES = 8;
constexpr int LDS_BYTES = 148480;

constexpr size_t SZ_WGU = (size_t)2 * FF * DM * 2, SZ_WD = (size_t)DM * FF * 2, SZ_WIN = (size_t)INC * DM * 2, SZ_WOUT = (size_t)DM * DM * 2, SZ_WGLU = (size_t)512 * 512 * 2;
constexpr size_t LW_GU1 = 0, LW_D1 = LW_GU1 + SZ_WGU, LW_IN = LW_D1 + SZ_WD, LW_OUT = LW_IN + SZ_WIN, LW_GLU = LW_OUT + SZ_WOUT, LW_GU2 = LW_GLU + SZ_WGLU, LW_D2 = LW_GU2 + SZ_WGU, LW_SIZE = LW_D2 + SZ_WD;
constexpr size_t WS_W = 1u << 20;
constexpr size_t WS_XN = WS_W + NLAYER * LW_SIZE;
constexpr size_t WS_BIG = WS_XN + (size_t)M * DM * 2;
constexpr size_t WS_Y = WS_BIG + (size_t)M * FF * 2;
constexpr size_t WS_MIX = WS_Y + (size_t)M * DM * 4;
constexpr size_t WS_YS = WS_MIX + (size_t)M * DM * 2;
constexpr size_t WS_YSB = WS_YS + (size_t)M * 512 * 4;
constexpr size_t WS_END = WS_YSB + (size_t)M * 512 * 2;

struct Args { const float* in[31]; float* out; unsigned char* ws; };
typedef __attribute__((address_space(4))) const Args* KArgs;
__device__ __forceinline__ KArgs kargs_ptr() { KArgs ap = (KArgs)__builtin_amdgcn_kernarg_segment_ptr(); asm volatile("" : "+s"(ap)); return ap; }
#define IN(k) (kargs_ptr()->in[(k)])

__device__ const unsigned char T5B[128] = {0, 1, 2, 3, 4, 5, 6, 7, 8, 9, 10, 11, 12, 13, 14, 15, 16, 16, 16, 17, 17, 18, 18, 18, 19, 19, 19, 20, 20, 20, 20, 21, 21, 21, 21, 22, 22, 22, 22, 22, 23, 23, 23, 23, 23, 23, 24, 24, 24, 24, 24, 24, 25, 25, 25, 25, 25, 25, 25, 26, 26, 26, 26, 26, 26, 26, 26, 27, 27, 27, 27, 27, 27, 27, 27, 27, 27, 28, 28, 28, 28, 28, 28, 28, 28, 28, 28, 29, 29, 29, 29, 29, 29, 29, 29, 29, 29, 29, 29, 30, 30, 30, 30, 30, 30, 30, 30, 30, 30, 30, 30, 30, 30, 31, 31, 31, 31, 31, 31, 31, 31, 31, 31, 31, 31, 31, 31, 31};

#define LDS_WAIT() asm volatile("s_waitcnt lgkmcnt(0)" ::: "memory")
#define WAVE_SYNC() do { asm volatile("s_waitcnt lgkmcnt(0)" ::: "memory"); __builtin_amdgcn_wave_barrier(); } while (0)
#define MFMA32(a, b, c) __builtin_amdgcn_mfma_f32_32x32x16_bf16((a), (b), (c), 0, 0, 0)
__device__ __forceinline__ unsigned f2bf(float f) { unsigned u = __float_as_uint(f); return (u + 0x7fffu + ((u >> 16) & 1u)) >> 16; }
__device__ __forceinline__ unsigned pk2(float lo, float hi) { return f2bf(lo) | (f2bf(hi) << 16); }
__device__ __forceinline__ unsigned cvtpk(float lo, float hi) { f32x2_t v = {lo, hi}; bf16x2_t b = __builtin_convertvector(v, bf16x2_t); return __builtin_bit_cast(unsigned, b); }
__device__ __forceinline__ float bf2f(unsigned short b) { return __uint_as_float(((unsigned)b) << 16); }
__device__ __forceinline__ float wave_sum(float v) {
#pragma unroll
    for (int o = 1; o < 64; o <<= 1) v += __shfl_xor(v, o);
    return v;
}
__device__ __forceinline__ int crow(int i, int h) { return (i & 3) + 8 * (i >> 2) + 4 * h; }

#define XB_TMO      128
#define XB_XCNT(j)  (256  + 64 * (j))
#define XB_XSUB(j)  (1280 + 64 * (j))
#define XB_XGEN(j)  (2304 + 64 * (j))
#define XB_TOP      3328
#define XB_TOPGEN   3392
#define XCD_BAR_WORDS 3456
#define XB_SPIN_CAP (1u << 18)

__device__ __forceinline__ unsigned xb_ld(unsigned* p)              { return __hip_atomic_load(p, __ATOMIC_RELAXED, __HIP_MEMORY_SCOPE_AGENT); }
__device__ __forceinline__ unsigned xb_add(unsigned* p, unsigned v) { return __hip_atomic_fetch_add(p, v, __ATOMIC_RELAXED, __HIP_MEMORY_SCOPE_AGENT); }
__device__ __forceinline__ unsigned xb_xcc_id() { return (unsigned)__builtin_amdgcn_s_getreg((3 << 11) | 20) & 0xFu; }
#define XB_SPIN(cond, bar) do { unsigned _sp = 0; while (cond) { __builtin_amdgcn_s_sleep(1); \
    if ((++_sp & 255u) == 0u) { if (xb_ld(&(bar)[XB_TMO])) break; if (_sp > XB_SPIN_CAP) { atomicAdd(&(bar)[XB_TMO], 1u); break; } } } } while (0)

struct XcdBarrier {
    unsigned* bar; unsigned x;
    volatile LAS unsigned* st;
};

__device__ __forceinline__ XcdBarrier xcd_barrier_post(unsigned* bar, volatile LAS unsigned* st) {
    XcdBarrier b; b.bar = bar; b.x = xb_xcc_id(); b.st = st;
    if (threadIdx.x == 0) (void)xb_add(&bar[XB_XCNT(b.x)], 1u);
    return b;
}
__device__ __forceinline__ void xcd_barrier_complete(unsigned* bar, unsigned x, unsigned& nloc, unsigned& nx) {
    const unsigned G = gridDim.x * gridDim.y * gridDim.z;
    unsigned sum, cnt, mine, sp = 0u;
    for (;;) {
        sum = 0u; cnt = 0u; mine = 0u;
#pragma unroll
        for (unsigned j = 0; j < 16; ++j) { const unsigned c = xb_ld(&bar[XB_XCNT(j)]); sum += c; cnt += (c > 0u) ? 1u : 0u; mine = (j == x) ? c : mine; }
        if (sum == G) break;
        __builtin_amdgcn_s_sleep(1);
        if ((++sp & 255u) == 0u) { if (xb_ld(&bar[XB_TMO])) break; if (sp > XB_SPIN_CAP) { atomicAdd(&bar[XB_TMO], 1u); break; } }
    }
    nloc = mine > 0u ? mine : 1u; nx = cnt > 0u ? cnt : 1u;
}

__device__ __forceinline__ void xcd_barrier(const XcdBarrier& b) {
    asm volatile("s_waitcnt vmcnt(0)" ::: "memory");
    __syncthreads();
    if (threadIdx.x == 0) {
        unsigned* bar = b.bar;
        __builtin_amdgcn_s_waitcnt(0);
        unsigned nloc = b.st[0], nx = b.st[1];
        if (nloc == 0u) { xcd_barrier_complete(bar, b.x, nloc, nx); b.st[0] = nloc; b.st[1] = nx; }
        const unsigned old = xb_add(&bar[XB_XSUB(b.x)], 1u);
        const unsigned gen = old / nloc;
        if (old + 1u == (gen + 1u) * nloc) {
            __builtin_amdgcn_fence(__ATOMIC_RELEASE, "agent");
            asm volatile("s_waitcnt vmcnt(0)" ::: "memory");
            const unsigned og = xb_add(&bar[XB_TOP], 1u);
            const unsigned tg = og / nx;
            if (og + 1u == (tg + 1u) * nx) xb_add(&bar[XB_TOPGEN], 1u);
            else XB_SPIN(xb_ld(&bar[XB_TOPGEN]) == tg, bar);
            __builtin_amdgcn_fence(__ATOMIC_ACQUIRE, "agent");
            xb_add(&bar[XB_XGEN(b.x)], 1u);
            asm volatile("s_waitcnt vmcnt(0)" ::: "memory");
        } else {
            XB_SPIN(xb_ld(&bar[XB_XGEN(b.x)]) == gen, bar);
            __builtin_amdgcn_fence(__ATOMIC_ACQUIRE, "agent");
            asm volatile("s_waitcnt vmcnt(0)" ::: "memory");
        }
    }
    __syncthreads();
}

__device__ __forceinline__ void transpose_item(const float* __restrict__ W, int K, int N, bf16* WT, int mode, LAS float* scr, int item, int lane) {
    const int nblk = N / 32, kb = item / nblk, nb = item % nblk, k0 = 64 * kb, n0 = 32 * nb;
#pragma unroll 8
    for (int i = 0; i < 32; ++i) { const int kk = 2 * i + (lane >> 5); scr[kk * 33 + (lane & 31)] = __builtin_nontemporal_load(&W[(size_t)(k0 + kk) * N + n0 + (lane & 31)]); }
    LDS_WAIT();
    const int rb = mode == 0 ? n0 : ((n0 >> 7) * 256 + (n0 & 127) + (mode == 2 ? 128 : 0));
    const int c = lane & 7;
#pragma unroll
    for (int j = 0; j < 4; ++j) { const int n = (lane >> 3) + 8 * j; const LAS float* s = scr + (8 * c) * 33 + n;
        u32x4 o; o.x = pk2(s[0 * 33], s[1 * 33]); o.y = pk2(s[2 * 33], s[3 * 33]); o.z = pk2(s[4 * 33], s[5 * 33]); o.w = pk2(s[6 * 33], s[7 * 33]);
        *(u32x4*)(WT + (size_t)(rb + n) * K + k0 + 8 * c) = o; }
    LDS_WAIT();
}

__device__ __forceinline__ void row_pass(const bf16* Y, const float* Hin, float* Hout, bf16* XN, const float* gpost, float wres, const float* gpre, int gw, int ngw, int lane) {
    for (int m = gw; m < M; m += ngw) {
        f32x4 hv[8];
        const f32x4* hr = (const f32x4*)(Hin + (size_t)m * DM) + 2 * lane;
#pragma unroll
        for (int j = 0; j < 4; ++j) { hv[2 * j] = hr[128 * j]; hv[2 * j + 1] = hr[128 * j + 1]; }
        if (Y) {
            f32x4 yv[8]; const u32x4* yr = (const u32x4*)(Y + (size_t)m * DM) + lane; float ss = 0.f;
#pragma unroll
            for (int j = 0; j < 4; ++j) { const u32x4 p = yr[64 * j];
                yv[2 * j] = (f32x4){__uint_as_float(p.x << 16), __uint_as_float(p.x & 0xffff0000u), __uint_as_float(p.y << 16), __uint_as_float(p.y & 0xffff0000u)};
                yv[2 * j + 1] = (f32x4){__uint_as_float(p.z << 16), __uint_as_float(p.z & 0xffff0000u), __uint_as_float(p.w << 16), __uint_as_float(p.w & 0xffff0000u)}; }
#pragma unroll
            for (int j = 0; j < 8; ++j) ss += (yv[j].x * yv[j].x + yv[j].y * yv[j].y) + (yv[j].z * yv[j].z + yv[j].w * yv[j].w);
            ss = wave_sum(ss);
            const float rstd = wres / sqrtf(ss * (1.0f / DM) + EPS);
#pragma unroll
            for (int j = 0; j < 4; ++j) { const f32x4 g0 = ((const f32x4*)gpost)[2 * lane + 128 * j], g1 = ((const f32x4*)gpost)[2 * lane + 128 * j + 1];
                hv[2 * j] = hv[2 * j] + yv[2 * j] * g0 * rstd; hv[2 * j + 1] = hv[2 * j + 1] + yv[2 * j + 1] * g1 * rstd; }
        }
        if (Hout) { f32x4* ho = (f32x4*)(Hout + (size_t)m * DM) + 2 * lane;
#pragma unroll
            for (int j = 0; j < 4; ++j) { ho[128 * j] = hv[2 * j]; ho[128 * j + 1] = hv[2 * j + 1]; } }
        if (gpre) {
            float s2 = 0.f;
#pragma unroll
            for (int j = 0; j < 8; ++j) s2 += (hv[j].x * hv[j].x + hv[j].y * hv[j].y) + (hv[j].z * hv[j].z + hv[j].w * hv[j].w);
            s2 = wave_sum(s2);
            const float r2 = 1.0f / sqrtf(s2 * (1.0f / DM) + EPS);
            u32x4* xo = (u32x4*)(XN + (size_t)m * DM) + lane;
#pragma unroll
            for (int j = 0; j < 4; ++j) { const f32x4 g0 = ((const f32x4*)gpre)[2 * lane + 128 * j], g1 = ((const f32x4*)gpre)[2 * lane + 128 * j + 1];
                const f32x4 v0 = hv[2 * j] * g0 * r2, v1 = hv[2 * j + 1] * g1 * r2; u32x4 o; o.x = pk2(v0.x, v0.y); o.y = pk2(v0.z, v0.w); o.z = pk2(v1.x, v1.y); o.w = pk2(v1.z, v1.w); xo[64 * j] = o; }
        }
    }
}

constexpr int KP = 272, VP = 320;
constexpr int KBYTES = 64 * KP, VBYTES = 64 * VP;
constexpr int A_K = 0, A_V = 2 * KBYTES, A_BIAS = A_V + 2 * VBYTES, A_FLAG = A_BIAS + 1024, A_Q = A_FLAG + 1024, A_END = A_Q + 8 * 32 * KP;

__device__ __forceinline__ void tile_prefetch(u32x4 (&rg)[2], const bf16* g, int tid) {
#pragma unroll
    for (int i = 0; i < 2; ++i) { const int chunk = tid + 512 * i, row = chunk >> 4, ch = chunk & 15; rg[i] = *(const u32x4*)(g + (size_t)row * INC + ch * 8); }
}
__device__ __forceinline__ void tile_store(LAS char* dst, int pitch, const u32x4 (&rg)[2], int tid) {
#pragma unroll
    for (int i = 0; i < 2; ++i) { const int chunk = tid + 512 * i, row = chunk >> 4, ch = chunk & 15; *(LAS u32x4*)(dst + row * pitch + ch * 16) = rg[i]; }
}
__device__ __forceinline__ void pv_half(f32x16 (&o)[4], const LAS char* Vb, int kh, bf16x8 P0, bf16x8 P1, int lane) {
    const int h = lane >> 5, i16 = lane & 15, qq = i16 >> 2, p = i16 & 3, blk = (lane >> 4) & 1;
    const LAS char* vb = Vb + (32 * kh + 4 * h + qq) * VP + (16 * blk + 4 * p) * 2;
#pragma unroll
    for (int s2 = 0; s2 < 2; ++s2)
#pragma unroll
        for (int db = 0; db < 4; ++db) {
            const s16x4 lo = __builtin_bit_cast(s16x4, __builtin_amdgcn_ds_read_tr16_b64_v4i16((LAS s16x4*)(vb + (16 * s2) * VP + db * 64)));
            const s16x4 hi = __builtin_bit_cast(s16x4, __builtin_amdgcn_ds_read_tr16_b64_v4i16((LAS s16x4*)(vb + (16 * s2 + 8) * VP + db * 64)));
            const bf16x8 vf = __builtin_shufflevector(lo, hi, 0, 1, 2, 3, 4, 5, 6, 7);
            o[db] = MFMA32(vf, s2 == 0 ? P0 : P1, o[db]);
        }
}

#ifndef SB_DONE
#define SB_DONE (-50.0f)
#endif
__device__ __forceinline__ void sb_unit(LAS char* lds, const bf16* PROJ, bf16* MIX, int b, int hd, int qb) {
    int tid_o = threadIdx.x; asm volatile("" : "+v"(tid_o)); const int tid = tid_o, lane = tid & 63, r = lane & 31, h = lane >> 5, w = __builtin_amdgcn_readfirstlane(tid >> 6);
    const int q0 = qb * 256, qw = q0 + 32 * w, q = qw + r;
    const size_t rowb = (size_t)b * SEQ;
    const float SCALE = 0.08838834764831845f;
    bf16x8 qf[8];
    { const bf16* Qg = PROJ + (rowb + q) * INC + C_SBQ + hd * 128 + 8 * h;
#pragma unroll
      for (int s = 0; s < 8; ++s) qf[s] = *(const bf16x8*)(Qg + 16 * s); }
    const bf16* Kg = PROJ + rowb * INC + C_SBK + hd * 128; const bf16* Vg = PROJ + rowb * INC + C_SBV + hd * 128;
    f32x16 o[4];
#pragma unroll
    for (int d = 0; d < 4; ++d)
#pragma unroll
        for (int i = 0; i < 16; ++i) o[d][i] = 0.f;
    float R = 0.f; bool wdone = false;
    const int kt_hi = (q0 + 255) >> 6;
    volatile LAS int* flags = (volatile LAS int*)(lds + A_FLAG);
    u32x4 kr[2], vr[2];
    tile_prefetch(kr, Kg + (size_t)(kt_hi * 64) * INC, tid); tile_prefetch(vr, Vg + (size_t)(kt_hi * 64) * INC, tid);
    int it = 0;
    for (int kt = kt_hi; kt >= 0; --kt, ++it) {
        const int buf = it & 1;
        LAS char* Kb = lds + A_K + buf * KBYTES; LAS char* Vb = lds + A_V + buf * VBYTES;
        tile_store(Kb, KP, kr, tid); tile_store(Vb, VP, vr, tid);
        __syncthreads();
        if (it > 0) { int alld = 1;
#pragma unroll
            for (int ww = 0; ww < 8; ++ww) alld &= flags[((it - 1) & 1) * 8 + ww];
            if (alld) break; }
        if (kt > 0) { tile_prefetch(kr, Kg + (size_t)((kt - 1) * 64) * INC, tid); tile_prefetch(vr, Vg + (size_t)((kt - 1) * 64) * INC, tid); }
        const int k0 = kt * 64;
        if (k0 < qw + 31 && !wdone) {
#pragma unroll
            for (int kh = 1; kh >= 0; --kh) {
                f32x16 c;
#pragma unroll
                for (int i = 0; i < 16; ++i) c[i] = 0.f;
                const LAS char* kp = Kb + (32 * kh + r) * KP + 16 * h;
#pragma unroll
                for (int s = 0; s < 8; ++s) { const bf16x8 kf = *(const LAS bf16x8*)(kp + 32 * s); c = MFMA32(kf, qf[s], c); }
                const int keyb = k0 + 32 * kh + 4 * h;
                float lk[16], lb[16], gs[4], og[4];
#pragma unroll
                for (int i = 0; i < 16; ++i) { const int key = keyb + (i & 3) + 8 * (i >> 2); const float z = c[i] * SCALE;
                    const float e = __expf(-fabsf(z)); const float ls = fminf(z, 0.f) - __logf(1.0f + e);
                    lb[i] = ls; lk[i] = (key < q) ? (ls - z) : 0.f; }
#pragma unroll
                for (int g = 0; g < 4; ++g) { gs[g] = (lk[4 * g] + lk[4 * g + 1]) + (lk[4 * g + 2] + lk[4 * g + 3]); og[g] = __shfl_xor(gs[g], 32); }
                const float sg = (gs[0] + gs[1]) + (gs[2] + gs[3]), so = (og[0] + og[1]) + (og[2] + og[3]);
                float after[4];
                after[3] = (h ? 0.f : og[3]);
                after[2] = gs[3] + og[3] + (h ? 0.f : og[2]);
                after[1] = gs[3] + gs[2] + og[3] + og[2] + (h ? 0.f : og[1]);
                after[0] = gs[3] + gs[2] + gs[1] + og[3] + og[2] + og[1] + (h ? 0.f : og[0]);
                float wv[16];
#pragma unroll
                for (int g = 0; g < 4; ++g) { const float base = R + after[g];
                    const float s3 = 0.f, s2 = lk[4 * g + 3], s1 = s2 + lk[4 * g + 2], s0 = s1 + lk[4 * g + 1];
                    const float bt[4] = {s0, s1, s2, s3};
#pragma unroll
                    for (int j = 0; j < 4; ++j) { const int i = 4 * g + j; const int key = keyb + j + 8 * g;
                        wv[i] = (key < q) ? __expf(lb[i] + base + bt[j]) : 0.f; } }
                R += sg + so;
                u32x4 p0, p1;
                p0.x = cvtpk(wv[0], wv[1]); p0.y = cvtpk(wv[2], wv[3]); p0.z = cvtpk(wv[4], wv[5]); p0.w = cvtpk(wv[6], wv[7]);
                p1.x = cvtpk(wv[8], wv[9]); p1.y = cvtpk(wv[10], wv[11]); p1.z = cvtpk(wv[12], wv[13]); p1.w = cvtpk(wv[14], wv[15]);
                pv_half(o, Vb, kh, __builtin_bit_cast(bf16x8, p0), __builtin_bit_cast(bf16x8, p1), lane);
            }
            wdone = __all(R < SB_DONE);
        }
        if (lane == 0) flags[(it & 1) * 8 + w] = wdone ? 1 : 0;
    }
    bf16* Og = MIX + (rowb + q) * DM + MIX_SB + hd * 128 + 4 * h;
#pragma unroll
    for (int db = 0; db < 4; ++db)
#pragma unroll
        for (int g = 0; g < 4; ++g) { u32x2 ov; ov.x = cvtpk(o[db][4 * g], o[db][4 * g + 1]); ov.y = cvtpk(o[db][4 * g + 2], o[db][4 * g + 3]); *(u32x2*)(Og + 32 * db + 8 * g) = ov; }
    __syncthreads();
}

__device__ __forceinline__ f32x16 diff_qk(const LAS char* kp, const LAS char* qp) {
    f32x16 c;
#pragma unroll
    for (int i = 0; i < 16; ++i) c[i] = 0.f;
#pragma unroll
    for (int s = 0; s < 4; ++s) { const bf16x8 kf = *(const LAS bf16x8*)(kp + 32 * s); const bf16x8 qf = *(const LAS bf16x8*)(qp + 32 * s); c = MFMA32(kf, qf, c); }
    return c;
}
__device__ __forceinline__ void diff_sm(f32x16& c, bool far, float bfar, const LAS float* bt, int q, int keyb, float& m, float& l, f32x16 (&o)[4], bf16x8& P0, bf16x8& P1) {
    const float SC2 = 0.125f * LOG2E;
    if (!far) {
#pragma unroll
        for (int i = 0; i < 16; ++i) { const int key = keyb + (i & 3) + 8 * (i >> 2); const int n = q - key; const int ni = n < 0 ? 0 : (n > 128 ? 128 : n);
            c[i] = (n < 0) ? -INFINITY : (c[i] * SC2 + bt[ni]); }
    }
    float mx = fmaxf(fmaxf(c[0], c[1]), c[2]);
#pragma unroll
    for (int i = 3; i < 15; i += 2) mx = fmaxf(fmaxf(mx, c[i]), c[i + 1]);
    mx = fmaxf(mx, c[15]);
    if (far) mx = mx * SC2 + bfar;
    mx = fmaxf(mx, __shfl_xor(mx, 32));
    const float mnew = fmaxf(m, mx);
    if (__any(mx > m + 8.0f)) {
        const float sc = __builtin_amdgcn_exp2f(m - mnew); l *= sc;
#pragma unroll
        for (int d = 0; d < 4; ++d)
#pragma unroll
            for (int i = 0; i < 16; ++i) o[d][i] *= sc;
        m = mnew;
    }
    const float mul = far ? SC2 : 1.0f, add = (far ? bfar : 0.f) - m;
#pragma unroll
    for (int i = 0; i < 16; ++i) c[i] = __builtin_amdgcn_exp2f(c[i] * mul + add);
    l += ((c[0] + c[1]) + (c[2] + c[3])) + ((c[4] + c[5]) + (c[6] + c[7])) + (((c[8] + c[9]) + (c[10] + c[11])) + ((c[12] + c[13]) + (c[14] + c[15])));
    u32x4 p0, p1;
    p0.x = cvtpk(c[0], c[1]); p0.y = cvtpk(c[2], c[3]); p0.z = cvtpk(c[4], c[5]); p0.w = cvtpk(c[6], c[7]);
    p1.x = cvtpk(c[8], c[9]); p1.y = cvtpk(c[10], c[11]); p1.z = cvtpk(c[12], c[13]); p1.w = cvtpk(c[14], c[15]);
    P0 = __builtin_bit_cast(bf16x8, p0); P1 = __builtin_bit_cast(bf16x8, p1);
}
__device__ __forceinline__ void diff_unit(LAS char* lds, const bf16* PROJ, bf16* MIX, const float* relb, float lam, float outscale, const float* subg, int b, int hd, int qb) {
    int tid_o = threadIdx.x; asm volatile("" : "+v"(tid_o)); const int tid = tid_o, lane = tid & 63, r = lane & 31, h = lane >> 5, w = __builtin_amdgcn_readfirstlane(tid >> 6);
    const int rg = w & 3, kh = w >> 2;
    const int q0 = qb * 128, qw = q0 + 32 * rg, q = qw + r;
    const size_t rowb = (size_t)b * SEQ;
    LAS float* bt = (LAS float*)(lds + A_BIAS);
    if (tid < 129) { const int bucket = tid < 128 ? (int)T5B[tid] : 31; bt[tid] = relb[bucket * 6 + hd] * LOG2E; }
    LAS char* qp = lds + A_Q + w * (32 * KP) + r * KP + 16 * h;
    { const bf16* Qg = PROJ + (rowb + q) * INC + C_DQ + hd * 128 + 8 * h;
#pragma unroll
      for (int s = 0; s < 8; ++s) *(LAS u32x4*)(qp + 32 * s) = *(const u32x4*)(Qg + 16 * s); }
    const bf16* Kg = PROJ + rowb * INC + C_DK + hd * 128; const bf16* Vg = PROJ + rowb * INC + C_DV + hd * 128;
    float m1 = -1e30f, m2 = -1e30f, l1 = 0.f, l2 = 0.f;
    f32x16 o1[4], o2[4];
#pragma unroll
    for (int d = 0; d < 4; ++d)
#pragma unroll
        for (int i = 0; i < 16; ++i) { o1[d][i] = 0.f; o2[d][i] = 0.f; }
    const int nt = ((q0 + 127) >> 6) + 1;
    u32x4 kr[2], vr[2];
    tile_prefetch(kr, Kg, tid); tile_prefetch(vr, Vg, tid);
#pragma unroll 1
    for (int kt = 0; kt < nt; ++kt) {
        const int buf = kt & 1;
        LAS char* Kb = lds + A_K + buf * KBYTES; LAS char* Vb = lds + A_V + buf * VBYTES;
        tile_store(Kb, KP, kr, tid); tile_store(Vb, VP, vr, tid);
        __syncthreads();
        if (kt + 1 < nt) { tile_prefetch(kr, Kg + (size_t)((kt + 1) * 64) * INC, tid); tile_prefetch(vr, Vg + (size_t)((kt + 1) * 64) * INC, tid); }
        const int k0 = kt * 64;
        if (k0 + 32 * kh <= qw + 31) {
            const bool far = (qw - (k0 + 63)) >= 128; const float bfar = bt[128];
            const LAS char* kp = Kb + (32 * kh + r) * KP + 16 * h;
            const int keyb = k0 + 32 * kh + 4 * h;
            bf16x8 Pa, Pb, Pc, Pd;
            f32x16 c1 = diff_qk(kp, qp), c2 = diff_qk(kp + 128, qp + 128);
            diff_sm(c1, far, bfar, bt, q, keyb, m1, l1, o1, Pa, Pb);
            pv_half(o1, Vb, kh, Pa, Pb, lane);
            diff_sm(c2, far, bfar, bt, q, keyb, m2, l2, o2, Pc, Pd);
            pv_half(o2, Vb, kh, Pc, Pd, lane);
            __builtin_amdgcn_sched_barrier(0);
        }
    }
    l1 += __shfl_xor(l1, 32); l2 += __shfl_xor(l2, 32);
    __syncthreads();
    LAS float* EX = (LAS float*)(lds + rg * 16384) + lane;
    LAS float* ST = (LAS float*)(lds + 65536 + rg * 1024) + lane;
    if (kh == 1) { ST[0] = m1; ST[64] = l1; ST[128] = m2; ST[192] = l2;
#pragma unroll
        for (int d = 0; d < 4; ++d)
#pragma unroll
            for (int i = 0; i < 16; ++i) EX[(16 * d + i) * 64] = o1[d][i]; }
    __syncthreads();
    float f2a = 1.f, f2b = 0.f;
    if (kh == 0) {
        const float mb1 = ST[0], lb1 = ST[64], mb2 = ST[128], lb2 = ST[192];
        const float mn1 = fmaxf(m1, mb1), fa = __builtin_amdgcn_exp2f(m1 - mn1), fb = __builtin_amdgcn_exp2f(mb1 - mn1);
        l1 = l1 * fa + lb1 * fb;
#pragma unroll
        for (int d = 0; d < 4; ++d)
#pragma unroll
            for (int i = 0; i < 16; ++i) o1[d][i] = o1[d][i] * fa + EX[(16 * d + i) * 64] * fb;
        const float mn2 = fmaxf(m2, mb2); f2a = __builtin_amdgcn_exp2f(m2 - mn2); f2b = __builtin_amdgcn_exp2f(mb2 - mn2);
        l2 = l2 * f2a + lb2 * f2b;
    }
    __syncthreads();
    if (kh == 1) {
#pragma unroll
        for (int d = 0; d < 4; ++d)
#pragma unroll
            for (int i = 0; i < 16; ++i) EX[(16 * d + i) * 64] = o2[d][i]; }
    __syncthreads();
    if (kh == 0) {
        const float inv1 = 1.0f / l1, inv2 = lam / l2;
        float ss = 0.f;
#pragma unroll
        for (int db = 0; db < 4; ++db)
#pragma unroll
            for (int i = 0; i < 16; ++i) { const float v2 = o2[db][i] * f2a + EX[(16 * db + i) * 64] * f2b; const float v = o1[db][i] * inv1 - v2 * inv2; o1[db][i] = v; ss += v * v; }
        ss += __shfl_xor(ss, 32);
        const float rs = outscale / sqrtf(ss * (1.0f / 128.0f) + EPS);
        bf16* Og = MIX + (rowb + q) * DM + MIX_DIFF + hd * 128 + 4 * h;
#pragma unroll
        for (int db = 0; db < 4; ++db)
#pragma unroll
            for (int g = 0; g < 4; ++g) { const f32x4 gg = *(const f32x4*)(subg + 32 * db + 8 * g + 4 * h);
                u32x2 ov; ov.x = cvtpk(o1[db][4 * g] * rs * gg.x, o1[db][4 * g + 1] * rs * gg.y); ov.y = cvtpk(o1[db][4 * g + 2] * rs * gg.z, o1[db][4 * g + 3] * rs * gg.w); *(u32x2*)(Og + 32 * db + 8 * g) = ov; }
    }
    __syncthreads();
}

constexpr int S_E = 0, S_XT = 16384, S_XTB = 32 * KP;
__device__ __forceinline__ float gelu_tanh(float y) {
    const float a = 0.7978845608028654f * (y + 0.044715f * y * y * y);
    const float t = 1.0f - 2.0f / (__expf(2.0f * a) + 1.0f);
    return 0.5f * y * (1.0f + t);
}
#define SSM_BU(uf_) \
    f32x16 a_re, b_re, a_im, b_im; \
    { f32x16 z; _Pragma("unroll") for (int i = 0; i < 16; ++i) z[i] = 0.f; \
      a_re = MFMA32(uf_, bfrag[0], z); b_re = MFMA32(uf_, bfrag[1], z); a_im = MFMA32(uf_, bfrag[2], z); b_im = MFMA32(uf_, bfrag[3], z); \
      _Pragma("unroll") for (int i = 0; i < 16; ++i) { \
          auto s1 = __builtin_amdgcn_permlane32_swap(__float_as_uint(a_re[i]), __float_as_uint(b_re[i]), false, false); a_re[i] = __uint_as_float(s1[0]); b_re[i] = __uint_as_float(s1[1]); \
          auto s2 = __builtin_amdgcn_permlane32_swap(__float_as_uint(a_im[i]), __float_as_uint(b_im[i]), false, false); a_im[i] = __uint_as_float(s2[0]); b_im[i] = __uint_as_float(s2[1]); } }
#define SSM_ADV(bur_, bui_) do { const float nxr = lr * xr - li * xi + (bur_), nxi = lr * xi + li * xr + (bui_); xr = nxr; xi = nxi; } while (0)
__device__ __forceinline__ void ssm_unit(LAS char* lds, int l, const bf16* PROJ, bf16* YSB, int b, int g, unsigned* done_cnt) {
    int tid_o = threadIdx.x; asm volatile("" : "+v"(tid_o)); const int tid = tid_o, lane = tid & 63, r = lane & 31, h = lane >> 5, w = __builtin_amdgcn_readfirstlane(tid >> 6);
    const int lg = l * 32 + g;
    const size_t rowb = (size_t)b * SEQ;
    LAS float* E = (LAS float*)(lds + S_E);
    LAS char* XT = lds + S_XT + w * S_XTB;
    const int trow = 16 * ((r >> 2) & 1) + (r & 3) + 4 * (r >> 3);
    const float ar = IN(8)[lg * 64 + lane], ai = IN(9)[lg * 64 + lane], dt = expf(IN(10)[lg]);
    const float mag = expf(ar * dt); const float lr = mag * cosf(ai * dt), li = mag * sinf(ai * dt);
    const float den = ar * ar + ai * ai;
    const float fr = ((lr - 1.0f) * ar + li * ai) / den, fi = (li * ar - (lr - 1.0f) * ai) / den;
    bf16x8 bfrag[4];
    { float bbr[16], bbi[16], pbr[16], pbi[16];
      const f32x4* br4 = (const f32x4*)(IN(11) + ((size_t)lg * 64 + lane) * 16); const f32x4* bi4 = (const f32x4*)(IN(12) + ((size_t)lg * 64 + lane) * 16);
#pragma unroll
      for (int j = 0; j < 4; ++j) { const f32x4 br = br4[j], bi = bi4[j];
#pragma unroll
          for (int e = 0; e < 4; ++e) { bbr[4 * j + e] = fr * br[e] - fi * bi[e]; bbi[4 * j + e] = fr * bi[e] + fi * br[e]; } }
#pragma unroll
      for (int c = 0; c < 16; ++c) { pbr[c] = __shfl_xor(bbr[c], 32); pbi[c] = __shfl_xor(bbi[c], 32); }
#pragma unroll
      for (int nb = 0; nb < 4; ++nb) { const bool own = ((nb & 1) == h); float v[8];
#pragma unroll
          for (int j = 0; j < 8; ++j) { const float o_ = (nb < 2) ? (h ? bbr[8 + j] : bbr[j]) : (h ? bbi[8 + j] : bbi[j]); const float p_ = (nb < 2) ? (h ? pbr[8 + j] : pbr[j]) : (h ? pbi[8 + j] : pbi[j]); v[j] = own ? o_ : p_; }
          u32x4 pk; pk.x = cvtpk(v[0], v[1]); pk.y = cvtpk(v[2], v[3]); pk.z = cvtpk(v[4], v[5]); pk.w = cvtpk(v[6], v[7]); bfrag[nb] = __builtin_bit_cast(bf16x8, pk); } }
    bf16x8 cmf[9];
#pragma unroll
    for (int s = 0; s < 8; ++s) { u32x4 pk = {0u, 0u, 0u, 0u};
        if (r < 16) { const float* src = (s < 4 ? IN(13) : IN(14)) + ((size_t)lg * 16 + r) * 64 + 16 * (s & 3) + 8 * h; const float sg = s < 4 ? 1.0f : -1.0f;
            const f32x4 a = *(const f32x4*)src * sg, c = *(const f32x4*)(src + 4) * sg;
            pk.x = cvtpk(a.x, a.y); pk.y = cvtpk(a.z, a.w); pk.z = cvtpk(c.x, c.y); pk.w = cvtpk(c.z, c.w); }
        cmf[s] = __builtin_bit_cast(bf16x8, pk); }
    { const float dsk = IN(15)[lg * 16 + (r & 15)]; float v[8];
#pragma unroll
      for (int j = 0; j < 8; ++j) v[j] = (r < 16 && (8 * h + j) == r) ? dsk : 0.f;
      u32x4 pk; pk.x = cvtpk(v[0], v[1]); pk.y = cvtpk(v[2], v[3]); pk.z = cvtpk(v[4], v[5]); pk.w = cvtpk(v[6], v[7]); cmf[8] = __builtin_bit_cast(bf16x8, pk); }
    float l64r = lr, l64i = li;
#pragma unroll
    for (int s = 0; s < 6; ++s) { const float nr = l64r * l64r - l64i * l64i, ni = 2.0f * l64r * l64i; l64r = nr; l64i = ni; }
#define SSM_UADDR(bi_) (PROJ + (rowb + 64 * (w + 8 * ((bi_) >> 1)) + 32 * ((bi_) & 1) + trow) * INC + C_U + g * 16 + 8 * h)
    {
        bf16x8 ufc = *(const bf16x8*)SSM_UADDR(0);
        float xr = 0.f, xi = 0.f;
#pragma unroll 1
        for (int bi = 0; bi < 8; ++bi) {
            const bf16x8 ufn = *(const bf16x8*)SSM_UADDR(bi < 7 ? bi + 1 : 7);
            SSM_BU(ufc)
#pragma unroll
            for (int i = 0; i < 16; ++i) SSM_ADV(a_re[i], a_im[i]);
#pragma unroll
            for (int i = 0; i < 16; ++i) SSM_ADV(b_re[i], b_im[i]);
            if (bi & 1) { const int k = w + 8 * (bi >> 1); E[k * 128 + lane] = xr; E[k * 128 + 64 + lane] = xi; xr = 0.f; xi = 0.f; }
            ufc = ufn;
        }
    }
    __syncthreads();
    LAS char* xw = XT + 2 * lane;
    const LAS char* xrd = XT + r * KP + 16 * h;
    {
        float cr = 0.f, ci = 0.f;
#pragma unroll 1
        for (int k = 0; k < w; ++k) { const float er = E[k * 128 + lane], ei = E[k * 128 + 64 + lane]; const float nr = l64r * cr - l64i * ci + er, ni = l64r * ci + l64i * cr + ei; cr = nr; ci = ni; }
        bf16x8 ufc = *(const bf16x8*)SSM_UADDR(0);
        float xr = cr, xi = ci;
#pragma unroll 1
        for (int bi = 0; bi < 8; ++bi) {
            const bf16x8 ufn = *(const bf16x8*)SSM_UADDR(bi < 7 ? bi + 1 : 7);
            const size_t row0 = rowb + 64 * (w + 8 * (bi >> 1)) + 32 * (bi & 1);
            { SSM_BU(ufc)
#pragma unroll
              for (int i = 0; i < 16; ++i) { SSM_ADV(a_re[i], a_im[i]); const unsigned pk = cvtpk(xr, xi); const int rho = 8 * (i >> 2) + (i & 3);
                  *(LAS unsigned short*)(xw + rho * KP) = (unsigned short)pk; *(LAS unsigned short*)(xw + rho * KP + 128) = (unsigned short)(pk >> 16); }
#pragma unroll
              for (int i = 0; i < 16; ++i) { SSM_ADV(b_re[i], b_im[i]); const unsigned pk = cvtpk(xr, xi); const int rho = 8 * (i >> 2) + 4 + (i & 3);
                  *(LAS unsigned short*)(xw + rho * KP) = (unsigned short)pk; *(LAS unsigned short*)(xw + rho * KP + 128) = (unsigned short)(pk >> 16); } }
            WAVE_SYNC();
            f32x16 y;
#pragma unroll
            for (int i = 0; i < 16; ++i) y[i] = 0.f;
            y = MFMA32(cmf[8], ufc, y);
#pragma unroll
            for (int s = 0; s < 8; ++s) { const bf16x8 xa = *(const LAS bf16x8*)(xrd + 32 * s); y = MFMA32(cmf[s], xa, y); }
            {
                bf16* yo = YSB + (row0 + trow) * 512 + g * 16 + 4 * h;
                u32x2 w0, w1;
                w0.x = pk2(gelu_tanh(y[0]), gelu_tanh(y[1])); w0.y = pk2(gelu_tanh(y[2]), gelu_tanh(y[3]));
                w1.x = pk2(gelu_tanh(y[4]), gelu_tanh(y[5])); w1.y = pk2(gelu_tanh(y[6]), gelu_tanh(y[7]));
                *(u32x2*)yo = w0; *(u32x2*)(yo + 8) = w1;
            }
            WAVE_SYNC();
            if ((bi & 1) && bi < 7) {
                const int k0c = w + 8 * (bi >> 1);
#pragma unroll 1
                for (int k = k0c; k < k0c + 8; ++k) { const float er = E[k * 128 + lane], ei = E[k * 128 + 64 + lane]; const float nr = l64r * cr - l64i * ci + er, ni = l64r * ci + l64i * cr + ei; cr = nr; ci = ni; }
                xr = cr; xi = ci;
            }
            ufc = ufn;
        }
    }
    asm volatile("s_waitcnt vmcnt(0)" ::: "memory");
    __syncthreads();
    if (tid == 0) { __builtin_amdgcn_fence(__ATOMIC_RELEASE, "agent"); asm volatile("s_waitcnt vmcnt(0)" ::: "memory"); __hip_atomic_fetch_add(done_cnt, 1u, __ATOMIC_RELAXED, __HIP_MEMORY_SCOPE_AGENT); }
}
#undef SSM_UADDR
#undef SSM_BU
#undef SSM_ADV
constexpr int I_G = (DM / 64) * (FF / 32), I_D = (FF / 64) * (DM / 32), I_IN = (DM / 64) * (INC / 32), I_OUT = (DM / 64) * (DM / 32), I_GLU = (512 / 64) * (512 / 32);
constexpr int CV_PER_LAYER = 4 * I_G + 2 * I_D + I_IN + I_OUT + I_GLU, CV_TOTAL = NLAYER * CV_PER_LAYER;
static_assert(CV_TOTAL % 8 == 0 && (2 * I_G) % 8 == 0, "batches of 8");
__device__ __forceinline__ void convert_item(int it, unsigned char* wsb, LAS float* scr, int lane) {
    const int l = it / CV_PER_LAYER; int r = it % CV_PER_LAYER;
    unsigned char* lw0 = wsb + WS_W + (size_t)l * LW_SIZE;
    if (r < I_G) { transpose_item(IN(2) + (size_t)l * DM * FF, DM, FF, (bf16*)(lw0 + LW_GU1), 1, scr, r, lane); return; } r -= I_G;
    if (r < I_G) { transpose_item(IN(3) + (size_t)l * DM * FF, DM, FF, (bf16*)(lw0 + LW_GU1), 2, scr, r, lane); return; } r -= I_G;
    if (r < I_D) { transpose_item(IN(4) + (size_t)l * FF * DM, FF, DM, (bf16*)(lw0 + LW_D1), 0, scr, r, lane); return; } r -= I_D;
    if (r < I_IN) { transpose_item(IN(7) + (size_t)l * DM * INC, DM, INC, (bf16*)(lw0 + LW_IN), 0, scr, r, lane); return; } r -= I_IN;
    if (r < I_OUT) { transpose_item(IN(24) + (size_t)l * DM * DM, DM, DM, (bf16*)(lw0 + LW_OUT), 0, scr, r, lane); return; } r -= I_OUT;
    if (r < I_GLU) { transpose_item(IN(16) + (size_t)l * 512 * 512, 512, 512, (bf16*)(lw0 + LW_GLU), 0, scr, r, lane); return; } r -= I_GLU;
    if (r < I_G) { transpose_item(IN(27) + (size_t)l * DM * FF, DM, FF, (bf16*)(lw0 + LW_GU2), 1, scr, r, lane); return; } r -= I_G;
    if (r < I_G) { transpose_item(IN(28) + (size_t)l * DM * FF, DM, FF, (bf16*)(lw0 + LW_GU2), 2, scr, r, lane); return; } r -= I_G;
    transpose_item(IN(29) + (size_t)l * FF * DM, FF, DM, (bf16*)(lw0 + LW_D2), 0, scr, r, lane);
}
__device__ __forceinline__ void convert_static(int start, int end, int b0, int nb, unsigned char* wsb, LAS unsigned char* lds) {
    const int ib = (int)blockIdx.x - b0; if (ib < 0 || ib >= nb) return;
    int tid_o = threadIdx.x; asm volatile("" : "+v"(tid_o)); const int lane = tid_o & 63, wave = __builtin_amdgcn_readfirstlane(tid_o >> 6);
    LAS float* scr = (LAS float*)(lds + wave * 16384);
#pragma unroll 1
    for (int it = start + ib * NWAVES + wave; it < end; it += nb * NWAVES) convert_item(it, wsb, scr, lane);
}
__device__ __forceinline__ void convert_batch64(int c0, unsigned char* wsb, LAS unsigned char* lds) {
    int tid_o = threadIdx.x; asm volatile("" : "+v"(tid_o)); const int lane = tid_o & 63, wave = __builtin_amdgcn_readfirstlane(tid_o >> 6);
    LAS float* scr = (LAS float*)(lds + wave * 16384);
#pragma unroll 1
    for (int j = 0; j < 8; ++j) convert_item(c0 + 8 * wave + j, wsb, scr, lane);
}
#ifndef CV_UPFRONT
#define CV_UPFRONT 1
#endif
#if CV_UPFRONT
constexpr int CV_P0_END = CV_TOTAL, CV_A_END = CV_TOTAL, CV_B_END = CV_TOTAL, CV_M_END = CV_TOTAL, CV_MB = 0;
#else
constexpr int CV_P0_END = 2 * I_G;
constexpr int CV_A_END = 4 * I_G + I_D + I_IN + I_OUT + I_GLU - 2 * I_G + 2048;
constexpr int CV_B_END = CV_PER_LAYER;
constexpr int CV_M_END = CV_PER_LAYER + 2 * I_G + I_D + I_IN + I_OUT + I_GLU;
constexpr int CV_MB = (CV_M_END - CV_B_END) / 64;
#endif
static_assert((CV_M_END - CV_B_END) % 64 == 0, "mixer-phase conversion batches");
#ifndef PHASE_MASK
#define PHASE_MASK 0xFFFF
#endif
#define PH(k) if constexpr (((PHASE_MASK) >> (k)) & 1)
#ifndef MK_SYNC
#define MK_SYNC() do { XcdBarrier xb_; xb_.bar = (unsigned*)ws + 1024; xb_.x = xb_xcc_id(); xb_.st = (volatile LAS unsigned*)(lds + LDS_BYTES - 32); xcd_barrier(xb_); } while (0)
#endif
#ifndef CV_P0_LIM
#define CV_P0_LIM (2 * I_G)
#endif
#ifndef CV_LIM_GU1
#define CV_LIM_GU1 32000
#endif
#ifndef CV_LIM_WIN
#define CV_LIM_WIN 52000
#endif
#ifndef CV_LIM_MIX
#define CV_LIM_MIX 64000
#endif
__global__ void __launch_bounds__(NTHREADS, 2) fwd_megakernel(Args args) {
    extern __shared__ __attribute__((aligned(16))) unsigned char lds_raw[];
    cg::grid_group grid = cg::this_grid();
    LAS unsigned char* lds = (LAS unsigned char*)lds_raw;
    const int G = gridDim.x, bid = blockIdx.x, ngw = G * NWAVES;
    if (threadIdx.x < 2) ((volatile LAS unsigned*)(lds + LDS_BYTES - 32))[threadIdx.x] = 0u;
    __syncthreads();
    (void)xcd_barrier_post((unsigned*)(kargs_ptr()->ws) + 1024, (volatile LAS unsigned*)(lds + LDS_BYTES - 32));
#define LANE_SETUP() int tid_o = threadIdx.x; asm volatile("" : "+v"(tid_o)); const int lane = tid_o & 63, wave = __builtin_amdgcn_readfirstlane(tid_o >> 6), gw = bid * NWAVES + wave; (void)gw; (void)lane
#define ws (kargs_ptr()->ws)
#define XN ((bf16*)(ws + WS_XN))
#define BIG ((bf16*)(ws + WS_BIG))
#define Y ((bf16*)(ws + WS_Y))
#define MIX ((bf16*)(ws + WS_MIX))
#define YS ((float*)(ws + WS_YS))
#define YSB ((bf16*)(ws + WS_YSB))
#define H (kargs_ptr()->out)

    { convert_static(0, CV_P0_END, 0, G, ws, lds);
      PH(0) { LANE_SETUP();
        row_pass(nullptr, IN(0), nullptr, XN, nullptr, 0.f, IN(1), gw, ngw, lane); }
    }
    if (__builtin_expect(kargs_ptr()->out == nullptr, 0)) grid.sync();
    MK_SYNC();

#pragma unroll 1
    for (int l = 0; l < NLAYER; ++l) {
#define lw (ws + WS_W + (size_t)l * LW_SIZE)
#pragma unroll 1
        for (int f = 0; f < 2; ++f) {
            PH(1) { pg8::Gemm g{XN, (const bf16*)(lw + (f ? LW_GU2 : LW_GU1)), M, 2 * FF, DM}; pg8::StaticOrder S; S.init(M, 2 * FF, G, bid);
              pg8::EpiSwiGLU E{BIG, FF};
              pg8::gemm_phase<pg8::EpiSwiGLU, pg8::StaticOrder, true, true>(lds, g, S, E); }
            MK_SYNC();
            PH(2) { pg8::Gemm g{BIG, (const bf16*)(lw + (f ? LW_D2 : LW_D1)), M, DM, FF}; pg8::StaticOrder S; S.init(M, DM, G, bid);
              pg8::EpiBf16Plain E{Y, DM};
              pg8::gemm_phase<pg8::EpiBf16Plain, pg8::StaticOrder, true, true>(lds, g, S, E); }
            MK_SYNC();
            PH(3) { LANE_SETUP(); const float* gpost = (f ? IN(30) : IN(5)) + (size_t)l * DM;
              const float* gpre = f == 0 ? IN(6) + (size_t)l * DM : (l + 1 < NLAYER ? IN(1) + (size_t)(l + 1) * DM : nullptr);
              row_pass(Y, (l == 0 && f == 0) ? IN(0) : (const float*)H, H, XN, gpost, 0.5f, gpre, gw, ngw, lane); }
            if (f == 1) break;
            MK_SYNC();
            PH(4) { pg8::Gemm g{XN, (const bf16*)(lw + LW_IN), M, INC, DM}; pg8::StaticOrder S; S.init(M, INC, G, bid);
              pg8::EpiBf16Plain E{BIG, INC};
              pg8::gemm_phase<pg8::EpiBf16Plain, pg8::StaticOrder, true, true>(lds, g, S, E); }
            MK_SYNC();
#ifndef MIX_REPS
#define MIX_REPS 1
#endif
            {
                LANE_SETUP();
                static_assert(NLAYER == 2, "lambda_init table");
                int lo_ = l; asm volatile("" : "+s"(lo_));
                const float lambda_init = (lo_ == 0) ? 0.2f : 0.35550907f;
                const float d1 = wave_sum(IN(18)[l * 64 + lane] * IN(19)[l * 64 + lane]);
                const float d2 = wave_sum(IN(20)[l * 64 + lane] * IN(21)[l * 64 + lane]);
                const float lam = expf(d1) - expf(d2) + lambda_init;
                volatile LAS int* slot = (volatile LAS int*)(lds + LDS_BYTES - 64);
                volatile LAS int* peekv = (volatile LAS int*)(lds + LDS_BYTES - 128);
                const int myx = (int)(xb_xcc_id() & 7u);
#pragma unroll 1
                for (int stage = 0; stage < 3; ++stage) {
                    const int limit = stage == 0 ? 64 : (stage == 1 ? 24 : 64);
                    const int cbase = stage == 0 ? 64 * (l * 8) : (stage == 1 ? 4608 + 64 * (l * 8) : 5632 + 64 * l);
#pragma unroll 1
                    for (int pass = 0; ; ++pass) {
                        int x = 0;
                        if (stage == 2) { if (pass) break; }
                        else if (pass == 0) x = myx;
                        else {
                            if (tid_o < 8) peekv[tid_o] = (int)__hip_atomic_load((unsigned*)ws + cbase + 64 * tid_o, __ATOMIC_RELAXED, __HIP_MEMORY_SCOPE_AGENT);
                            __syncthreads();
                            x = -1;
#pragma unroll
                            for (int j = 7; j >= 0; --j) { const int xx = (myx + j) & 7; if (peekv[xx] < limit) x = xx; }
                            __syncthreads();
                            if (x < 0) break;
                        }
                        unsigned* ctr = (unsigned*)ws + cbase + 64 * x;
                        if (tid_o == 0) *slot = (int)atomicAdd(ctr, 1u);
                        __syncthreads();
                        int item = *slot;
                        __syncthreads();
                        while (item < limit) {
                            if (stage == 0) {
                                if (item < 24 || item >= 40) { PH(5) { const int di = item < 24 ? item : item - 16; const int qb = 15 - (di / 3), bh = 8 * (di % 3) + x;
                                    diff_unit((LAS char*)lds, BIG, MIX, IN(23), lam, 1.0f - lambda_init, IN(22) + (size_t)l * 128, bh / 6, bh % 6, qb); } }
                                else { PH(6) { const int u = 8 * (item - 24) + x; ssm_unit((LAS char*)lds, l, BIG, YSB, u / 32, u % 32, (unsigned*)ws + 6144 + 64 * (l * 4 + u / 32)); } }
                            } else if (stage == 1) { PH(7) { const int qb = 7 - (item / 3), bh = 8 * (item % 3) + x; sb_unit((LAS char*)lds, BIG, MIX, bh / 6, bh % 6, qb); } }
                            else { PH(8) {
                                pg8::Gemm g{YSB, (const bf16*)(lw + LW_GLU), M, 512, 512};
                                pg8::GatedUnit S1{pg8::Unit{item >> 1, item & 1}, (unsigned*)ws + 6144 + 64 * (l * 4 + (item >> 4)), 32u};
                                pg8::EpiGlu E{MIX + MIX_SSM, DM, YSB, 512, IN(17) + (size_t)l * 512};
                                pg8::gemm_phase<pg8::EpiGlu, pg8::GatedUnit, true, true>(lds, g, S1, E);
                                __syncthreads(); } }
                            if (tid_o == 0) *slot = (int)atomicAdd(ctr, 1u);
                            __syncthreads();
                            item = *slot;
                            __syncthreads();
                        }
                    }
                }
            }
            MK_SYNC();
            PH(9) { pg8::Gemm g{MIX, (const bf16*)(lw + LW_OUT), M, DM, DM}; pg8::StaticOrder S; S.init(M, DM, G, bid);
              pg8::EpiBf16Plain E{Y, DM};
              pg8::gemm_phase<pg8::EpiBf16Plain, pg8::StaticOrder, true, true>(lds, g, S, E); }
            MK_SYNC();
            PH(3) { LANE_SETUP(); row_pass(Y, H, H, XN, IN(25) + (size_t)l * DM, 1.0f, IN(26) + (size_t)l * DM, gw, ngw, lane); }
            MK_SYNC();
        }
        if (l + 1 < NLAYER) MK_SYNC();
    }
}

#undef ws
#undef XN
#undef BIG
#undef Y
#undef MIX
#undef YS
#undef YSB
#undef H
#undef lw
extern "C" void kernel_launch(void* const* d_in, const int* in_sizes, int n_in, void* d_out, int out_size, void* d_ws, size_t ws_size, hipStream_t stream) {
    static int grid = 0;
    if (grid == 0) {
        if (n_in != 31 || out_size != M * DM || ws_size < WS_END) { fprintf(stderr, "kernel_launch: unexpected shapes (n_in %d, out %d, ws %zu < %zu)\n", n_in, out_size, ws_size, (size_t)WS_END); grid = -1; return; }
        int dev = 0, cus = 0, per_cu = 0;
        hipGetDevice(&dev); hipDeviceGetAttribute(&cus, hipDeviceAttributeMultiprocessorCount, dev);
        if (hipFuncSetAttribute((const void*)fwd_megakernel, hipFuncAttributeMaxDynamicSharedMemorySize, LDS_BYTES) != hipSuccess) { fprintf(stderr, "kernel_launch: hipFuncSetAttribute failed\n"); grid = -1; return; }
        hipOccupancyMaxActiveBlocksPerMultiprocessor(&per_cu, (const void*)fwd_megakernel, NTHREADS, LDS_BYTES);
        if (per_cu < 1) { fprintf(stderr, "kernel_launch: occupancy query says %d blocks per CU\n", per_cu); per_cu = 1; }
        (void)hipGetLastError();
        grid = cus * 1;
    }
    if (grid < 0) return;
    if (hipMemsetAsync(d_ws, 0, 65536, stream) != hipSuccess) { fprintf(stderr, "kernel_launch: memset failed\n"); return; }
    Args a{};
    for (int i = 0; i < 31; ++i) a.in[i] = (const float*)d_in[i];
    a.out = (float*)d_out; a.ws = (unsigned char*)d_ws;
    void* kargs[] = {&a};
    hipError_t e = hipLaunchCooperativeKernel((const void*)fwd_megakernel, dim3(grid), dim3(NTHREADS), kargs, LDS_BYTES, stream);
    if (e != hipSuccess) fprintf(stderr, "kernel_launch: cooperative launch failed: %s (grid %d)\n", hipGetErrorString(e), grid);
}
```
